# Optimizing an MI355X kernel written in HIP

```python
import math
import jax, jax.numpy as jnp
from jax import lax
import numpy as np

D_MODEL = 1024
BATCH = 16
SEQ = 2048
DEPTH = 2

F32 = jnp.float32
D_MIX = D_MODEL
NORM_EPS = 1e-6
Q_BLOCK = 128
MLA_HEADS = 6
MLA_NOPE = 64
MLA_ROPE = 32
MLA_V = 64
MLA_Q_RANK = 256
MLA_KV_RANK = 128
ROPE_THETA = 10000.0
MLA_W = MLA_HEADS * MLA_V
DIFF_HEADS = 4
DIFF_DH = 32
DIFF_W = DIFF_HEADS * 2 * DIFF_DH
DIFF_SUBLN_EPS = 1e-5
RW_HEADS = 6
RW_N = 64
RW_W = RW_HEADS * RW_N
RW_DECAY_RANK = 64
RW_AAA_RANK = 64
RW_MV_RANK = 32
RW_GN_EPS = 64e-5
RW_SHIFT_BASE = 3 * RW_W + RW_DECAY_RANK + RW_AAA_RANK
C_BASE = MLA_Q_RANK + MLA_KV_RANK + MLA_ROPE + 3 * DIFF_W + D_MIX + RW_SHIFT_BASE

kernel_name = 'hymba_style_mla_diff_rwkv7_hybrid'


def _split(t, sizes):
    return jnp.split(t, np.cumsum(sizes).tolist(), axis=-1)


def _rmsnorm(x, g, eps=NORM_EPS):
    xf = x.astype(F32)
    y = xf * lax.rsqrt(jnp.mean(xf * xf, axis=-1, keepdims=True) + eps) * g.astype(F32)
    return y.astype(x.dtype)


def _rope(t, positions):
    half = t.shape[-1] // 2
    inv = ROPE_THETA ** (-jnp.arange(half, dtype=F32) / half)
    ang = positions.astype(F32)[:, None] * inv[None, :]
    cos = jnp.cos(ang)[None, :, None, :]
    sin = jnp.sin(ang)[None, :, None, :]
    t = t.astype(F32)
    t1, t2 = t[..., :half], t[..., half:]
    return jnp.concatenate([t1 * cos - t2 * sin, t1 * sin + t2 * cos], axis=-1)


def _causal_mask(q0, kend):
    q_idx = q0 + jnp.arange(Q_BLOCK)
    k_idx = jnp.arange(kend)
    return k_idx[None, :] <= q_idx[:, None]


def _alibi_slopes(n):
    return 2.0 ** (-8.0 * jnp.arange(1, n + 1, dtype=F32) / n)


def _mla_branch(cq, ckv, kpe, positions, g_q, g_kv, w_uq, w_ukv):
    B, S, _ = cq.shape
    dt = cq.dtype
    q = (_rmsnorm(cq, g_q) @ w_uq).reshape(B, S, MLA_HEADS, MLA_NOPE + MLA_ROPE)
    kv = (_rmsnorm(ckv, g_kv) @ w_ukv).reshape(B, S, MLA_HEADS, MLA_NOPE + MLA_V)
    q_nope, q_pe = q[..., :MLA_NOPE], q[..., MLA_NOPE:]
    k_nope, v = kv[..., :MLA_NOPE], kv[..., MLA_NOPE:]
    q_pe = _rope(q_pe, positions)
    k_pe = jnp.broadcast_to(_rope(kpe[:, :, None, :], positions), (B, S, MLA_HEADS, MLA_ROPE))
    q = jnp.concatenate([q_nope.astype(F32), q_pe], axis=-1).transpose(0, 2, 1, 3)
    k = jnp.concatenate([k_nope.astype(F32), k_pe], axis=-1).transpose(0, 2, 1, 3)
    v = v.astype(F32).transpose(0, 2, 1, 3)
    scale = (MLA_NOPE + MLA_ROPE) ** -0.5
    outs = []
    for q0 in range(0, S, Q_BLOCK):
        kend = q0 + Q_BLOCK
        s = jnp.einsum('bhqd,bhkd->bhqk', q[:, :, q0:kend], k[:, :, :kend]) * scale
        s = jnp.where(_causal_mask(q0, kend), s, -jnp.inf)
        p = jax.nn.softmax(s, axis=-1)
        outs.append(jnp.einsum('bhqk,bhkd->bhqd', p, v[:, :, :kend]))
    o = jnp.concatenate(outs, axis=2)
    return o.transpose(0, 2, 1, 3).reshape(B, S, MLA_W).astype(dt)


def _diff_branch(q, k, v, positions, lam, g_sub, layer):
    B, S, _ = q.shape
    dt = q.dtype
    q = q.astype(F32).reshape(B, S, DIFF_HEADS, 2, DIFF_DH).transpose(0, 2, 3, 1, 4)
    k = k.astype(F32).reshape(B, S, DIFF_HEADS, 2, DIFF_DH).transpose(0, 2, 3, 1, 4)
    v = v.astype(F32).reshape(B, S, DIFF_HEADS, 2 * DIFF_DH).transpose(0, 2, 1, 3)
    lam = lam.astype(F32)
    lam_init = 0.8 - 0.6 * math.exp(-0.3 * (layer + 1))
    lam_full = jnp.exp(jnp.sum(lam[0] * lam[1])) - jnp.exp(jnp.sum(lam[2] * lam[3])) + lam_init
    slopes = _alibi_slopes(DIFF_HEADS)[None, :, None, None, None]
    pos = positions.astype(F32)
    scale = DIFF_DH ** -0.5
    outs = []
    for q0 in range(0, S, Q_BLOCK):
        kend = q0 + Q_BLOCK
        s = jnp.einsum('bhmqd,bhmkd->bhmqk', q[:, :, :, q0:kend], k[:, :, :, :kend]) * scale
        dist = jnp.abs(pos[q0:kend, None] - pos[None, :kend])
        s = s - slopes * dist
        s = jnp.where(_causal_mask(q0, kend), s, -jnp.inf)
        p = jax.nn.softmax(s, axis=-1)
        a = p[:, :, 0] - lam_full * p[:, :, 1]
        outs.append(jnp.einsum('bhqk,bhkd->bhqd', a, v[:, :, :kend]))
    o = jnp.concatenate(outs, axis=2)
    o = _rmsnorm(o, g_sub, DIFF_SUBLN_EPS) * (1.0 - lam_init)
    return o.transpose(0, 2, 1, 3).reshape(B, S, DIFF_W).astype(dt)


def _wkv7_scan(r, w, k, v, a, b):
    B, S, H, N = r.shape

    def step(state, inp):
        r_t, w_t, k_t, v_t, a_t, b_t = inp
        sa = jnp.einsum('bhvk,bhk->bhv', state, a_t)
        state = (state * w_t[:, :, None, :] + sa[..., None] * b_t[:, :, None, :]
                 + v_t[..., None] * k_t[:, :, None, :])
        return state, jnp.einsum('bhvk,bhk->bhv', state, r_t)

    xs = tuple(jnp.moveaxis(t, 1, 0) for t in (r, w, k, v, a, b))
    _, ys = lax.scan(step, jnp.zeros((B, H, N, N), F32), xs)
    return jnp.moveaxis(ys, 0, 1)


def _rwkv7_branch(p, mu, w0, w2, a0, a2, k_k, k_a, r_k, ln_w, ln_b, v_first, v0, v2):
    B, S, _ = p.shape
    dt = p.dtype
    p = p.astype(F32)
    prev = jnp.pad(p, ((0, 0), (1, 0), (0, 0)))[:, :S]
    xs = p + (prev - p) * mu.astype(F32)
    r, k, v, hw, ha, hv = _split(xs, [RW_W, RW_W, RW_W, RW_DECAY_RANK, RW_AAA_RANK])
    w = -jax.nn.softplus(-(w0 + jnp.tanh(hw) @ w2)) - 0.5
    a = jax.nn.sigmoid(a0 + ha @ a2)
    if v_first is None:
        v_first = v
    else:
        v = v + (v_first - v) * jax.nn.sigmoid(v0 + hv @ v2)
    heads = lambda t: t.reshape(B, S, RW_HEADS, RW_N)
    kk = heads(k * k_k)
    kk = kk / jnp.maximum(jnp.sqrt(jnp.sum(kk * kk, axis=-1, keepdims=True)), 1e-12)
    k = k * (1.0 + (a - 1.0) * k_a)
    r, k, v, a = heads(r), heads(k), heads(v), heads(a)
    decay = jnp.exp(-jnp.exp(heads(w)))
    y = _wkv7_scan(r, decay, k, v, -kk, kk * a)
    mean = jnp.mean(y, axis=-1, keepdims=True)
    var = jnp.mean(jnp.square(y - mean), axis=-1, keepdims=True)
    y = ((y - mean) * lax.rsqrt(var + RW_GN_EPS) * ln_w.reshape(RW_HEADS, RW_N)
         + ln_b.reshape(RW_HEADS, RW_N))
    y = y + jnp.sum(r * k * r_k, axis=-1, keepdims=True) * v
    return y.reshape(B, S, RW_W).astype(dt), v_first


def setup_inputs(seed: int = 0) -> dict:
    key = jax.random.key(seed)
    ks = iter(jax.random.split(key, 32))
    normal = lambda shape, scale: jax.random.normal(next(ks), shape, F32) * scale
    gain = lambda shape: 1.0 + normal(shape, 0.02)
    uniform = lambda shape, lo, hi: jax.random.uniform(next(ks), shape, F32, lo, hi)
    L, Lv = DEPTH, DEPTH - 1
    x = normal((BATCH, SEQ, D_MODEL), 1.0)
    offset = jax.random.randint(next(ks), (), 0, 4096, dtype=jnp.int32)
    positions = offset + jnp.arange(SEQ, dtype=jnp.int32)
    return {
        'x': x,
        'positions': positions,
        'pre_g': gain((L, D_MODEL)),
        'w_in': normal((L, D_MODEL, C_BASE), D_MODEL ** -0.5),
        'w_in_vres': normal((Lv, D_MODEL, RW_MV_RANK), D_MODEL ** -0.5),
        'w_out': normal((L, D_MIX, D_MODEL), D_MIX ** -0.5),
        'mla_gq': gain((L, MLA_Q_RANK)),
        'mla_gkv': gain((L, MLA_KV_RANK)),
        'mla_wuq': normal((L, MLA_Q_RANK, MLA_HEADS * (MLA_NOPE + MLA_ROPE)), MLA_Q_RANK ** -0.5),
        'mla_wukv': normal((L, MLA_KV_RANK, MLA_HEADS * (MLA_NOPE + MLA_V)), MLA_KV_RANK ** -0.5),
        'diff_lam': normal((L, 4, DIFF_DH), 0.1),
        'diff_gsub': gain((L, 2 * DIFF_DH)),
        'rw_mu': uniform((L, RW_SHIFT_BASE), 0.0, 1.0),
        'rw_mu_vres': uniform((Lv, RW_MV_RANK), 0.0, 1.0),
        'rw_w0': uniform((L, RW_W), -6.0, -1.0),
        'rw_w2': normal((L, RW_DECAY_RANK, RW_W), RW_DECAY_RANK ** -0.5),
        'rw_a0': normal((L, RW_W), 0.1),
        'rw_a2': normal((L, RW_AAA_RANK, RW_W), RW_AAA_RANK ** -0.5),
        'rw_v0': 1.0 + normal((Lv, RW_W), 0.1),
        'rw_v2': normal((Lv, RW_MV_RANK, RW_W), RW_MV_RANK ** -0.5),
        'rw_kk': 0.85 + normal((L, RW_W), 0.02),
        'rw_ka': gain((L, RW_W)),
        'rw_rk': normal((L, RW_HEADS, RW_N), 0.1),
        'rw_lnw': gain((L, RW_W)),
        'rw_lnb': normal((L, RW_W), 0.02),
        'final_g': gain((D_MODEL,)),
    }


def reference(x, positions, pre_g, w_in, w_in_vres, w_out, mla_gq, mla_gkv, mla_wuq, mla_wukv,
              diff_lam, diff_gsub, rw_mu, rw_mu_vres, rw_w0, rw_w2, rw_a0, rw_a2, rw_v0, rw_v2,
              rw_kk, rw_ka, rw_rk, rw_lnw, rw_lnb, final_g):
    v_first = None
    for layer in range(DEPTH):
        h = _rmsnorm(x, pre_g[layer])
        if layer == 0:
            w_comb, mu = w_in[0], rw_mu[0]
            v0, v2 = None, None
        else:
            w_comb = jnp.concatenate([w_in[layer], w_in_vres[layer - 1]], axis=1)
            mu = jnp.concatenate([rw_mu[layer], rw_mu_vres[layer - 1]], axis=0)
            v0, v2 = rw_v0[layer - 1], rw_v2[layer - 1]
        proj = h @ w_comb
        cq, ckv, kpe, dq, dk, dv, gate, rw = _split(
            proj, [MLA_Q_RANK, MLA_KV_RANK, MLA_ROPE, DIFF_W, DIFF_W, DIFF_W, D_MIX])
        o_mla = _mla_branch(cq, ckv, kpe, positions, mla_gq[layer], mla_gkv[layer],
                            mla_wuq[layer], mla_wukv[layer])
        o_diff = _diff_branch(dq, dk, dv, positions, diff_lam[layer], diff_gsub[layer], layer)
        o_rw, v_first = _rwkv7_branch(rw, mu, rw_w0[layer], rw_w2[layer], rw_a0[layer], rw_a2[layer],
                                      rw_kk[layer], rw_ka[layer], rw_rk[layer], rw_lnw[layer],
                                      rw_lnb[layer], v_first, v0, v2)
        g_mla, g_diff, g_rw = _split(gate, [MLA_W, DIFF_W])
        mixed = jnp.concatenate([o_mla * jax.nn.silu(g_mla), o_diff * jax.nn.silu(g_diff),
                                 o_rw * jax.nn.silu(g_rw)], axis=-1)
        x = x + mixed @ w_out[layer]
    return _rmsnorm(x, final_g)
```

```cpp
#include <hip/hip_runtime.h>
#include <hip/hip_cooperative_groups.h>
#include <cstdio>
#include <cstdint>
namespace cg = cooperative_groups;

#ifndef MK_LAUNCHES
#define MK_LAUNCHES 9
#endif

typedef unsigned short bf16_t;
typedef short bf16x8 __attribute__((ext_vector_type(8)));
typedef float f32x4 __attribute__((ext_vector_type(4)));
#define DI __device__ __forceinline__

constexpr int NB = 16, SEQ = 2048, T = NB * SEQ, DM = 1024;
constexpr int NP = 3584;
constexpr int LDPA = 1536;
constexpr int LDPB = 1728;
constexpr int NPHASE = 9;

constexpr size_t OFF_CTL = 0;
constexpr size_t OFF_TAB = 4096;
constexpr size_t SZ_WC = (size_t)NP * 1024 * 2;
constexpr size_t OFF_WC = OFF_TAB + 262144;
constexpr size_t SZ_WO = (size_t)1024 * 1024 * 2;
constexpr size_t OFF_WO = OFF_WC + 2 * SZ_WC;
constexpr size_t SZ_WUQ = (size_t)640 * 256 * 2;
constexpr size_t OFF_WUQ = OFF_WO + 2 * SZ_WO;
constexpr size_t SZ_WUKV = (size_t)768 * 128 * 2;
constexpr size_t OFF_WUKV = OFF_WUQ + 2 * SZ_WUQ;
constexpr size_t SZ_L = (size_t)384 * 64 * 2;
constexpr size_t OFF_W2 = OFF_WUKV + 2 * SZ_WUKV;
constexpr size_t OFF_A2 = OFF_W2 + 2 * SZ_L;
constexpr size_t OFF_V2 = OFF_A2 + 2 * SZ_L;
constexpr size_t OFF_R1 = OFF_V2 + SZ_L;
constexpr size_t SZ_QK = (size_t)T * 576 * 2;
constexpr size_t OFF_PA = OFF_R1 + 2 * SZ_QK;
constexpr size_t OFF_R2 = OFF_PA + (size_t)T * LDPA * 2;
constexpr size_t OFF_VTM = OFF_R2 + (size_t)T * LDPB * 2;
constexpr size_t OFF_VTD = OFF_VTM + (size_t)T * 384 * 2;
constexpr size_t SZ_SC = (size_t)T * 384 * 2;
constexpr size_t OFF_SC = OFF_VTD + (size_t)T * 256 * 2;
constexpr size_t OFF_LA = OFF_SC + 6 * SZ_SC;
constexpr size_t WS_END = OFF_LA + (size_t)T * 192 * 2;
static_assert(OFF_R1 % 256 == 0, "align");

struct KP { const float* in[26]; float* out; unsigned char* ws; int ph_lo, ph_hi; };

DI unsigned f2bf(float f) { unsigned u = __float_as_uint(f); return (u + 0x7fffu + ((u >> 16) & 1u)) >> 16; }
DI float bf2f(bf16_t h) { return __uint_as_float(((unsigned)h) << 16); }
DI unsigned pk2(float a, float b) { return f2bf(a) | (f2bf(b) << 16); }
DI void store4bf(bf16_t* p, f32x4 v) { uint2 u; u.x = pk2(v[0], v[1]); u.y = pk2(v[2], v[3]); *(uint2*)p = u; }
DI f32x4 up4(uint2 u) { f32x4 r; r[0] = __uint_as_float(u.x << 16); r[1] = __uint_as_float(u.x & 0xffff0000u); r[2] = __uint_as_float(u.y << 16); r[3] = __uint_as_float(u.y & 0xffff0000u); return r; }
DI f32x4 load4bf(const bf16_t* p) { return up4(*(const uint2*)p); }
DI float wave_sum(float v) {
#pragma unroll
  for (int o = 1; o < 64; o <<= 1) v += __shfl_xor(v, o);
  return v;
}
DI float ex2(float x) { return __builtin_amdgcn_exp2f(x); }
DI float fexp(float x) { return __builtin_amdgcn_exp2f(x * 1.4426950408889634f); }
DI float sigm(float x) { return 1.f / (1.f + fexp(-x)); }
DI float silu(float x) { return x / (1.f + fexp(-x)); }
template <int CTRL> DI float dppmov(float x) { return __builtin_bit_cast(float, __builtin_amdgcn_update_dpp(0, __builtin_bit_cast(int, x), CTRL, 0xF, 0xF, true)); }
DI float rowsum16(float x) {
  x += dppmov<0xB1>(x);
  x += dppmov<0x4E>(x);
  x += dppmov<0x124>(x);
  x += dppmov<0x128>(x);
  return x;
}
DI int otid() { int t = threadIdx.x; asm volatile("" : "+v"(t)); return t; }
#define MFMA16(a, b, c) __builtin_amdgcn_mfma_f32_16x16x32_bf16((a), (b), (c), 0, 0, 0)

template <class Epi>
DI void gemm_tile(unsigned char* lds, const bf16_t* __restrict__ A, int lda, const bf16_t* __restrict__ Bt, int ldb, int K, int row0, int col0, const Epi& epi) {
  bf16_t* sA = (bf16_t*)lds;
  bf16_t* sB = sA + 128 * 72;
  const int tid = otid(), lane = tid & 63, w = tid >> 6, wm = w >> 2, wn = w & 3, lr = lane & 15, g = lane >> 4;
  const int sr = tid >> 3, skc = tid & 7;
  const bf16_t* gA = A + (size_t)(row0 + sr) * lda + skc * 8;
  const bf16_t* gB = Bt + (size_t)(col0 + sr) * ldb + skc * 8;
  uint4 ra0, ra1, rb0, rb1;
  ra0 = *(const uint4*)(gA); ra1 = *(const uint4*)(gA + (size_t)64 * lda);
  rb0 = *(const uint4*)(gB); rb1 = *(const uint4*)(gB + (size_t)64 * ldb);
  f32x4 acc[4][2];
#pragma unroll
  for (int mi = 0; mi < 4; ++mi)
#pragma unroll
    for (int ni = 0; ni < 2; ++ni) acc[mi][ni] = (f32x4){0.f, 0.f, 0.f, 0.f};
  const int nk = K >> 6;
  for (int kt = 0; kt < nk; ++kt) {
    __syncthreads();
    *(uint4*)(sA + sr * 72 + skc * 8) = ra0; *(uint4*)(sA + (sr + 64) * 72 + skc * 8) = ra1;
    *(uint4*)(sB + sr * 72 + skc * 8) = rb0; *(uint4*)(sB + (sr + 64) * 72 + skc * 8) = rb1;
    __syncthreads();
    if (kt + 1 < nk) {
      const int k0 = (kt + 1) * 64;
      ra0 = *(const uint4*)(gA + k0); ra1 = *(const uint4*)(gA + (size_t)64 * lda + k0);
      rb0 = *(const uint4*)(gB + k0); rb1 = *(const uint4*)(gB + (size_t)64 * ldb + k0);
    }
#pragma unroll
    for (int ks = 0; ks < 2; ++ks) {
      bf16x8 af[4], bfr[2];
#pragma unroll
      for (int mi = 0; mi < 4; ++mi) af[mi] = *(const bf16x8*)(sA + (wm * 64 + mi * 16 + lr) * 72 + ks * 32 + g * 8);
#pragma unroll
      for (int ni = 0; ni < 2; ++ni) bfr[ni] = *(const bf16x8*)(sB + (wn * 32 + ni * 16 + lr) * 72 + ks * 32 + g * 8);
#pragma unroll
      for (int mi = 0; mi < 4; ++mi)
#pragma unroll
        for (int ni = 0; ni < 2; ++ni) acc[mi][ni] = MFMA16(bfr[ni], af[mi], acc[mi][ni]);
    }
  }
#pragma unroll
  for (int mi = 0; mi < 4; ++mi)
#pragma unroll
    for (int ni = 0; ni < 2; ++ni) epi(row0 + wm * 64 + mi * 16 + lr, col0 + wn * 32 + ni * 16 + 4 * g, acc[mi][ni]);
}

struct EpiRoute {
  bf16_t* pA; bf16_t* pB; bf16_t* VtD; int ncols;
  DI void operator()(int row, int col, f32x4 v) const {
    if (col >= ncols) return;
    if (col < 416) store4bf(pB + (size_t)row * LDPB + col, v);
    else if (col < 928) store4bf(pA + (size_t)row * LDPA + (col - 416), v);
    else if (col < 1184) {
      const int c = col - 928, h = c >> 6, dv = c & 63, b = row >> 11, s = row & 2047;
      bf16_t* q = VtD + ((size_t)((b * 4 + h) * 64 + dv)) * 2048 + s;
      q[0] = (bf16_t)f2bf(v[0]); q[2048] = (bf16_t)f2bf(v[1]); q[4096] = (bf16_t)f2bf(v[2]); q[6144] = (bf16_t)f2bf(v[3]);
    }
    else if (col < 2208) store4bf(pA + (size_t)row * LDPA + 512 + (col - 1184), v);
    else store4bf(pB + (size_t)row * LDPB + 416 + (col - 2208), v);
  }
};
struct EpiQ {
  bf16_t* Qm; const float* rs; int row0;
  DI void operator()(int row, int col, f32x4 v) const {
    if (col >= 576) return;
    const float r = rs[row - row0]; v = v * r;
    store4bf(Qm + (size_t)row * 576 + col, v);
  }
};
struct EpiKV {
  bf16_t* Km; bf16_t* VtM; const float* rs; int row0;
  DI void operator()(int row, int col, f32x4 v) const {
    const float r = rs[row - row0]; v = v * r;
    const int head = col >> 7, c = col & 127;
    if (c < 64) store4bf(Km + (size_t)row * 576 + head * 96 + c, v);
    else {
      const int b = row >> 11, s = row & 2047;
      bf16_t* q = VtM + ((size_t)((b * 6 + head) * 64 + (c - 64))) * 2048 + s;
      q[0] = (bf16_t)f2bf(v[0]); q[2048] = (bf16_t)f2bf(v[1]); q[4096] = (bf16_t)f2bf(v[2]); q[6144] = (bf16_t)f2bf(v[3]);
    }
  }
};
struct EpiW {
  bf16_t* wbuf; const float* w0;
  DI void operator()(int row, int col, f32x4 v) const {
    f32x4 o;
#pragma unroll
    for (int i = 0; i < 4; ++i) { const float val = v[i] + w0[col + i]; const float wv = -__logf(1.f + fexp(-val)) - 0.5f; o[i] = -fexp(wv); }
    store4bf(wbuf + (size_t)row * 384 + col, o);
  }
};
struct EpiA {
  bf16_t* abuf; bf16_t* kbuf; const float* a0; const float* ka;
  DI void operator()(int row, int col, f32x4 v) const {
    f32x4 kr = load4bf(kbuf + (size_t)row * 384 + col), a, kn;
#pragma unroll
    for (int i = 0; i < 4; ++i) { a[i] = sigm(v[i] + a0[col + i]); kn[i] = kr[i] * (1.f + (a[i] - 1.f) * ka[col + i]); }
    store4bf(abuf + (size_t)row * 384 + col, a);
    store4bf(kbuf + (size_t)row * 384 + col, kn);
  }
};
struct EpiV {
  bf16_t* vbuf; const bf16_t* pB; const float* v0; const float* mu;
  DI void operator()(int row, int col, f32x4 v) const {
    const int s = row & 2047;
    f32x4 p = load4bf(pB + (size_t)row * LDPB + 416 + 768 + col), pr = (f32x4){0.f, 0.f, 0.f, 0.f};
    if (s > 0) pr = load4bf(pB + (size_t)(row - 1) * LDPB + 416 + 768 + col);
    f32x4 vf = load4bf(vbuf + (size_t)row * 384 + col), o;
#pragma unroll
    for (int i = 0; i < 4; ++i) { const float xv = p[i] + (pr[i] - p[i]) * mu[768 + col + i]; const float sg = sigm(v[i] + v0[col + i]); o[i] = xv + (vf[i] - xv) * sg; }
    store4bf(vbuf + (size_t)row * 384 + col, o);
  }
};
struct EpiOut {
  const float* xin; float* xout;
  DI void operator()(int row, int col, f32x4 v) const {
    const f32x4 x = *(const f32x4*)(xin + (size_t)row * 1024 + col);
    *(f32x4*)(xout + (size_t)row * 1024 + col) = x + v;
  }
};

DI void convT(const float* __restrict__ src, int K, int N, bf16_t* dst, int Kpad, int NR, const float* scale, int gt, int ngt) {
  const int kcN = Kpad >> 3, total = NR * kcN;
  for (int idx = gt; idx < total; idx += ngt) {
    const int n = idx % NR, kc = idx / NR; uint4 o = {0u, 0u, 0u, 0u};
    if (n < N) {
      float v[8];
#pragma unroll
      for (int j = 0; j < 8; ++j) { const int k = kc * 8 + j; v[j] = (k < K) ? src[(size_t)k * N + n] * (scale ? scale[k] : 1.f) : 0.f; }
      o.x = pk2(v[0], v[1]); o.y = pk2(v[2], v[3]); o.z = pk2(v[4], v[5]); o.w = pk2(v[6], v[7]);
    }
    *(uint4*)(dst + (size_t)n * Kpad + kc * 8) = o;
  }
}
DI void norm_rows_bf16(const float* x, const float* gain, bf16_t* hb, int rbeg, int rend, int gw, int ngw, int lane) {
  for (int row = rbeg + gw; row < rend; row += ngw) {
    const f32x4* xr = (const f32x4*)(x + (size_t)row * 1024) + lane;
    f32x4 v[4]; float s = 0.f;
#pragma unroll
    for (int j = 0; j < 4; ++j) { v[j] = xr[64 * j]; s += v[j][0] * v[j][0] + v[j][1] * v[j][1] + v[j][2] * v[j][2] + v[j][3] * v[j][3]; }
    const float rstd = 1.f / sqrtf(wave_sum(s) * (1.f / 1024.f) + 1e-6f);
#pragma unroll
    for (int j = 0; j < 4; ++j) { const f32x4 gg = *((const f32x4*)gain + lane + 64 * j); store4bf(hb + (size_t)row * 1024 + 4 * lane + 256 * j, v[j] * rstd * gg); }
  }
}

DI void p2_unit(unsigned char* lds, const KP& p, int l, int rt) {
  unsigned char* ws = p.ws;
  const int tid = otid(), lane = tid & 63, w = tid >> 6, row0 = rt * 128;
  bf16_t* pB = (bf16_t*)(ws + OFF_R2);
  bf16_t* Qm = (bf16_t*)(ws + OFF_R1); bf16_t* Km = Qm + (size_t)T * 576;
  bf16_t* VtM = (bf16_t*)(ws + OFF_VTM);
  bf16_t* rbuf = (bf16_t*)(ws + OFF_SC); bf16_t* kbuf = rbuf + (size_t)T * 384; bf16_t* vbuf = kbuf + (size_t)T * 384;
  bf16_t* wbuf = vbuf + (size_t)T * 384; bf16_t* kkbuf = wbuf + (size_t)T * 384; bf16_t* abuf = kkbuf + (size_t)T * 384;
  bf16_t* LA = (bf16_t*)(ws + OFF_LA);
  const float* tab = (const float*)(ws + OFF_TAB);
  float* sRq = (float*)(lds + 36864); float* sRkv = sRq + 128;
  __syncthreads();
  {
    const int r = tid >> 2, part = tid & 3; const bf16_t* pr = pB + (size_t)(row0 + r) * LDPB;
    float sq = 0.f, sk = 0.f;
#pragma unroll
    for (int j = 0; j < 16; ++j) { f32x4 v = load4bf(pr + part * 64 + j * 4); sq += v[0] * v[0] + v[1] * v[1] + v[2] * v[2] + v[3] * v[3]; }
#pragma unroll
    for (int j = 0; j < 8; ++j) { f32x4 v = load4bf(pr + 256 + part * 32 + j * 4); sk += v[0] * v[0] + v[1] * v[1] + v[2] * v[2] + v[3] * v[3]; }
    sq += __shfl_xor(sq, 1); sq += __shfl_xor(sq, 2); sk += __shfl_xor(sk, 1); sk += __shfl_xor(sk, 2);
    if (part == 0) { sRq[r] = 1.f / sqrtf(sq * (1.f / 256.f) + 1e-6f); sRkv[r] = 1.f / sqrtf(sk * (1.f / 128.f) + 1e-6f); }
  }
  {
    const float* mu = p.in[12] + l * 1280; const float* kkw = p.in[20] + l * 384;
    for (int it = w; it < 128 * 6; it += 8) {
      const int t = it / 6, h = it - t * 6, row = row0 + t, s = row & 2047, col = h * 64 + lane;
      const bf16_t* pc = pB + (size_t)row * LDPB + 416 + col;
      float pr_ = bf2f(pc[0]), pk_ = bf2f(pc[384]), pv_ = bf2f(pc[768]), qr = 0.f, qk = 0.f, qv = 0.f;
      if (s > 0) { qr = bf2f(pc[-LDPB]); qk = bf2f(pc[384 - LDPB]); qv = bf2f(pc[768 - LDPB]); }
      const float xr = pr_ + (qr - pr_) * mu[col], xk = pk_ + (qk - pk_) * mu[384 + col], xv = pv_ + (qv - pv_) * mu[768 + col];
      const float kv_ = xk * kkw[col]; const float ss = wave_sum(kv_ * kv_);
      const float kk = kv_ / fmaxf(sqrtf(ss), 1e-12f);
      const size_t o = (size_t)row * 384 + col;
      rbuf[o] = (bf16_t)f2bf(xr); kbuf[o] = (bf16_t)f2bf(xk); kkbuf[o] = (bf16_t)f2bf(kk);
      if (l == 0) vbuf[o] = (bf16_t)f2bf(xv);
    }
    const float* muv = p.in[13];
    for (int idx = tid; idx < 128 * 192; idx += 512) {
      const int t = idx / 192, j = idx - t * 192, row = row0 + t, s = row & 2047;
      float val = 0.f;
      if (j < 128 || (j < 160 && l > 0)) {
        const int sc_ = 1152 + j;
        const float m = (j < 128) ? mu[sc_] : muv[j - 128];
        const bf16_t* pc = pB + (size_t)row * LDPB + 416 + sc_;
        const float a = bf2f(pc[0]), b = (s > 0) ? bf2f(pc[-LDPB]) : 0.f;
        val = a + (b - a) * m;
        if (j < 64) val = 1.f - 2.f / (fexp(2.f * val) + 1.f);
      }
      LA[(size_t)row * 192 + j] = (bf16_t)f2bf(val);
    }
  }
  __syncthreads();
  {
    const bf16_t* WuqT = (const bf16_t*)(ws + OFF_WUQ + l * SZ_WUQ);
    const bf16_t* WukvT = (const bf16_t*)(ws + OFF_WUKV + l * SZ_WUKV);
    EpiQ eq{Qm, sRq, row0};
    for (int ct = 0; ct < 5; ++ct) gemm_tile(lds, pB, LDPB, WuqT, 256, 256, row0, ct * 128, eq);
    EpiKV ek{Km, VtM, sRkv, row0};
    for (int ct = 0; ct < 6; ++ct) gemm_tile(lds, pB + 256, LDPB, WukvT, 128, 128, row0, ct * 128, ek);
  }
  {
    const bf16_t* w2T = (const bf16_t*)(ws + OFF_W2 + l * SZ_L);
    const bf16_t* a2T = (const bf16_t*)(ws + OFF_A2 + l * SZ_L);
    const bf16_t* v2T = (const bf16_t*)(ws + OFF_V2);
    EpiW ew{wbuf, p.in[14] + l * 384};
    for (int ct = 0; ct < 3; ++ct) gemm_tile(lds, LA, 192, w2T, 64, 64, row0, ct * 128, ew);
    EpiA ea{abuf, kbuf, p.in[16] + l * 384, p.in[21] + l * 384};
    for (int ct = 0; ct < 3; ++ct) gemm_tile(lds, LA + 64, 192, a2T, 64, 64, row0, ct * 128, ea);
    if (l > 0) {
      EpiV ev{vbuf, pB, p.in[18], p.in[12] + l * 1280};
      for (int ct = 0; ct < 3; ++ct) gemm_tile(lds, LA + 128, 192, v2T, 64, 64, row0, ct * 128, ev);
    }
  }
  __syncthreads();
  {
    for (int idx = tid; idx < 128 * 16; idx += 512) {
      const int r = idx >> 4, i = idx & 15, row = row0 + r, s = row & 2047;
      const float c = tab[s * 32 + i], sn = tab[s * 32 + 16 + i];
      bf16_t* q = Qm + (size_t)row * 576 + 64;
#pragma unroll
      for (int h = 0; h < 6; ++h) { const float t1 = bf2f(q[h * 96 + i]), t2 = bf2f(q[h * 96 + 16 + i]); q[h * 96 + i] = (bf16_t)f2bf(t1 * c - t2 * sn); q[h * 96 + 16 + i] = (bf16_t)f2bf(t1 * sn + t2 * c); }
      const float k1 = bf2f(pB[(size_t)row * LDPB + 384 + i]), k2 = bf2f(pB[(size_t)row * LDPB + 400 + i]);
      const bf16_t o1 = (bf16_t)f2bf(k1 * c - k2 * sn), o2 = (bf16_t)f2bf(k1 * sn + k2 * c);
      bf16_t* kq = Km + (size_t)row * 576 + 64;
#pragma unroll
      for (int h = 0; h < 6; ++h) { kq[h * 96 + i] = o1; kq[h * 96 + 16 + i] = o2; }
    }
  }
}

DI void scan_unit(unsigned char* lds, const KP& p, int unit) {
  unsigned char* ws = p.ws;
  float* sm = (float*)lds;
  const int tid = otid(), hsel = tid >> 8, th = tid & 255, lane = tid & 63, w16 = th >> 6, rg = lane >> 4, cg_ = lane & 15;
  const int hid = unit * 2 + hsel, b = hid / 6, h = hid - b * 6;
  const bf16_t* rbuf = (const bf16_t*)(ws + OFF_SC); const bf16_t* kbuf = rbuf + (size_t)T * 384; const bf16_t* vbuf = kbuf + (size_t)T * 384;
  const bf16_t* wbuf = vbuf + (size_t)T * 384; const bf16_t* kkbuf = wbuf + (size_t)T * 384; const bf16_t* abuf = kkbuf + (size_t)T * 384;
  bf16_t* ybuf = (bf16_t*)(ws + OFF_R2);
  const int st = th >> 4, sp = th & 15;
  const size_t gbase = ((size_t)b * 2048) * 384 + h * 64 + sp * 4;
  uint2 qw, qk, qkk, qa, qr, qv;
#define SCAN_LOAD(t0) do { const size_t o_ = gbase + (size_t)((t0) + st) * 384; qw = *(const uint2*)(wbuf + o_); qk = *(const uint2*)(kbuf + o_); qkk = *(const uint2*)(kkbuf + o_); \
    qa = *(const uint2*)(abuf + o_); qr = *(const uint2*)(rbuf + o_); qv = *(const uint2*)(vbuf + o_); } while (0)
  float S[4][4];
#pragma unroll
  for (int i = 0; i < 4; ++i)
#pragma unroll
    for (int c = 0; c < 4; ++c) S[i][c] = 0.f;
  SCAN_LOAD(0);
  float* mybase = sm + hsel * 6144;
  for (int ch = 0; ch < 128; ++ch) {
    __syncthreads();
    {
      float* d = mybase + st * 384 + sp * 4;
      const f32x4 fw = up4(qw), fk = up4(qk), fkk = up4(qkk), fa = up4(qa), fr = up4(qr), fv = up4(qv);
      f32x4 dec;
#pragma unroll
      for (int i = 0; i < 4; ++i) dec[i] = fexp(fw[i]);
      *(f32x4*)(d) = dec; *(f32x4*)(d + 64) = fk; *(f32x4*)(d + 128) = -fkk; *(f32x4*)(d + 192) = fkk * fa; *(f32x4*)(d + 256) = fr; *(f32x4*)(d + 320) = fv;
    }
    __syncthreads();
    if (ch + 1 < 128) SCAN_LOAD((ch + 1) * 16);
#pragma unroll 4
    for (int t = 0; t < 16; ++t) {
      const float* q = mybase + t * 384;
      const f32x4 w4 = *(const f32x4*)(q + 4 * cg_), k4 = *(const f32x4*)(q + 64 + 4 * cg_), a4 = *(const f32x4*)(q + 128 + 4 * cg_);
      const f32x4 b4 = *(const f32x4*)(q + 192 + 4 * cg_), r4 = *(const f32x4*)(q + 256 + 4 * cg_), v4 = *(const f32x4*)(q + 320 + w16 * 16 + rg * 4);
      f32x4 yv;
#pragma unroll
      for (int i = 0; i < 4; ++i) {
        float sa = S[i][0] * a4[0] + S[i][1] * a4[1] + S[i][2] * a4[2] + S[i][3] * a4[3];
        sa = rowsum16(sa);
        const float vi = v4[i];
#pragma unroll
        for (int c = 0; c < 4; ++c) S[i][c] = S[i][c] * w4[c] + (sa * b4[c] + vi * k4[c]);
        float y = S[i][0] * r4[0] + S[i][1] * r4[1] + S[i][2] * r4[2] + S[i][3] * r4[3];
        yv[i] = rowsum16(y);
      }
      if (cg_ == 0) store4bf(ybuf + ((size_t)(b * 2048 + ch * 16 + t)) * 384 + h * 64 + w16 * 16 + rg * 4, yv);
    }
  }
#undef SCAN_LOAD
}

template <bool DIFF>
DI void attn_unit(unsigned char* lds, const bf16_t* __restrict__ Qb, const bf16_t* __restrict__ Kb, int ld, const bf16_t* __restrict__ Vt,
                  const bf16_t* __restrict__ gate, bf16_t* mixed, const int* __restrict__ pos, int qb, int h, int rowb,
                  float lam_full, float lam_init, const float* __restrict__ gsub) {
  constexpr int KS = DIFF ? 1 : 3, NM = DIFF ? 2 : 1, KW = DIFF ? 72 : 104, NQT = DIFF ? 1 : 2, QU = 128 * NQT;
  bf16_t* sK = (bf16_t*)lds; bf16_t* sV = sK + 64 * KW;
  const int tid = otid(), lane = tid & 63, w = tid >> 6, lr = lane & 15, g = lane >> 4;
  const int q0 = qb * QU, qw0 = q0 + 16 * NQT * w;
  bf16x8 qf[NM][NQT][KS];
#pragma unroll
  for (int m = 0; m < NM; ++m)
#pragma unroll
    for (int qt = 0; qt < NQT; ++qt)
#pragma unroll
      for (int ks = 0; ks < KS; ++ks) qf[m][qt][ks] = *(const bf16x8*)(Qb + (size_t)(qw0 + 16 * qt + lr) * ld + m * 32 + ks * 32 + g * 8);
  f32x4 O[NM][4][NQT]; float mrun[NM][NQT], lrun[NM][NQT];
#pragma unroll
  for (int m = 0; m < NM; ++m)
#pragma unroll
    for (int qt = 0; qt < NQT; ++qt) { mrun[m][qt] = -INFINITY; lrun[m][qt] = 0.f;
#pragma unroll
      for (int dt = 0; dt < 4; ++dt) O[m][dt][qt] = (f32x4){0.f, 0.f, 0.f, 0.f}; }
  float posq[2] = {0.f, 0.f};
  if (DIFF) { posq[0] = (float)pos[qw0 + lr]; if (NQT > 1) posq[1] = (float)pos[qw0 + 16 + lr]; }
  const float sc = DIFF ? (0.17677669529663687f * 1.4426950408889634f) : (0.10206207261596575f * 1.4426950408889634f);
  const float slope2 = DIFF ? ex2(-2.f * (float)(h + 1)) * 1.4426950408889634f : 0.f;
  const int nkt = (q0 + QU) / 64;
  const int vr = tid >> 3, vc = tid & 7;
  int kr0, kc0, kr1 = 0, kc1 = 0;
  if (DIFF) { kr0 = tid >> 3; kc0 = tid & 7; } else { kr0 = tid / 12; kc0 = tid - kr0 * 12; const int c1 = tid + 512; kr1 = c1 / 12; kc1 = c1 - kr1 * 12; }
  const bool two = (!DIFF) && (tid < 256);
  uint4 rk0, rk1 = {0u, 0u, 0u, 0u}, rv;
#define ATT_LOAD(j_) do { rk0 = *(const uint4*)(Kb + (size_t)(64 * (j_) + kr0) * ld + kc0 * 8); if (two) rk1 = *(const uint4*)(Kb + (size_t)(64 * (j_) + kr1) * ld + kc1 * 8); \
    rv = *(const uint4*)(Vt + (size_t)vr * 2048 + 64 * (j_) + vc * 8); } while (0)
  ATT_LOAD(0);
  for (int j = 0; j < nkt; ++j) {
    __syncthreads();
    *(uint4*)(sK + kr0 * KW + kc0 * 8) = rk0; if (two) *(uint4*)(sK + kr1 * KW + kc1 * 8) = rk1; *(uint4*)(sV + vr * 72 + vc * 8) = rv;
    __syncthreads();
    if (j + 1 < nkt) ATT_LOAD(j + 1);
    if (64 * j <= qw0 + 16 * NQT - 1) {
      const bool domask = (64 * j + 63 > qw0);
      int4 pk[4];
      if (DIFF) {
#pragma unroll
        for (int kt = 0; kt < 4; ++kt) pk[kt] = *(const int4*)(pos + 64 * j + 16 * kt + 4 * g);
      }
#pragma unroll
      for (int m = 0; m < NM; ++m) {
        f32x4 s[4][NQT];
#pragma unroll
        for (int kt = 0; kt < 4; ++kt) {
#pragma unroll
          for (int qt = 0; qt < NQT; ++qt) s[kt][qt] = (f32x4){0.f, 0.f, 0.f, 0.f};
#pragma unroll
          for (int ks = 0; ks < KS; ++ks) {
            const bf16x8 kf = *(const bf16x8*)(sK + (16 * kt + lr) * KW + m * 32 + ks * 32 + g * 8);
#pragma unroll
            for (int qt = 0; qt < NQT; ++qt) s[kt][qt] = MFMA16(kf, qf[m][qt][ks], s[kt][qt]);
          }
        }
#pragma unroll
        for (int kt = 0; kt < 4; ++kt)
#pragma unroll
          for (int qt = 0; qt < NQT; ++qt)
#pragma unroll
            for (int i = 0; i < 4; ++i) {
              float v = s[kt][qt][i] * sc;
              if (DIFF) { const int pki = (i == 0) ? pk[kt].x : (i == 1) ? pk[kt].y : (i == 2) ? pk[kt].z : pk[kt].w; v -= slope2 * fabsf(posq[qt] - (float)pki); }
              if (domask && (64 * j + 16 * kt + 4 * g + i > qw0 + 16 * qt + lr)) v = -INFINITY;
              s[kt][qt][i] = v;
            }
#pragma unroll
        for (int qt = 0; qt < NQT; ++qt) {
          float mx = -INFINITY;
#pragma unroll
          for (int kt = 0; kt < 4; ++kt)
#pragma unroll
            for (int i = 0; i < 4; ++i) mx = fmaxf(mx, s[kt][qt][i]);
          mx = fmaxf(mx, __shfl_xor(mx, 16)); mx = fmaxf(mx, __shfl_xor(mx, 32));
          const float mn = fmaxf(mrun[m][qt], mx), alpha = ex2(mrun[m][qt] - mn); mrun[m][qt] = mn;
          float ls = 0.f;
#pragma unroll
          for (int kt = 0; kt < 4; ++kt)
#pragma unroll
            for (int i = 0; i < 4; ++i) { const float pv = ex2(s[kt][qt][i] - mn); ls += pv; s[kt][qt][i] = pv; }
          lrun[m][qt] = lrun[m][qt] * alpha + ls;
#pragma unroll
          for (int dt = 0; dt < 4; ++dt) O[m][dt][qt] = O[m][dt][qt] * alpha;
        }
#pragma unroll
        for (int s2 = 0; s2 < 2; ++s2) {
          bf16x8 pf[NQT];
#pragma unroll
          for (int qt = 0; qt < NQT; ++qt) {
            uint4 u; u.x = pk2(s[2 * s2][qt][0], s[2 * s2][qt][1]); u.y = pk2(s[2 * s2][qt][2], s[2 * s2][qt][3]);
            u.z = pk2(s[2 * s2 + 1][qt][0], s[2 * s2 + 1][qt][1]); u.w = pk2(s[2 * s2 + 1][qt][2], s[2 * s2 + 1][qt][3]);
            pf[qt] = __builtin_bit_cast(bf16x8, u);
          }
#pragma unroll
          for (int dt = 0; dt < 4; ++dt) {
            const uint2 lo = *(const uint2*)(sV + (16 * dt + lr) * 72 + 32 * s2 + 4 * g), hi = *(const uint2*)(sV + (16 * dt + lr) * 72 + 32 * s2 + 16 + 4 * g);
            uint4 u; u.x = lo.x; u.y = lo.y; u.z = hi.x; u.w = hi.y;
            const bf16x8 vf = __builtin_bit_cast(bf16x8, u);
#pragma unroll
            for (int qt = 0; qt < NQT; ++qt) O[m][dt][qt] = MFMA16(vf, pf[qt], O[m][dt][qt]);
          }
        }
      }
    }
  }
#undef ATT_LOAD
#pragma unroll
  for (int qt = 0; qt < NQT; ++qt) {
    const size_t row = (size_t)rowb + qw0 + 16 * qt + lr;
    float inv[NM];
#pragma unroll
    for (int m = 0; m < NM; ++m) { float lt = lrun[m][qt]; lt += __shfl_xor(lt, 16); lt += __shfl_xor(lt, 32); inv[m] = 1.f / lt; }
    if (!DIFF) {
#pragma unroll
      for (int dt = 0; dt < 4; ++dt) {
        const int col = h * 64 + 16 * dt + 4 * g;
        const f32x4 gt = load4bf(gate + row * LDPA + 512 + col); f32x4 o = O[0][dt][qt] * inv[0];
#pragma unroll
        for (int i = 0; i < 4; ++i) o[i] *= silu(gt[i]);
        store4bf(mixed + row * 1024 + col, o);
      }
    } else {
      f32x4 o[4]; float ss = 0.f;
#pragma unroll
      for (int dt = 0; dt < 4; ++dt) { o[dt] = O[0][dt][qt] * inv[0] - O[NM - 1][dt][qt] * (lam_full * inv[NM - 1]); ss += o[dt][0] * o[dt][0] + o[dt][1] * o[dt][1] + o[dt][2] * o[dt][2] + o[dt][3] * o[dt][3]; }
      ss += __shfl_xor(ss, 16); ss += __shfl_xor(ss, 32);
      const float rs = (1.f / sqrtf(ss * (1.f / 64.f) + 1e-5f)) * (1.f - lam_init);
#pragma unroll
      for (int dt = 0; dt < 4; ++dt) {
        const int dvc = 16 * dt + 4 * g, col = h * 64 + dvc;
        const f32x4 gs = *(const f32x4*)(gsub + dvc); const f32x4 gt = load4bf(gate + row * LDPA + 512 + 384 + col);
        f32x4 r;
#pragma unroll
        for (int i = 0; i < 4; ++i) r[i] = o[dt][i] * rs * gs[i] * silu(gt[i]);
        store4bf(mixed + row * 1024 + 384 + col, r);
      }
    }
  }
}

DI void p4_unit(unsigned char* lds, const KP& p, int l, int rt) {
  unsigned char* ws = p.ws;
  const int tid = otid(), lane = tid & 63, w = tid >> 6, row0 = rt * 128;
  const bf16_t* rbuf = (const bf16_t*)(ws + OFF_SC); const bf16_t* kbuf = rbuf + (size_t)T * 384; const bf16_t* vbuf = kbuf + (size_t)T * 384;
  const bf16_t* ybuf = (const bf16_t*)(ws + OFF_R2); bf16_t* mixed = (bf16_t*)(ws + OFF_R2 + SZ_SC);
  const bf16_t* pA = (const bf16_t*)(ws + OFF_PA);
  const float* lnw = p.in[23] + l * 384; const float* lnb = p.in[24] + l * 384; const float* rk = p.in[22] + l * 384;
  for (int it = w; it < 128 * 6; it += 8) {
    const int t = it / 6, h = it - t * 6, row = row0 + t, col = h * 64 + lane; const size_t o = (size_t)row * 384 + col;
    const float y = bf2f(ybuf[o]), r = bf2f(rbuf[o]), k = bf2f(kbuf[o]), v = bf2f(vbuf[o]);
    const float mean = wave_sum(y) * (1.f / 64.f); const float d = y - mean; const float var = wave_sum(d * d) * (1.f / 64.f);
    const float dot = wave_sum(r * k * rk[col]);
    float outv = d * (1.f / sqrtf(var + 64e-5f)) * lnw[col] + lnb[col] + dot * v;
    const float gt = bf2f(pA[(size_t)row * LDPA + 512 + 640 + col]);
    mixed[(size_t)row * 1024 + 640 + col] = (bf16_t)f2bf(outv * silu(gt));
  }
  __syncthreads();
  const bf16_t* WoT = (const bf16_t*)(ws + OFF_WO + l * SZ_WO);
  EpiOut eo{l == 0 ? p.in[0] : p.out, p.out};
  for (int ct = 0; ct < 8; ++ct) gemm_tile(lds, mixed, 1024, WoT, 1024, 1024, row0, ct * 128, eo);
  __syncthreads();
  if (l == 0) norm_rows_bf16(p.out, p.in[2] + 1024, (bf16_t*)(ws + OFF_R1), row0, row0 + 128, w, 8, lane);
  else {
    const float* fg = p.in[25];
    for (int row = row0 + w; row < row0 + 128; row += 8) {
      f32x4* xr = (f32x4*)(p.out + (size_t)row * 1024) + lane;
      f32x4 v[4]; float s = 0.f;
#pragma unroll
      for (int j = 0; j < 4; ++j) { v[j] = xr[64 * j]; s += v[j][0] * v[j][0] + v[j][1] * v[j][1] + v[j][2] * v[j][2] + v[j][3] * v[j][3]; }
      const float rstd = 1.f / sqrtf(wave_sum(s) * (1.f / 1024.f) + 1e-6f);
#pragma unroll
      for (int j = 0; j < 4; ++j) { const f32x4 gg = *((const f32x4*)fg + lane + 64 * j); xr[64 * j] = v[j] * rstd * gg; }
    }
  }
}

__global__ void __launch_bounds__(512) mk_fwd(KP p) {
  __shared__ __attribute__((aligned(16))) unsigned char lds[49152 + 1024];
  __shared__ int s_unit;
  cg::grid_group grid = cg::this_grid();
  unsigned char* ws = p.ws;
  const int tid = otid(), lane = tid & 63, w = tid >> 6;
  const int G = gridDim.x, bid = blockIdx.x;
#define RUN(k) (p.ph_lo <= (k) && (k) < p.ph_hi)
#define SEAM(k) do { if (RUN(k) && RUN((k) + 1)) grid.sync(); } while (0)

  if (RUN(0)) {
    const int gt = bid * 512 + tid, ngt = G * 512;
    if (gt < 64) ((unsigned*)(ws + OFF_CTL))[gt] = 0u;
    for (int l = 0; l < 2; ++l) {
      bf16_t* Wc = (bf16_t*)(ws + OFF_WC + l * SZ_WC);
      if (l == 0) convT(p.in[3], 1024, 3488, Wc, 1024, NP, nullptr, gt, ngt);
      else { convT(p.in[3] + (size_t)1024 * 3488, 1024, 3488, Wc, 1024, 3488, nullptr, gt, ngt); convT(p.in[4], 1024, 32, Wc + (size_t)3488 * 1024, 1024, 96, nullptr, gt, ngt); }
      convT(p.in[5] + (size_t)l * 1024 * 1024, 1024, 1024, (bf16_t*)(ws + OFF_WO + l * SZ_WO), 1024, 1024, nullptr, gt, ngt);
      convT(p.in[8] + (size_t)l * 256 * 576, 256, 576, (bf16_t*)(ws + OFF_WUQ + l * SZ_WUQ), 256, 640, p.in[6] + l * 256, gt, ngt);
      convT(p.in[9] + (size_t)l * 128 * 768, 128, 768, (bf16_t*)(ws + OFF_WUKV + l * SZ_WUKV), 128, 768, p.in[7] + l * 128, gt, ngt);
      convT(p.in[15] + (size_t)l * 64 * 384, 64, 384, (bf16_t*)(ws + OFF_W2 + l * SZ_L), 64, 384, nullptr, gt, ngt);
      convT(p.in[17] + (size_t)l * 64 * 384, 64, 384, (bf16_t*)(ws + OFF_A2 + l * SZ_L), 64, 384, nullptr, gt, ngt);
    }
    convT(p.in[19], 32, 384, (bf16_t*)(ws + OFF_V2), 64, 384, nullptr, gt, ngt);
    {
      float* tab = (float*)(ws + OFF_TAB); const int* pos = (const int*)p.in[1];
      for (int idx = gt; idx < 2048 * 16; idx += ngt) {
        const int s = idx >> 4, i = idx & 15;
        const float inv = exp2f(-(float)i * (13.287712379549449f / 16.f));
        const float ang = (float)pos[s] * inv;
        double rev = (double)ang * 0.15915494309189535; rev -= __builtin_rint(rev);
        tab[s * 32 + i] = __builtin_amdgcn_cosf((float)rev); tab[s * 32 + 16 + i] = __builtin_amdgcn_sinf((float)rev);
      }
    }
    norm_rows_bf16(p.in[0], p.in[2], (bf16_t*)(ws + OFF_R1), 0, T, bid * 8 + w, G * 8, lane);
  }
  SEAM(0);
  for (int l = 0; l < 2; ++l) {
    const int pb = 1 + 4 * l;
    if (RUN(pb)) {
      EpiRoute e{(bf16_t*)(ws + OFF_PA), (bf16_t*)(ws + OFF_R2), (bf16_t*)(ws + OFF_VTD), l ? 3520 : 3488};
      const bf16_t* hb = (const bf16_t*)(ws + OFF_R1); const bf16_t* Wc = (const bf16_t*)(ws + OFF_WC + l * SZ_WC);
      for (int u = bid; u < 256 * 28; u += G) { const int rt = u / 28, ct = u - rt * 28; gemm_tile(lds, hb, 1024, Wc, 1024, 1024, rt * 128, ct * 128, e); }
    }
    SEAM(pb);
    if (RUN(pb + 1)) { for (int rt = bid; rt < 256; rt += G) p2_unit(lds, p, l, rt); }
    SEAM(pb + 1);
    if (RUN(pb + 2)) {
      unsigned* ctr = (unsigned*)(ws + OFF_CTL) + 16 * (l + 1);
      const bf16_t* pA = (const bf16_t*)(ws + OFF_PA);
      const bf16_t* Qm = (const bf16_t*)(ws + OFF_R1); const bf16_t* Km = Qm + (size_t)T * 576;
      bf16_t* mixed = (bf16_t*)(ws + OFF_R2 + SZ_SC);
      const int* pos = (const int*)p.in[1];
      const float* lam = p.in[10] + l * 128;
      float d0 = 0.f, d1 = 0.f;
      for (int i = 0; i < 32; ++i) { d0 += lam[i] * lam[32 + i]; d1 += lam[64 + i] * lam[96 + i]; }
      const float lam_init = 0.8f - 0.6f * expf(-0.3f * (float)(l + 1));
      const float lam_full = expf(d0) - expf(d1) + lam_init;
      for (;;) {
        __syncthreads();
        if (tid == 0) s_unit = (int)atomicAdd(ctr, 1u);
        __syncthreads();
        const int u = s_unit;
        if (u >= 48 + 768 + 1024) break;
        if (u < 48) scan_unit(lds, p, u);
        else if (u < 48 + 768) {
          const int v = u - 48, qb = 7 - v / 96, bh = v % 96, b = bh / 6, h = bh - b * 6;
          attn_unit<false>(lds, Qm + (size_t)b * 2048 * 576 + h * 96, Km + (size_t)b * 2048 * 576 + h * 96, 576, (const bf16_t*)(ws + OFF_VTM) + (size_t)bh * 64 * 2048,
                           pA, mixed, pos, qb, h, b * 2048, 0.f, 0.f, nullptr);
        } else {
          const int v = u - 816, qb = 15 - v / 64, bh = v % 64, b = bh >> 2, h = bh & 3;
          attn_unit<true>(lds, pA + (size_t)b * 2048 * LDPA + h * 64, pA + (size_t)b * 2048 * LDPA + 256 + h * 64, LDPA, (const bf16_t*)(ws + OFF_VTD) + (size_t)bh * 64 * 2048,
                          pA, mixed, pos, qb, h, b * 2048, lam_full, lam_init, p.in[11] + l * 64);
        }
      }
    }
    SEAM(pb + 2);
    if (RUN(pb + 3)) { for (int rt = bid; rt < 256; rt += G) p4_unit(lds, p, l, rt); }
    SEAM(pb + 3);
  }
#undef RUN
#undef SEAM
}

extern "C" void kernel_launch(void* const* d_in, const int* in_sizes, int n_in, void* d_out, int out_size, void* d_ws, size_t ws_size, hipStream_t stream) {
  static int grid = 0;
  if (grid == 0) {
    if (n_in != 26 || ws_size < WS_END) { fprintf(stderr, "kernel_launch: need 26 inputs and %zu bytes of workspace (got %d, %zu)\n", (size_t)WS_END, n_in, ws_size); grid = -1; return; }
    int dev = 0, cus = 0, per_cu = 0;
    hipGetDevice(&dev);
    hipDeviceGetAttribute(&cus, hipDeviceAttributeMultiprocessorCount, dev);
    hipOccupancyMaxActiveBlocksPerMultiprocessor(&per_cu, (const void*)mk_fwd, 512, 0);
    if (per_cu < 1) { fprintf(stderr, "kernel_launch: occupancy query returned %d\n", per_cu); per_cu = 1; }
    grid = cus * per_cu;
  }
  if (grid < 0) return;
  KP p{};
  for (int i = 0; i < 26; ++i) p.in[i] = (const float*)d_in[i];
  p.out = (float*)d_out; p.ws = (unsigned char*)d_ws;
  if (MK_LAUNCHES == 1) {
    p.ph_lo = 0; p.ph_hi = NPHASE;
    void* args[] = {&p};
    hipError_t e = hipLaunchCooperativeKernel((const void*)mk_fwd, dim3(grid), dim3(512), args, 0, stream);
    if (e != hipSuccess) fprintf(stderr, "cooperative launch failed: %s (grid %d)\n", hipGetErrorString(e), grid);
  } else {
    for (int k = 0; k < NPHASE; ++k) { p.ph_lo = k; p.ph_hi = k + 1; hipLaunchKernelGGL(mk_fwd, dim3(grid), dim3(512), 0, stream, p); }
  }
}
```

```cpp
#include <hip/hip_runtime.h>
#include <hip/hip_cooperative_groups.h>
#include <cstdio>
#include <cstdint>
namespace cg = cooperative_groups;

#ifndef MK_LAUNCHES
#define MK_LAUNCHES 1
#endif

typedef unsigned short bf16_t;
typedef short bf16x8 __attribute__((ext_vector_type(8)));
typedef float f32x4 __attribute__((ext_vector_type(4)));
#define DI __device__ __forceinline__

constexpr int NB = 16, SEQ = 2048, T = NB * SEQ, DM = 1024;
constexpr int NP = 3584;
constexpr int LDPA = 1536;
constexpr int LDPB = 1728;
constexpr int NPHASE = 9;

constexpr size_t OFF_CTL = 0;
constexpr size_t OFF_TAB = 4096;
constexpr size_t SZ_WC = (size_t)NP * 1024 * 2;
constexpr size_t OFF_WC = OFF_TAB + 262144;
constexpr size_t SZ_WO = (size_t)1024 * 1024 * 2;
constexpr size_t OFF_WO = OFF_WC + 2 * SZ_WC;
constexpr size_t SZ_WUQ = (size_t)640 * 256 * 2;
constexpr size_t OFF_WUQ = OFF_WO + 2 * SZ_WO;
constexpr size_t SZ_WUKV = (size_t)768 * 128 * 2;
constexpr size_t OFF_WUKV = OFF_WUQ + 2 * SZ_WUQ;
constexpr size_t SZ_L = (size_t)384 * 64 * 2;
constexpr size_t OFF_W2 = OFF_WUKV + 2 * SZ_WUKV;
constexpr size_t OFF_A2 = OFF_W2 + 2 * SZ_L;
constexpr size_t OFF_V2 = OFF_A2 + 2 * SZ_L;
constexpr size_t OFF_R1 = OFF_V2 + SZ_L;
constexpr size_t SZ_QK = (size_t)T * 576 * 2;
constexpr size_t OFF_PA = OFF_R1 + 2 * SZ_QK;
constexpr size_t OFF_R2 = OFF_PA + (size_t)T * LDPA * 2;
constexpr size_t OFF_VTM = OFF_R2 + (size_t)T * LDPB * 2;
constexpr size_t OFF_VTD = OFF_VTM + (size_t)T * 384 * 2;
constexpr size_t SZ_SC = (size_t)T * 384 * 2;
constexpr size_t OFF_SC = OFF_VTD + (size_t)T * 256 * 2;
constexpr size_t OFF_LA = OFF_SC + 6 * SZ_SC;
constexpr size_t WS_END = OFF_LA + (size_t)T * 192 * 2;
static_assert(OFF_R1 % 256 == 0, "align");

struct KP { const float* in[26]; float* out; unsigned char* ws; int ph_lo, ph_hi; };

DI unsigned f2bf(float f) { unsigned u = __float_as_uint(f); return (u + 0x7fffu + ((u >> 16) & 1u)) >> 16; }
DI float bf2f(bf16_t h) { return __uint_as_float(((unsigned)h) << 16); }
DI unsigned pk2(float a, float b) { return f2bf(a) | (f2bf(b) << 16); }
DI void store4bf(bf16_t* p, f32x4 v) { uint2 u; u.x = pk2(v[0], v[1]); u.y = pk2(v[2], v[3]); *(uint2*)p = u; }
DI f32x4 up4(uint2 u) { f32x4 r; r[0] = __uint_as_float(u.x << 16); r[1] = __uint_as_float(u.x & 0xffff0000u); r[2] = __uint_as_float(u.y << 16); r[3] = __uint_as_float(u.y & 0xffff0000u); return r; }
DI f32x4 load4bf(const bf16_t* p) { return up4(*(const uint2*)p); }
DI float wave_sum(float v) {
#pragma unroll
  for (int o = 1; o < 64; o <<= 1) v += __shfl_xor(v, o);
  return v;
}
DI float ex2(float x) { return __builtin_amdgcn_exp2f(x); }
DI float fexp(float x) { return __builtin_amdgcn_exp2f(x * 1.4426950408889634f); }
DI float sigm(float x) { return 1.f / (1.f + fexp(-x)); }
DI float silu(float x) { return x / (1.f + fexp(-x)); }
template <int CTRL> DI float dppmov(float x) { return __builtin_bit_cast(float, __builtin_amdgcn_update_dpp(0, __builtin_bit_cast(int, x), CTRL, 0xF, 0xF, true)); }
DI float rowsum16(float x) {
  x += dppmov<0xB1>(x);
  x += dppmov<0x4E>(x);
  x += dppmov<0x124>(x);
  x += dppmov<0x128>(x);
  return x;
}
DI int otid() { int t = threadIdx.x; asm volatile("" : "+v"(t)); return t; }
#define MFMA16(a, b, c) __builtin_amdgcn_mfma_f32_16x16x32_bf16((a), (b), (c), 0, 0, 0)

template <class Epi>
DI void gemm_tile(unsigned char* lds, const bf16_t* __restrict__ A, int lda, const bf16_t* __restrict__ Bt, int ldb, int K, int row0, int col0, const Epi& epi) {
  bf16_t* sA = (bf16_t*)lds;
  bf16_t* sB = sA + 128 * 72;
  const int tid = otid(), lane = tid & 63, w = tid >> 6, wm = w >> 2, wn = w & 3, lr = lane & 15, g = lane >> 4;
  const int sr = tid >> 3, skc = tid & 7;
  const bf16_t* gA = A + (size_t)(row0 + sr) * lda + skc * 8;
  const bf16_t* gB = Bt + (size_t)(col0 + sr) * ldb + skc * 8;
  uint4 ra0, ra1, rb0, rb1;
  ra0 = *(const uint4*)(gA); ra1 = *(const uint4*)(gA + (size_t)64 * lda);
  rb0 = *(const uint4*)(gB); rb1 = *(const uint4*)(gB + (size_t)64 * ldb);
  f32x4 acc[4][2];
#pragma unroll
  for (int mi = 0; mi < 4; ++mi)
#pragma unroll
    for (int ni = 0; ni < 2; ++ni) acc[mi][ni] = (f32x4){0.f, 0.f, 0.f, 0.f};
  const int nk = K >> 6;
  for (int kt = 0; kt < nk; ++kt) {
    __syncthreads();
    *(uint4*)(sA + sr * 72 + skc * 8) = ra0; *(uint4*)(sA + (sr + 64) * 72 + skc * 8) = ra1;
    *(uint4*)(sB + sr * 72 + skc * 8) = rb0; *(uint4*)(sB + (sr + 64) * 72 + skc * 8) = rb1;
    __syncthreads();
    if (kt + 1 < nk) {
      const int k0 = (kt + 1) * 64;
      ra0 = *(const uint4*)(gA + k0); ra1 = *(const uint4*)(gA + (size_t)64 * lda + k0);
      rb0 = *(const uint4*)(gB + k0); rb1 = *(const uint4*)(gB + (size_t)64 * ldb + k0);
    }
#pragma unroll
    for (int ks = 0; ks < 2; ++ks) {
      bf16x8 af[4], bfr[2];
#pragma unroll
      for (int mi = 0; mi < 4; ++mi) af[mi] = *(const bf16x8*)(sA + (wm * 64 + mi * 16 + lr) * 72 + ks * 32 + g * 8);
#pragma unroll
      for (int ni = 0; ni < 2; ++ni) bfr[ni] = *(const bf16x8*)(sB + (wn * 32 + ni * 16 + lr) * 72 + ks * 32 + g * 8);
#pragma unroll
      for (int mi = 0; mi < 4; ++mi)
#pragma unroll
        for (int ni = 0; ni < 2; ++ni) acc[mi][ni] = MFMA16(bfr[ni], af[mi], acc[mi][ni]);
    }
  }
#pragma unroll
  for (int mi = 0; mi < 4; ++mi)
#pragma unroll
    for (int ni = 0; ni < 2; ++ni) epi(row0 + wm * 64 + mi * 16 + lr, col0 + wn * 32 + ni * 16 + 4 * g, acc[mi][ni]);
}

struct EpiRoute {
  bf16_t* pA; bf16_t* pB; bf16_t* VtD; int ncols;
  DI void operator()(int row, int col, f32x4 v) const {
    if (col >= ncols) return;
    if (col < 416) store4bf(pB + (size_t)row * LDPB + col, v);
    else if (col < 928) store4bf(pA + (size_t)row * LDPA + (col - 416), v);
    else if (col < 1184) {
      const int c = col - 928, h = c >> 6, dv = c & 63, b = row >> 11, s = row & 2047;
      bf16_t* q = VtD + ((size_t)((b * 4 + h) * 64 + dv)) * 2048 + s;
      q[0] = (bf16_t)f2bf(v[0]); q[2048] = (bf16_t)f2bf(v[1]); q[4096] = (bf16_t)f2bf(v[2]); q[6144] = (bf16_t)f2bf(v[3]);
    }
    else if (col < 2208) store4bf(pA + (size_t)row * LDPA + 512 + (col - 1184), v);
    else store4bf(pB + (size_t)row * LDPB + 416 + (col - 2208), v);
  }
};
struct EpiQ {
  bf16_t* Qm; const float* rs; int row0;
  DI void operator()(int row, int col, f32x4 v) const {
    if (col >= 576) return;
    const float r = rs[row - row0]; v = v * r;
    store4bf(Qm + (size_t)row * 576 + col, v);
  }
};
struct EpiKV {
  bf16_t* Km; bf16_t* VtM; const float* rs; int row0;
  DI void operator()(int row, int col, f32x4 v) const {
    const float r = rs[row - row0]; v = v * r;
    const int head = col >> 7, c = col & 127;
    if (c < 64) store4bf(Km + (size_t)row * 576 + head * 96 + c, v);
    else {
      const int b = row >> 11, s = row & 2047;
      bf16_t* q = VtM + ((size_t)((b * 6 + head) * 64 + (c - 64))) * 2048 + s;
      q[0] = (bf16_t)f2bf(v[0]); q[2048] = (bf16_t)f2bf(v[1]); q[4096] = (bf16_t)f2bf(v[2]); q[6144] = (bf16_t)f2bf(v[3]);
    }
  }
};
struct EpiW {
  bf16_t* wbuf; const float* w0;
  DI void operator()(int row, int col, f32x4 v) const {
    f32x4 o;
#pragma unroll
    for (int i = 0; i < 4; ++i) { const float val = v[i] + w0[col + i]; const float wv = -__logf(1.f + fexp(-val)) - 0.5f; o[i] = -fexp(wv); }
    store4bf(wbuf + (size_t)row * 384 + col, o);
  }
};
struct EpiA {
  bf16_t* abuf; bf16_t* kbuf; const float* a0; const float* ka;
  DI void operator()(int row, int col, f32x4 v) const {
    f32x4 kr = load4bf(kbuf + (size_t)row * 384 + col), a, kn;
#pragma unroll
    for (int i = 0; i < 4; ++i) { a[i] = sigm(v[i] + a0[col + i]); kn[i] = kr[i] * (1.f + (a[i] - 1.f) * ka[col + i]); }
    store4bf(abuf + (size_t)row * 384 + col, a);
    store4bf(kbuf + (size_t)row * 384 + col, kn);
  }
};
struct EpiV {
  bf16_t* vbuf; const bf16_t* pB; const float* v0; const float* mu;
  DI void operator()(int row, int col, f32x4 v) const {
    const int s = row & 2047;
    f32x4 p = load4bf(pB + (size_t)row * LDPB + 416 + 768 + col), pr = (f32x4){0.f, 0.f, 0.f, 0.f};
    if (s > 0) pr = load4bf(pB + (size_t)(row - 1) * LDPB + 416 + 768 + col);
    f32x4 vf = load4bf(vbuf + (size_t)row * 384 + col), o;
#pragma unroll
    for (int i = 0; i < 4; ++i) { const float xv = p[i] + (pr[i] - p[i]) * mu[768 + col + i]; const float sg = sigm(v[i] + v0[col + i]); o[i] = xv + (vf[i] - xv) * sg; }
    store4bf(vbuf + (size_t)row * 384 + col, o);
  }
};
struct EpiOut {
  const float* xin; float* xout;
  DI void operator()(int row, int col, f32x4 v) const {
    const f32x4 x = *(const f32x4*)(xin + (size_t)row * 1024 + col);
    *(f32x4*)(xout + (size_t)row * 1024 + col) = x + v;
  }
};

DI void convT(const float* __restrict__ src, int K, int N, bf16_t* dst, int Kpad, int NR, const float* scale, int gt, int ngt) {
  const int kcN = Kpad >> 3, total = NR * kcN;
  for (int idx = gt; idx < total; idx += ngt) {
    const int n = idx % NR, kc = idx / NR; uint4 o = {0u, 0u, 0u, 0u};
    if (n < N) {
      float v[8];
#pragma unroll
      for (int j = 0; j < 8; ++j) { const int k = kc * 8 + j; v[j] = (k < K) ? src[(size_t)k * N + n] * (scale ? scale[k] : 1.f) : 0.f; }
      o.x = pk2(v[0], v[1]); o.y = pk2(v[2], v[3]); o.z = pk2(v[4], v[5]); o.w = pk2(v[6], v[7]);
    }
    *(uint4*)(dst + (size_t)n * Kpad + kc * 8) = o;
  }
}
DI void norm_rows_bf16(const float* x, const float* gain, bf16_t* hb, int rbeg, int rend, int gw, int ngw, int lane) {
  for (int row = rbeg + gw; row < rend; row += ngw) {
    const f32x4* xr = (const f32x4*)(x + (size_t)row * 1024) + lane;
    f32x4 v[4]; float s = 0.f;
#pragma unroll
    for (int j = 0; j < 4; ++j) { v[j] = xr[64 * j]; s += v[j][0] * v[j][0] + v[j][1] * v[j][1] + v[j][2] * v[j][2] + v[j][3] * v[j][3]; }
    const float rstd = 1.f / sqrtf(wave_sum(s) * (1.f / 1024.f) + 1e-6f);
#pragma unroll
    for (int j = 0; j < 4; ++j) { const f32x4 gg = *((const f32x4*)gain + lane + 64 * j); store4bf(hb + (size_t)row * 1024 + 4 * lane + 256 * j, v[j] * rstd * gg); }
  }
}

DI void p2_unit(unsigned char* lds, const KP& p, int l, int rt) {
  unsigned char* ws = p.ws;
  const int tid = otid(), lane = tid & 63, w = tid >> 6, row0 = rt * 128;
  bf16_t* pB = (bf16_t*)(ws + OFF_R2);
  bf16_t* Qm = (bf16_t*)(ws + OFF_R1); bf16_t* Km = Qm + (size_t)T * 576;
  bf16_t* VtM = (bf16_t*)(ws + OFF_VTM);
  bf16_t* rbuf = (bf16_t*)(ws + OFF_SC); bf16_t* kbuf = rbuf + (size_t)T * 384; bf16_t* vbuf = kbuf + (size_t)T * 384;
  bf16_t* wbuf = vbuf + (size_t)T * 384; bf16_t* kkbuf = wbuf + (size_t)T * 384; bf16_t* abuf = kkbuf + (size_t)T * 384;
  bf16_t* LA = (bf16_t*)(ws + OFF_LA);
  const float* tab = (const float*)(ws + OFF_TAB);
  float* sRq = (float*)(lds + 36864); float* sRkv = sRq + 128;
  __syncthreads();
  {
    const int r = tid >> 2, part = tid & 3; const bf16_t* pr = pB + (size_t)(row0 + r) * LDPB;
    float sq = 0.f, sk = 0.f;
#pragma unroll
    for (int j = 0; j < 16; ++j) { f32x4 v = load4bf(pr + part * 64 + j * 4); sq += v[0] * v[0] + v[1] * v[1] + v[2] * v[2] + v[3] * v[3]; }
#pragma unroll
    for (int j = 0; j < 8; ++j) { f32x4 v = load4bf(pr + 256 + part * 32 + j * 4); sk += v[0] * v[0] + v[1] * v[1] + v[2] * v[2] + v[3] * v[3]; }
    sq += __shfl_xor(sq, 1); sq += __shfl_xor(sq, 2); sk += __shfl_xor(sk, 1); sk += __shfl_xor(sk, 2);
    if (part == 0) { sRq[r] = 1.f / sqrtf(sq * (1.f / 256.f) + 1e-6f); sRkv[r] = 1.f / sqrtf(sk * (1.f / 128.f) + 1e-6f); }
  }
  {
    const float* mu = p.in[12] + l * 1280; const float* kkw = p.in[20] + l * 384;
    for (int it = w; it < 128 * 6; it += 8) {
      const int t = it / 6, h = it - t * 6, row = row0 + t, s = row & 2047, col = h * 64 + lane;
      const bf16_t* pc = pB + (size_t)row * LDPB + 416 + col;
      float pr_ = bf2f(pc[0]), pk_ = bf2f(pc[384]), pv_ = bf2f(pc[768]), qr = 0.f, qk = 0.f, qv = 0.f;
      if (s > 0) { qr = bf2f(pc[-LDPB]); qk = bf2f(pc[384 - LDPB]); qv = bf2f(pc[768 - LDPB]); }
      const float xr = pr_ + (qr - pr_) * mu[col], xk = pk_ + (qk - pk_) * mu[384 + col], xv = pv_ + (qv - pv_) * mu[768 + col];
      const float kv_ = xk * kkw[col]; const float ss = wave_sum(kv_ * kv_);
      const float kk = kv_ / fmaxf(sqrtf(ss), 1e-12f);
      const size_t o = (size_t)row * 384 + col;
      rbuf[o] = (bf16_t)f2bf(xr); kbuf[o] = (bf16_t)f2bf(xk); kkbuf[o] = (bf16_t)f2bf(kk);
      if (l == 0) vbuf[o] = (bf16_t)f2bf(xv);
    }
    const float* muv = p.in[13];
    for (int idx = tid; idx < 128 * 192; idx += 512) {
      const int t = idx / 192, j = idx - t * 192, row = row0 + t, s = row & 2047;
      float val = 0.f;
      if (j < 128 || (j < 160 && l > 0)) {
        const int sc_ = 1152 + j;
        const float m = (j < 128) ? mu[sc_] : muv[j - 128];
        const bf16_t* pc = pB + (size_t)row * LDPB + 416 + sc_;
        const float a = bf2f(pc[0]), b = (s > 0) ? bf2f(pc[-LDPB]) : 0.f;
        val = a + (b - a) * m;
        if (j < 64) val = 1.f - 2.f / (fexp(2.f * val) + 1.f);
      }
      LA[(size_t)row * 192 + j] = (bf16_t)f2bf(val);
    }
  }
  __syncthreads();
  {
    const bf16_t* WuqT = (const bf16_t*)(ws + OFF_WUQ + l * SZ_WUQ);
    const bf16_t* WukvT = (const bf16_t*)(ws + OFF_WUKV + l * SZ_WUKV);
    EpiQ eq{Qm, sRq, row0};
    for (int ct = 0; ct < 5; ++ct) gemm_tile(lds, pB, LDPB, WuqT, 256, 256, row0, ct * 128, eq);
    EpiKV ek{Km, VtM, sRkv, row0};
    for (int ct = 0; ct < 6; ++ct) gemm_tile(lds, pB + 256, LDPB, WukvT, 128, 128, row0, ct * 128, ek);
  }
  {
    const bf16_t* w2T = (const bf16_t*)(ws + OFF_W2 + l * SZ_L);
    const bf16_t* a2T = (const bf16_t*)(ws + OFF_A2 + l * SZ_L);
    const bf16_t* v2T = (const bf16_t*)(ws + OFF_V2);
    EpiW ew{wbuf, p.in[14] + l * 384};
    for (int ct = 0; ct < 3; ++ct) gemm_tile(lds, LA, 192, w2T, 64, 64, row0, ct * 128, ew);
    EpiA ea{abuf, kbuf, p.in[16] + l * 384, p.in[21] + l * 384};
    for (int ct = 0; ct < 3; ++ct) gemm_tile(lds, LA + 64, 192, a2T, 64, 64, row0, ct * 128, ea);
    if (l > 0) {
      EpiV ev{vbuf, pB, p.in[18], p.in[12] + l * 1280};
      for (int ct = 0; ct < 3; ++ct) gemm_tile(lds, LA + 128, 192, v2T, 64, 64, row0, ct * 128, ev);
    }
  }
  __syncthreads();
  {
    for (int idx = tid; idx < 128 * 16; idx += 512) {
      const int r = idx >> 4, i = idx & 15, row = row0 + r, s = row & 2047;
      const float c = tab[s * 32 + i], sn = tab[s * 32 + 16 + i];
      bf16_t* q = Qm + (size_t)row * 576 + 64;
#pragma unroll
      for (int h = 0; h < 6; ++h) { const float t1 = bf2f(q[h * 96 + i]), t2 = bf2f(q[h * 96 + 16 + i]); q[h * 96 + i] = (bf16_t)f2bf(t1 * c - t2 * sn); q[h * 96 + 16 + i] = (bf16_t)f2bf(t1 * sn + t2 * c); }
      const float k1 = bf2f(pB[(size_t)row * LDPB + 384 + i]), k2 = bf2f(pB[(size_t)row * LDPB + 400 + i]);
      const bf16_t o1 = (bf16_t)f2bf(k1 * c - k2 * sn), o2 = (bf16_t)f2bf(k1 * sn + k2 * c);
      bf16_t* kq = Km + (size_t)row * 576 + 64;
#pragma unroll
      for (int h = 0; h < 6; ++h) { kq[h * 96 + i] = o1; kq[h * 96 + 16 + i] = o2; }
    }
  }
}

DI void scan_unit(unsigned char* lds, const KP& p, int unit) {
  unsigned char* ws = p.ws;
  float* sm = (float*)lds;
  const int tid = otid(), hsel = tid >> 8, th = tid & 255, lane = tid & 63, w16 = th >> 6, rg = lane >> 4, cg_ = lane & 15;
  const int hid = unit * 2 + hsel, b = hid / 6, h = hid - b * 6;
  const bf16_t* rbuf = (const bf16_t*)(ws + OFF_SC); const bf16_t* kbuf = rbuf + (size_t)T * 384; const bf16_t* vbuf = kbuf + (size_t)T * 384;
  const bf16_t* wbuf = vbuf + (size_t)T * 384; const bf16_t* kkbuf = wbuf + (size_t)T * 384; const bf16_t* abuf = kkbuf + (size_t)T * 384;
  bf16_t* ybuf = (bf16_t*)(ws + OFF_R2);
  const int st = th >> 4, sp = th & 15;
  const size_t gbase = ((size_t)b * 2048) * 384 + h * 64 + sp * 4;
  uint2 qw, qk, qkk, qa, qr, qv;
#define SCAN_LOAD(t0) do { const size_t o_ = gbase + (size_t)((t0) + st) * 384; qw = *(const uint2*)(wbuf + o_); qk = *(const uint2*)(kbuf + o_); qkk = *(const uint2*)(kkbuf + o_); \
    qa = *(const uint2*)(abuf + o_); qr = *(const uint2*)(rbuf + o_); qv = *(const uint2*)(vbuf + o_); } while (0)
  float S[4][4];
#pragma unroll
  for (int i = 0; i < 4; ++i)
#pragma unroll
    for (int c = 0; c < 4; ++c) S[i][c] = 0.f;
  SCAN_LOAD(0);
  float* mybase = sm + hsel * 6144;
  for (int ch = 0; ch < 128; ++ch) {
    __syncthreads();
    {
      float* d = mybase + st * 384 + sp * 4;
      const f32x4 fw = up4(qw), fk = up4(qk), fkk = up4(qkk), fa = up4(qa), fr = up4(qr), fv = up4(qv);
      f32x4 dec;
#pragma unroll
      for (int i = 0; i < 4; ++i) dec[i] = fexp(fw[i]);
      *(f32x4*)(d) = dec; *(f32x4*)(d + 64) = fk; *(f32x4*)(d + 128) = -fkk; *(f32x4*)(d + 192) = fkk * fa; *(f32x4*)(d + 256) = fr; *(f32x4*)(d + 320) = fv;
    }
    __syncthreads();
    if (ch + 1 < 128) SCAN_LOAD((ch + 1) * 16);
#pragma unroll 4
    for (int t = 0; t < 16; ++t) {
      const float* q = mybase + t * 384;
      const f32x4 w4 = *(const f32x4*)(q + 4 * cg_), k4 = *(const f32x4*)(q + 64 + 4 * cg_), a4 = *(const f32x4*)(q + 128 + 4 * cg_);
      const f32x4 b4 = *(const f32x4*)(q + 192 + 4 * cg_), r4 = *(const f32x4*)(q + 256 + 4 * cg_), v4 = *(const f32x4*)(q + 320 + w16 * 16 + rg * 4);
      f32x4 yv;
#pragma unroll
      for (int i = 0; i < 4; ++i) {
        float sa = S[i][0] * a4[0] + S[i][1] * a4[1] + S[i][2] * a4[2] + S[i][3] * a4[3];
        sa = rowsum16(sa);
        const float vi = v4[i];
#pragma unroll
        for (int c = 0; c < 4; ++c) S[i][c] = S[i][c] * w4[c] + (sa * b4[c] + vi * k4[c]);
        float y = S[i][0] * r4[0] + S[i][1] * r4[1] + S[i][2] * r4[2] + S[i][3] * r4[3];
        yv[i] = rowsum16(y);
      }
      if (cg_ == 0) store4bf(ybuf + ((size_t)(b * 2048 + ch * 16 + t)) * 384 + h * 64 + w16 * 16 + rg * 4, yv);
    }
  }
#undef SCAN_LOAD
}

template <bool DIFF>
DI void attn_unit(unsigned char* lds, const bf16_t* __restrict__ Qb, const bf16_t* __restrict__ Kb, int ld, const bf16_t* __restrict__ Vt,
                  const bf16_t* __restrict__ gate, bf16_t* mixed, const int* __restrict__ pos, int qb, int h, int rowb,
                  float lam_full, float lam_init, const float* __restrict__ gsub) {
  constexpr int KS = DIFF ? 1 : 3, NM = DIFF ? 2 : 1, KW = DIFF ? 72 : 104, NQT = DIFF ? 1 : 2, QU = 128 * NQT;
  bf16_t* sK = (bf16_t*)lds; bf16_t* sV = sK + 64 * KW;
  const int tid = otid(), lane = tid & 63, w = tid >> 6, lr = lane & 15, g = lane >> 4;
  const int q0 = qb * QU, qw0 = q0 + 16 * NQT * w;
  bf16x8 qf[NM][NQT][KS];
#pragma unroll
  for (int m = 0; m < NM; ++m)
#pragma unroll
    for (int qt = 0; qt < NQT; ++qt)
#pragma unroll
      for (int ks = 0; ks < KS; ++ks) qf[m][qt][ks] = *(const bf16x8*)(Qb + (size_t)(qw0 + 16 * qt + lr) * ld + m * 32 + ks * 32 + g * 8);
  f32x4 O[NM][4][NQT]; float mrun[NM][NQT], lrun[NM][NQT];
#pragma unroll
  for (int m = 0; m < NM; ++m)
#pragma unroll
    for (int qt = 0; qt < NQT; ++qt) { mrun[m][qt] = -INFINITY; lrun[m][qt] = 0.f;
#pragma unroll
      for (int dt = 0; dt < 4; ++dt) O[m][dt][qt] = (f32x4){0.f, 0.f, 0.f, 0.f}; }
  float posq[2] = {0.f, 0.f};
  if (DIFF) { posq[0] = (float)pos[qw0 + lr]; if (NQT > 1) posq[1] = (float)pos[qw0 + 16 + lr]; }
  const float sc = DIFF ? (0.17677669529663687f * 1.4426950408889634f) : (0.10206207261596575f * 1.4426950408889634f);
  const float slope2 = DIFF ? ex2(-2.f * (float)(h + 1)) * 1.4426950408889634f : 0.f;
  const int nkt = (q0 + QU) / 64;
  const int vr = tid >> 3, vc = tid & 7;
  int kr0, kc0, kr1 = 0, kc1 = 0;
  if (DIFF) { kr0 = tid >> 3; kc0 = tid & 7; } else { kr0 = tid / 12; kc0 = tid - kr0 * 12; const int c1 = tid + 512; kr1 = c1 / 12; kc1 = c1 - kr1 * 12; }
  const bool two = (!DIFF) && (tid < 256);
  uint4 rk0, rk1 = {0u, 0u, 0u, 0u}, rv;
#define ATT_LOAD(j_) do { rk0 = *(const uint4*)(Kb + (size_t)(64 * (j_) + kr0) * ld + kc0 * 8); if (two) rk1 = *(const uint4*)(Kb + (size_t)(64 * (j_) + kr1) * ld + kc1 * 8); \
    rv = *(const uint4*)(Vt + (size_t)vr * 2048 + 64 * (j_) + vc * 8); } while (0)
  ATT_LOAD(0);
  for (int j = 0; j < nkt; ++j) {
    __syncthreads();
    *(uint4*)(sK + kr0 * KW + kc0 * 8) = rk0; if (two) *(uint4*)(sK + kr1 * KW + kc1 * 8) = rk1; *(uint4*)(sV + vr * 72 + vc * 8) = rv;
    __syncthreads();
    if (j + 1 < nkt) ATT_LOAD(j + 1);
    if (64 * j <= qw0 + 16 * NQT - 1) {
      const bool domask = (64 * j + 63 > qw0);
      int4 pk[4];
      if (DIFF) {
#pragma unroll
        for (int kt = 0; kt < 4; ++kt) pk[kt] = *(const int4*)(pos + 64 * j + 16 * kt + 4 * g);
      }
#pragma unroll
      for (int m = 0; m < NM; ++m) {
        f32x4 s[4][NQT];
#pragma unroll
        for (int kt = 0; kt < 4; ++kt) {
#pragma unroll
          for (int qt = 0; qt < NQT; ++qt) s[kt][qt] = (f32x4){0.f, 0.f, 0.f, 0.f};
#pragma unroll
          for (int ks = 0; ks < KS; ++ks) {
            const bf16x8 kf = *(const bf16x8*)(sK + (16 * kt + lr) * KW + m * 32 + ks * 32 + g * 8);
#pragma unroll
            for (int qt = 0; qt < NQT; ++qt) s[kt][qt] = MFMA16(kf, qf[m][qt][ks], s[kt][qt]);
          }
        }
#pragma unroll
        for (int kt = 0; kt < 4; ++kt)
#pragma unroll
          for (int qt = 0; qt < NQT; ++qt)
#pragma unroll
            for (int i = 0; i < 4; ++i) {
              float v = s[kt][qt][i] * sc;
              if (DIFF) { const int pki = (i == 0) ? pk[kt].x : (i == 1) ? pk[kt].y : (i == 2) ? pk[kt].z : pk[kt].w; v -= slope2 * fabsf(posq[qt] - (float)pki); }
              if (domask && (64 * j + 16 * kt + 4 * g + i > qw0 + 16 * qt + lr)) v = -INFINITY;
              s[kt][qt][i] = v;
            }
#pragma unroll
        for (int qt = 0; qt < NQT; ++qt) {
          float mx = -INFINITY;
#pragma unroll
          for (int kt = 0; kt < 4; ++kt)
#pragma unroll
            for (int i = 0; i < 4; ++i) mx = fmaxf(mx, s[kt][qt][i]);
          mx = fmaxf(mx, __shfl_xor(mx, 16)); mx = fmaxf(mx, __shfl_xor(mx, 32));
          const float mn = fmaxf(mrun[m][qt], mx), alpha = ex2(mrun[m][qt] - mn); mrun[m][qt] = mn;
          float ls = 0.f;
#pragma unroll
          for (int kt = 0; kt < 4; ++kt)
#pragma unroll
            for (int i = 0; i < 4; ++i) { const float pv = ex2(s[kt][qt][i] - mn); ls += pv; s[kt][qt][i] = pv; }
          lrun[m][qt] = lrun[m][qt] * alpha + ls;
#pragma unroll
          for (int dt = 0; dt < 4; ++dt) O[m][dt][qt] = O[m][dt][qt] * alpha;
        }
#pragma unroll
        for (int s2 = 0; s2 < 2; ++s2) {
          bf16x8 pf[NQT];
#pragma unroll
          for (int qt = 0; qt < NQT; ++qt) {
            uint4 u; u.x = pk2(s[2 * s2][qt][0], s[2 * s2][qt][1]); u.y = pk2(s[2 * s2][qt][2], s[2 * s2][qt][3]);
            u.z = pk2(s[2 * s2 + 1][qt][0], s[2 * s2 + 1][qt][1]); u.w = pk2(s[2 * s2 + 1][qt][2], s[2 * s2 + 1][qt][3]);
            pf[qt] = __builtin_bit_cast(bf16x8, u);
          }
#pragma unroll
          for (int dt = 0; dt < 4; ++dt) {
            const uint2 lo = *(const uint2*)(sV + (16 * dt + lr) * 72 + 32 * s2 + 4 * g), hi = *(const uint2*)(sV + (16 * dt + lr) * 72 + 32 * s2 + 16 + 4 * g);
            uint4 u; u.x = lo.x; u.y = lo.y; u.z = hi.x; u.w = hi.y;
            const bf16x8 vf = __builtin_bit_cast(bf16x8, u);
#pragma unroll
            for (int qt = 0; qt < NQT; ++qt) O[m][dt][qt] = MFMA16(vf, pf[qt], O[m][dt][qt]);
          }
        }
      }
    }
  }
#undef ATT_LOAD
#pragma unroll
  for (int qt = 0; qt < NQT; ++qt) {
    const size_t row = (size_t)rowb + qw0 + 16 * qt + lr;
    float inv[NM];
#pragma unroll
    for (int m = 0; m < NM; ++m) { float lt = lrun[m][qt]; lt += __shfl_xor(lt, 16); lt += __shfl_xor(lt, 32); inv[m] = 1.f / lt; }
    if (!DIFF) {
#pragma unroll
      for (int dt = 0; dt < 4; ++dt) {
        const int col = h * 64 + 16 * dt + 4 * g;
        const f32x4 gt = load4bf(gate + row * LDPA + 512 + col); f32x4 o = O[0][dt][qt] * inv[0];
#pragma unroll
        for (int i = 0; i < 4; ++i) o[i] *= silu(gt[i]);
        store4bf(mixed + row * 1024 + col, o);
      }
    } else {
      f32x4 o[4]; float ss = 0.f;
#pragma unroll
      for (int dt = 0; dt < 4; ++dt) { o[dt] = O[0][dt][qt] * inv[0] - O[NM - 1][dt][qt] * (lam_full * inv[NM - 1]); ss += o[dt][0] * o[dt][0] + o[dt][1] * o[dt][1] + o[dt][2] * o[dt][2] + o[dt][3] * o[dt][3]; }
      ss += __shfl_xor(ss, 16); ss += __shfl_xor(ss, 32);
      const float rs = (1.f / sqrtf(ss * (1.f / 64.f) + 1e-5f)) * (1.f - lam_init);
#pragma unroll
      for (int dt = 0; dt < 4; ++dt) {
        const int dvc = 16 * dt + 4 * g, col = h * 64 + dvc;
        const f32x4 gs = *(const f32x4*)(gsub + dvc); const f32x4 gt = load4bf(gate + row * LDPA + 512 + 384 + col);
        f32x4 r;
#pragma unroll
        for (int i = 0; i < 4; ++i) r[i] = o[dt][i] * rs * gs[i] * silu(gt[i]);
        store4bf(mixed + row * 1024 + 384 + col, r);
      }
    }
  }
}

DI void p4_unit(unsigned char* lds, const KP& p, int l, int rt) {
  unsigned char* ws = p.ws;
  const int tid = otid(), lane = tid & 63, w = tid >> 6, row0 = rt * 128;
  const bf16_t* rbuf = (const bf16_t*)(ws + OFF_SC); const bf16_t* kbuf = rbuf + (size_t)T * 384; const bf16_t* vbuf = kbuf + (size_t)T * 384;
  const bf16_t* ybuf = (const bf16_t*)(ws + OFF_R2); bf16_t* mixed = (bf16_t*)(ws + OFF_R2 + SZ_SC);
  const bf16_t* pA = (const bf16_t*)(ws + OFF_PA);
  const float* lnw = p.in[23] + l * 384; const float* lnb = p.in[24] + l * 384; const float* rk = p.in[22] + l * 384;
  for (int it = w; it < 128 * 6; it += 8) {
    const int t = it / 6, h = it - t * 6, row = row0 + t, col = h * 64 + lane; const size_t o = (size_t)row * 384 + col;
    const float y = bf2f(ybuf[o]), r = bf2f(rbuf[o]), k = bf2f(kbuf[o]), v = bf2f(vbuf[o]);
    const float mean = wave_sum(y) * (1.f / 64.f); const float d = y - mean; const float var = wave_sum(d * d) * (1.f / 64.f);
    const float dot = wave_sum(r * k * rk[col]);
    float outv = d * (1.f / sqrtf(var + 64e-5f)) * lnw[col] + lnb[col] + dot * v;
    const float gt = bf2f(pA[(size_t)row * LDPA + 512 + 640 + col]);
    mixed[(size_t)row * 1024 + 640 + col] = (bf16_t)f2bf(outv * silu(gt));
  }
  __syncthreads();
  const bf16_t* WoT = (const bf16_t*)(ws + OFF_WO + l * SZ_WO);
  EpiOut eo{l == 0 ? p.in[0] : p.out, p.out};
  for (int ct = 0; ct < 8; ++ct) gemm_tile(lds, mixed, 1024, WoT, 1024, 1024, row0, ct * 128, eo);
  __syncthreads();
  if (l == 0) norm_rows_bf16(p.out, p.in[2] + 1024, (bf16_t*)(ws + OFF_R1), row0, row0 + 128, w, 8, lane);
  else {
    const float* fg = p.in[25];
    for (int row = row0 + w; row < row0 + 128; row += 8) {
      f32x4* xr = (f32x4*)(p.out + (size_t)row * 1024) + lane;
      f32x4 v[4]; float s = 0.f;
#pragma unroll
      for (int j = 0; j < 4; ++j) { v[j] = xr[64 * j]; s += v[j][0] * v[j][0] + v[j][1] * v[j][1] + v[j][2] * v[j][2] + v[j][3] * v[j][3]; }
      const float rstd = 1.f / sqrtf(wave_sum(s) * (1.f / 1024.f) + 1e-6f);
#pragma unroll
      for (int j = 0; j < 4; ++j) { const f32x4 gg = *((const f32x4*)fg + lane + 64 * j); xr[64 * j] = v[j] * rstd * gg; }
    }
  }
}

__global__ void __launch_bounds__(512) mk_fwd(KP p) {
  __shared__ __attribute__((aligned(16))) unsigned char lds[49152 + 1024];
  __shared__ int s_unit;
  cg::grid_group grid = cg::this_grid();
  unsigned char* ws = p.ws;
  const int tid = otid(), lane = tid & 63, w = tid >> 6;
  const int G = gridDim.x, bid = blockIdx.x;
#define RUN(k) (p.ph_lo <= (k) && (k) < p.ph_hi)
#define SEAM(k) do { if (RUN(k) && RUN((k) + 1)) grid.sync(); } while (0)

  if (RUN(0)) {
    const int gt = bid * 512 + tid, ngt = G * 512;
    if (gt < 64) ((unsigned*)(ws + OFF_CTL))[gt] = 0u;
    for (int l = 0; l < 2; ++l) {
      bf16_t* Wc = (bf16_t*)(ws + OFF_WC + l * SZ_WC);
      if (l == 0) convT(p.in[3], 1024, 3488, Wc, 1024, NP, nullptr, gt, ngt);
      else { convT(p.in[3] + (size_t)1024 * 3488, 1024, 3488, Wc, 1024, 3488, nullptr, gt, ngt); convT(p.in[4], 1024, 32, Wc + (size_t)3488 * 1024, 1024, 96, nullptr, gt, ngt); }
      convT(p.in[5] + (size_t)l * 1024 * 1024, 1024, 1024, (bf16_t*)(ws + OFF_WO + l * SZ_WO), 1024, 1024, nullptr, gt, ngt);
      convT(p.in[8] + (size_t)l * 256 * 576, 256, 576, (bf16_t*)(ws + OFF_WUQ + l * SZ_WUQ), 256, 640, p.in[6] + l * 256, gt, ngt);
      convT(p.in[9] + (size_t)l * 128 * 768, 128, 768, (bf16_t*)(ws + OFF_WUKV + l * SZ_WUKV), 128, 768, p.in[7] + l * 128, gt, ngt);
      convT(p.in[15] + (size_t)l * 64 * 384, 64, 384, (bf16_t*)(ws + OFF_W2 + l * SZ_L), 64, 384, nullptr, gt, ngt);
      convT(p.in[17] + (size_t)l * 64 * 384, 64, 384, (bf16_t*)(ws + OFF_A2 + l * SZ_L), 64, 384, nullptr, gt, ngt);
    }
    convT(p.in[19], 32, 384, (bf16_t*)(ws + OFF_V2), 64, 384, nullptr, gt, ngt);
    {
      float* tab = (float*)(ws + OFF_TAB); const int* pos = (const int*)p.in[1];
      for (int idx = gt; idx < 2048 * 16; idx += ngt) {
        const int s = idx >> 4, i = idx & 15;
        const float inv = exp2f(-(float)i * (13.287712379549449f / 16.f));
        const float ang = (float)pos[s] * inv;
        double rev = (double)ang * 0.15915494309189535; rev -= __builtin_rint(rev);
        tab[s * 32 + i] = __builtin_amdgcn_cosf((float)rev); tab[s * 32 + 16 + i] = __builtin_amdgcn_sinf((float)rev);
      }
    }
    norm_rows_bf16(p.in[0], p.in[2], (bf16_t*)(ws + OFF_R1), 0, T, bid * 8 + w, G * 8, lane);
  }
  SEAM(0);
  for (int l = 0; l < 2; ++l) {
    const int pb = 1 + 4 * l;
    if (RUN(pb)) {
      EpiRoute e{(bf16_t*)(ws + OFF_PA), (bf16_t*)(ws + OFF_R2), (bf16_t*)(ws + OFF_VTD), l ? 3520 : 3488};
      const bf16_t* hb = (const bf16_t*)(ws + OFF_R1); const bf16_t* Wc = (const bf16_t*)(ws + OFF_WC + l * SZ_WC);
      for (int u = bid; u < 256 * 28; u += G) { const int rt = u / 28, ct = u - rt * 28; gemm_tile(lds, hb, 1024, Wc, 1024, 1024, rt * 128, ct * 128, e); }
    }
    SEAM(pb);
    if (RUN(pb + 1)) { for (int rt = bid; rt < 256; rt += G) p2_unit(lds, p, l, rt); }
    SEAM(pb + 1);
    if (RUN(pb + 2)) {
      unsigned* ctr = (unsigned*)(ws + OFF_CTL) + 16 * (l + 1);
      const bf16_t* pA = (const bf16_t*)(ws + OFF_PA);
      const bf16_t* Qm = (const bf16_t*)(ws + OFF_R1); const bf16_t* Km = Qm + (size_t)T * 576;
      bf16_t* mixed = (bf16_t*)(ws + OFF_R2 + SZ_SC);
      const int* pos = (const int*)p.in[1];
      const float* lam = p.in[10] + l * 128;
      float d0 = 0.f, d1 = 0.f;
      for (int i = 0; i < 32; ++i) { d0 += lam[i] * lam[32 + i]; d1 += lam[64 + i] * lam[96 + i]; }
      const float lam_init = 0.8f - 0.6f * expf(-0.3f * (float)(l + 1));
      const float lam_full = expf(d0) - expf(d1) + lam_init;
      for (;;) {
        __syncthreads();
        if (tid == 0) s_unit = (int)atomicAdd(ctr, 1u);
        __syncthreads();
        const int u = s_unit;
        if (u >= 48 + 768 + 1024) break;
        if (u < 48) scan_unit(lds, p, u);
        else if (u < 48 + 768) {
          const int v = u - 48, qb = 7 - v / 96, bh = v % 96, b = bh / 6, h = bh - b * 6;
          attn_unit<false>(lds, Qm + (size_t)b * 2048 * 576 + h * 96, Km + (size_t)b * 2048 * 576 + h * 96, 576, (const bf16_t*)(ws + OFF_VTM) + (size_t)bh * 64 * 2048,
                           pA, mixed, pos, qb, h, b * 2048, 0.f, 0.f, nullptr);
        } else {
          const int v = u - 816, qb = 15 - v / 64, bh = v % 64, b = bh >> 2, h = bh & 3;
          attn_unit<true>(lds, pA + (size_t)b * 2048 * LDPA + h * 64, pA + (size_t)b * 2048 * LDPA + 256 + h * 64, LDPA, (const bf16_t*)(ws + OFF_VTD) + (size_t)bh * 64 * 2048,
                          pA, mixed, pos, qb, h, b * 2048, lam_full, lam_init, p.in[11] + l * 64);
        }
      }
    }
    SEAM(pb + 2);
    if (RUN(pb + 3)) { for (int rt = bid; rt < 256; rt += G) p4_unit(lds, p, l, rt); }
    SEAM(pb + 3);
  }
#undef RUN
#undef SEAM
}

extern "C" void kernel_launch(void* const* d_in, const int* in_sizes, int n_in, void* d_out, int out_size, void* d_ws, size_t ws_size, hipStream_t stream) {
  static int grid = 0;
  if (grid == 0) {
    if (n_in != 26 || ws_size < WS_END) { fprintf(stderr, "kernel_launch: need 26 inputs and %zu bytes of workspace (got %d, %zu)\n", (size_t)WS_END, n_in, ws_size); grid = -1; return; }
    int dev = 0, cus = 0, per_cu = 0;
    hipGetDevice(&dev);
    hipDeviceGetAttribute(&cus, hipDeviceAttributeMultiprocessorCount, dev);
    hipOccupancyMaxActiveBlocksPerMultiprocessor(&per_cu, (const void*)mk_fwd, 512, 0);
    if (per_cu < 1) { fprintf(stderr, "kernel_launch: occupancy query returned %d\n", per_cu); per_cu = 1; }
    grid = cus * per_cu;
  }
  if (grid < 0) return;
  KP p{};
  for (int i = 0; i < 26; ++i) p.in[i] = (const float*)d_in[i];
  p.out = (float*)d_out; p.ws = (unsigned char*)d_ws;
  if (MK_LAUNCHES == 1) {
    p.ph_lo = 0; p.ph_hi = NPHASE;
    void* args[] = {&p};
    hipError_t e = hipLaunchCooperativeKernel((const void*)mk_fwd, dim3(grid), dim3(512), args, 0, stream);
    if (e != hipSuccess) fprintf(stderr, "cooperative launch failed: %s (grid %d)\n", hipGetErrorString(e), grid);
  } else {
    for (int k = 0; k < NPHASE; ++k) { p.ph_lo = k; p.ph_hi = k + 1; hipLaunchKernelGGL(mk_fwd, dim3(grid), dim3(512), 0, stream, p); }
  }
}
```

```cpp
#include <hip/hip_runtime.h>
#include <hip/hip_cooperative_groups.h>
#include <cstdio>
#include <cstdint>
namespace cg = cooperative_groups;

#ifndef PROBE
#define PROBE 0
#endif
#ifndef MK_LAUNCHES
#define MK_LAUNCHES 1
#endif

typedef unsigned short bf16_t;
typedef short bf16x8 __attribute__((ext_vector_type(8)));
typedef float f32x4 __attribute__((ext_vector_type(4)));
#define DI __device__ __forceinline__

constexpr int NB = 16, SEQ = 2048, T = NB * SEQ, DM = 1024;
constexpr int NP = 3584;
constexpr int LDPA = 1536;
constexpr int LDPB = 1728;
constexpr int NPHASE = 9;
constexpr int NTH = 256;
constexpr int NSCAN = 192, NMLA = 96 * 16, NDIFF = 64 * 32, NATT = NMLA + NDIFF;

constexpr size_t OFF_CTL = 0;
constexpr size_t OFF_TAB = 4096;
constexpr size_t SZ_WC = (size_t)NP * 1024 * 2;
constexpr size_t OFF_WC = OFF_TAB + 262144;
constexpr size_t SZ_WO = (size_t)1024 * 1024 * 2;
constexpr size_t OFF_WO = OFF_WC + 2 * SZ_WC;
constexpr size_t SZ_WUQ = (size_t)640 * 256 * 2;
constexpr size_t OFF_WUQ = OFF_WO + 2 * SZ_WO;
constexpr size_t SZ_WUKV = (size_t)768 * 128 * 2;
constexpr size_t OFF_WUKV = OFF_WUQ + 2 * SZ_WUQ;
constexpr size_t SZ_L = (size_t)384 * 64 * 2;
constexpr size_t OFF_W2 = OFF_WUKV + 2 * SZ_WUKV;
constexpr size_t OFF_A2 = OFF_W2 + 2 * SZ_L;
constexpr size_t OFF_V2 = OFF_A2 + 2 * SZ_L;
constexpr size_t OFF_R1 = OFF_V2 + SZ_L;
constexpr size_t SZ_QK = (size_t)T * 576 * 2;
constexpr size_t OFF_PA = OFF_R1 + 2 * SZ_QK;
constexpr size_t OFF_R2 = OFF_PA + (size_t)T * LDPA * 2;
constexpr size_t OFF_VTM = OFF_R2 + (size_t)T * LDPB * 2;
constexpr size_t OFF_VTD = OFF_VTM + (size_t)T * 384 * 2;
constexpr size_t SZ_SC = (size_t)T * 384 * 2;
constexpr size_t OFF_SC = OFF_VTD + (size_t)T * 256 * 2;
constexpr size_t OFF_LA = OFF_SC + 6 * SZ_SC;
constexpr size_t OFF_CU = OFF_LA + (size_t)T * 192 * 2;
constexpr size_t WS_END = OFF_CU + 2 * 4096 * 4;
static_assert(OFF_R1 % 256 == 0, "align");

struct KP { const float* in[26]; float* out; unsigned char* ws; int ph_lo, ph_hi; };

DI unsigned f2bf(float f) { unsigned u = __float_as_uint(f); return (u + 0x7fffu + ((u >> 16) & 1u)) >> 16; }
DI float bf2f(bf16_t h) { return __uint_as_float(((unsigned)h) << 16); }
DI unsigned pk2(float a, float b) { return f2bf(a) | (f2bf(b) << 16); }
DI void store4bf(bf16_t* p, f32x4 v) { uint2 u; u.x = pk2(v[0], v[1]); u.y = pk2(v[2], v[3]); *(uint2*)p = u; }
DI f32x4 up4(uint2 u) { f32x4 r; r[0] = __uint_as_float(u.x << 16); r[1] = __uint_as_float(u.x & 0xffff0000u); r[2] = __uint_as_float(u.y << 16); r[3] = __uint_as_float(u.y & 0xffff0000u); return r; }
DI f32x4 load4bf(const bf16_t* p) { return up4(*(const uint2*)p); }
DI float wave_sum(float v) {
#pragma unroll
  for (int o = 1; o < 64; o <<= 1) v += __shfl_xor(v, o);
  return v;
}
DI float ex2(float x) { return __builtin_amdgcn_exp2f(x); }
DI float fexp(float x) { return __builtin_amdgcn_exp2f(x * 1.4426950408889634f); }
DI float sigm(float x) { return 1.f / (1.f + fexp(-x)); }
DI float silu(float x) { return x / (1.f + fexp(-x)); }
template <int CTRL> DI float dppmov(float x) { return __builtin_bit_cast(float, __builtin_amdgcn_update_dpp(0, __builtin_bit_cast(int, x), CTRL, 0xF, 0xF, true)); }
DI float rowsum16(float x) {
  x += dppmov<0xB1>(x);
  x += dppmov<0x4E>(x);
  x += dppmov<0x124>(x);
  x += dppmov<0x128>(x);
  return x;
}
DI int otid() { int t = threadIdx.x; asm volatile("" : "+v"(t)); return t; }
#define MFMA16(a, b, c) __builtin_amdgcn_mfma_f32_16x16x32_bf16((a), (b), (c), 0, 0, 0)

template <int MI, class Epi>
DI void gemm_tile(unsigned char* lds, const bf16_t* __restrict__ A, int lda, const bf16_t* __restrict__ Bt, int ldb, int K, int row0, int col0, const Epi& epi) {
  constexpr int BM = 32 * MI;
  bf16_t* sA = (bf16_t*)lds;
  bf16_t* sB = sA + BM * 72;
  const int tid = otid(), lane = tid & 63, w = tid >> 6, wm = w >> 1, wn = w & 1, lr = lane & 15, g = lane >> 4;
  const int sr = tid >> 3, skc = tid & 7;
  const bf16_t* gA = A + (size_t)(row0 + sr) * lda + skc * 8;
  const bf16_t* gB = Bt + (size_t)(col0 + sr) * ldb + skc * 8;
  uint4 ra0, ra1, ra2 = {0u, 0u, 0u, 0u}, ra3 = {0u, 0u, 0u, 0u}, rb0, rb1, rb2, rb3;
#define G_LOAD(k0_) do { ra0 = *(const uint4*)(gA + (k0_)); ra1 = *(const uint4*)(gA + (size_t)32 * lda + (k0_)); \
    if (MI == 4) { ra2 = *(const uint4*)(gA + (size_t)64 * lda + (k0_)); ra3 = *(const uint4*)(gA + (size_t)96 * lda + (k0_)); } \
    rb0 = *(const uint4*)(gB + (k0_)); rb1 = *(const uint4*)(gB + (size_t)32 * ldb + (k0_)); rb2 = *(const uint4*)(gB + (size_t)64 * ldb + (k0_)); rb3 = *(const uint4*)(gB + (size_t)96 * ldb + (k0_)); } while (0)
  G_LOAD(0);
  f32x4 acc[MI][4];
#pragma unroll
  for (int mi = 0; mi < MI; ++mi)
#pragma unroll
    for (int ni = 0; ni < 4; ++ni) acc[mi][ni] = (f32x4){0.f, 0.f, 0.f, 0.f};
  const int nk = K >> 6;
  for (int kt = 0; kt < nk; ++kt) {
    __syncthreads();
    *(uint4*)(sA + sr * 72 + skc * 8) = ra0; *(uint4*)(sA + (sr + 32) * 72 + skc * 8) = ra1;
    if (MI == 4) { *(uint4*)(sA + (sr + 64) * 72 + skc * 8) = ra2; *(uint4*)(sA + (sr + 96) * 72 + skc * 8) = ra3; }
    *(uint4*)(sB + sr * 72 + skc * 8) = rb0; *(uint4*)(sB + (sr + 32) * 72 + skc * 8) = rb1; *(uint4*)(sB + (sr + 64) * 72 + skc * 8) = rb2; *(uint4*)(sB + (sr + 96) * 72 + skc * 8) = rb3;
    __syncthreads();
    if (kt + 1 < nk) G_LOAD((kt + 1) * 64);
#pragma unroll
    for (int ks = 0; ks < 2; ++ks) {
      bf16x8 af[MI], bfr[4];
#pragma unroll
      for (int mi = 0; mi < MI; ++mi) af[mi] = *(const bf16x8*)(sA + (wm * 16 * MI + mi * 16 + lr) * 72 + ks * 32 + g * 8);
#pragma unroll
      for (int ni = 0; ni < 4; ++ni) bfr[ni] = *(const bf16x8*)(sB + (wn * 64 + ni * 16 + lr) * 72 + ks * 32 + g * 8);
#pragma unroll
      for (int mi = 0; mi < MI; ++mi)
#pragma unroll
        for (int ni = 0; ni < 4; ++ni) acc[mi][ni] = MFMA16(bfr[ni], af[mi], acc[mi][ni]);
    }
  }
#pragma unroll
  for (int mi = 0; mi < MI; ++mi)
#pragma unroll
    for (int ni = 0; ni < 4; ++ni) epi(row0 + wm * 16 * MI + mi * 16 + lr, col0 + wn * 64 + ni * 16 + 4 * g, acc[mi][ni]);
#undef G_LOAD
}

struct EpiRoute {
  bf16_t* pA; bf16_t* pB; bf16_t* VtD; int ncols;
  DI void operator()(int row, int col, f32x4 v) const {
    if (col >= ncols) return;
    if (col < 416) store4bf(pB + (size_t)row * LDPB + col, v);
    else if (col < 928) store4bf(pA + (size_t)row * LDPA + (col - 416), v);
    else if (col < 1184) {
      const int c = col - 928, h = c >> 6, dv = c & 63, b = row >> 11, s = row & 2047;
      bf16_t* q = VtD + ((size_t)((b * 4 + h) * 64 + dv)) * 2048 + s;
      q[0] = (bf16_t)f2bf(v[0]); q[2048] = (bf16_t)f2bf(v[1]); q[4096] = (bf16_t)f2bf(v[2]); q[6144] = (bf16_t)f2bf(v[3]);
    }
    else if (col < 2208) store4bf(pA + (size_t)row * LDPA + 512 + (col - 1184), v);
    else store4bf(pB + (size_t)row * LDPB + 416 + (col - 2208), v);
  }
};
struct EpiQ {
  bf16_t* Qm; const float* rs; int row0;
  DI void operator()(int row, int col, f32x4 v) const {
    if (col >= 576) return;
    const float r = rs[row - row0]; v = v * r;
    store4bf(Qm + (size_t)row * 576 + col, v);
  }
};
struct EpiKV {
  bf16_t* Km; bf16_t* VtM; const float* rs; int row0;
  DI void operator()(int row, int col, f32x4 v) const {
    const float r = rs[row - row0]; v = v * r;
    const int head = col >> 7, c = col & 127;
    if (c < 64) store4bf(Km + (size_t)row * 576 + head * 96 + c, v);
    else {
      const int b = row >> 11, s = row & 2047;
      bf16_t* q = VtM + ((size_t)((b * 6 + head) * 64 + (c - 64))) * 2048 + s;
      q[0] = (bf16_t)f2bf(v[0]); q[2048] = (bf16_t)f2bf(v[1]); q[4096] = (bf16_t)f2bf(v[2]); q[6144] = (bf16_t)f2bf(v[3]);
    }
  }
};
struct EpiW {
  bf16_t* wbuf; const float* w0;
  DI void operator()(int row, int col, f32x4 v) const {
    f32x4 o;
#pragma unroll
    for (int i = 0; i < 4; ++i) { const float val = v[i] + w0[col + i]; const float wv = -__logf(1.f + fexp(-val)) - 0.5f; o[i] = -fexp(wv); }
    store4bf(wbuf + (size_t)row * 384 + col, o);
  }
};
struct EpiA {
  bf16_t* abuf; bf16_t* kbuf; const float* a0; const float* ka;
  DI void operator()(int row, int col, f32x4 v) const {
    f32x4 kr = load4bf(kbuf + (size_t)row * 384 + col), a, kn;
#pragma unroll
    for (int i = 0; i < 4; ++i) { a[i] = sigm(v[i] + a0[col + i]); kn[i] = kr[i] * (1.f + (a[i] - 1.f) * ka[col + i]); }
    store4bf(abuf + (size_t)row * 384 + col, a);
    store4bf(kbuf + (size_t)row * 384 + col, kn);
  }
};
struct EpiV {
  bf16_t* vbuf; const bf16_t* pB; const float* v0; const float* mu;
  DI void operator()(int row, int col, f32x4 v) const {
    const int s = row & 2047;
    f32x4 p = load4bf(pB + (size_t)row * LDPB + 416 + 768 + col), pr = (f32x4){0.f, 0.f, 0.f, 0.f};
    if (s > 0) pr = load4bf(pB + (size_t)(row - 1) * LDPB + 416 + 768 + col);
    f32x4 vf = load4bf(vbuf + (size_t)row * 384 + col), o;
#pragma unroll
    for (int i = 0; i < 4; ++i) { const float xv = p[i] + (pr[i] - p[i]) * mu[768 + col + i]; const float sg = sigm(v[i] + v0[col + i]); o[i] = xv + (vf[i] - xv) * sg; }
    store4bf(vbuf + (size_t)row * 384 + col, o);
  }
};
struct EpiOut {
  const float* xin; float* xout;
  DI void operator()(int row, int col, f32x4 v) const {
    const f32x4 x = *(const f32x4*)(xin + (size_t)row * 1024 + col);
    *(f32x4*)(xout + (size_t)row * 1024 + col) = x + v;
  }
};

DI void convT(const float* __restrict__ src, int K, int N, bf16_t* dst, int Kpad, int NR, const float* scale, int gt, int ngt) {
  const int kcN = Kpad >> 3, total = NR * kcN;
  for (int idx = gt; idx < total; idx += ngt) {
    const int n = idx % NR, kc = idx / NR; uint4 o = {0u, 0u, 0u, 0u};
    if (n < N) {
      float v[8];
#pragma unroll
      for (int j = 0; j < 8; ++j) { const int k = kc * 8 + j; v[j] = (k < K) ? src[(size_t)k * N + n] * (scale ? scale[k] : 1.f) : 0.f; }
      o.x = pk2(v[0], v[1]); o.y = pk2(v[2], v[3]); o.z = pk2(v[4], v[5]); o.w = pk2(v[6], v[7]);
    }
    *(uint4*)(dst + (size_t)n * Kpad + kc * 8) = o;
  }
}
DI void norm_rows_bf16(const float* x, const float* gain, bf16_t* hb, int rbeg, int rend, int gw, int ngw, int lane) {
  for (int row = rbeg + gw; row < rend; row += ngw) {
    const f32x4* xr = (const f32x4*)(x + (size_t)row * 1024) + lane;
    f32x4 v[4]; float s = 0.f;
#pragma unroll
    for (int j = 0; j < 4; ++j) { v[j] = xr[64 * j]; s += v[j][0] * v[j][0] + v[j][1] * v[j][1] + v[j][2] * v[j][2] + v[j][3] * v[j][3]; }
    const float rstd = 1.f / sqrtf(wave_sum(s) * (1.f / 1024.f) + 1e-6f);
#pragma unroll
    for (int j = 0; j < 4; ++j) { const f32x4 gg = *((const f32x4*)gain + lane + 64 * j); store4bf(hb + (size_t)row * 1024 + 4 * lane + 256 * j, v[j] * rstd * gg); }
  }
}

DI void p2_unit(unsigned char* lds, const KP& p, int l, int rt) {
  unsigned char* ws = p.ws;
  const int tid = otid(), lane = tid & 63, w = tid >> 6, row0 = rt * 64;
  bf16_t* pB = (bf16_t*)(ws + OFF_R2);
  bf16_t* Qm = (bf16_t*)(ws + OFF_R1); bf16_t* Km = Qm + (size_t)T * 576;
  bf16_t* VtM = (bf16_t*)(ws + OFF_VTM);
  bf16_t* rbuf = (bf16_t*)(ws + OFF_SC); bf16_t* kbuf = rbuf + (size_t)T * 384; bf16_t* vbuf = kbuf + (size_t)T * 384;
  bf16_t* wbuf = vbuf + (size_t)T * 384; bf16_t* kkbuf = wbuf + (size_t)T * 384; bf16_t* abuf = kkbuf + (size_t)T * 384;
  bf16_t* LA = (bf16_t*)(ws + OFF_LA);
  const float* tab = (const float*)(ws + OFF_TAB);
  float* sRq = (float*)(lds + 36864); float* sRkv = sRq + 64;
  __syncthreads();
  {
    const int r = tid >> 2, part = tid & 3; const bf16_t* pr = pB + (size_t)(row0 + r) * LDPB;
    float sq = 0.f, sk = 0.f;
#pragma unroll
    for (int j = 0; j < 16; ++j) { f32x4 v = load4bf(pr + part * 64 + j * 4); sq += v[0] * v[0] + v[1] * v[1] + v[2] * v[2] + v[3] * v[3]; }
#pragma unroll
    for (int j = 0; j < 8; ++j) { f32x4 v = load4bf(pr + 256 + part * 32 + j * 4); sk += v[0] * v[0] + v[1] * v[1] + v[2] * v[2] + v[3] * v[3]; }
    sq += __shfl_xor(sq, 1); sq += __shfl_xor(sq, 2); sk += __shfl_xor(sk, 1); sk += __shfl_xor(sk, 2);
    if (part == 0) { sRq[r] = 1.f / sqrtf(sq * (1.f / 256.f) + 1e-6f); sRkv[r] = 1.f / sqrtf(sk * (1.f / 128.f) + 1e-6f); }
  }
  {
    const float* mu = p.in[12] + l * 1280; const float* kkw = p.in[20] + l * 384;
    for (int it = w; it < 64 * 6; it += 4) {
      const int t = it / 6, h = it - t * 6, row = row0 + t, s = row & 2047, col = h * 64 + lane;
      const bf16_t* pc = pB + (size_t)row * LDPB + 416 + col;
      float pr_ = bf2f(pc[0]), pk_ = bf2f(pc[384]), pv_ = bf2f(pc[768]), qr = 0.f, qk = 0.f, qv = 0.f;
      if (s > 0) { qr = bf2f(pc[-LDPB]); qk = bf2f(pc[384 - LDPB]); qv = bf2f(pc[768 - LDPB]); }
      const float xr = pr_ + (qr - pr_) * mu[col], xk = pk_ + (qk - pk_) * mu[384 + col], xv = pv_ + (qv - pv_) * mu[768 + col];
      const float kv_ = xk * kkw[col]; const float ss = wave_sum(kv_ * kv_);
      const float kk = kv_ / fmaxf(sqrtf(ss), 1e-12f);
      const size_t o = (size_t)row * 384 + col;
      rbuf[o] = (bf16_t)f2bf(xr); kbuf[o] = (bf16_t)f2bf(xk); kkbuf[o] = (bf16_t)f2bf(kk);
      if (l == 0) vbuf[o] = (bf16_t)f2bf(xv);
    }
    const float* muv = p.in[13];
    for (int idx = tid; idx < 64 * 192; idx += NTH) {
      const int t = idx / 192, j = idx - t * 192, row = row0 + t, s = row & 2047;
      float val = 0.f;
      if (j < 128 || (j < 160 && l > 0)) {
        const int sc_ = 1152 + j;
        const float m = (j < 128) ? mu[sc_] : muv[j - 128];
        const bf16_t* pc = pB + (size_t)row * LDPB + 416 + sc_;
        const float a = bf2f(pc[0]), b = (s > 0) ? bf2f(pc[-LDPB]) : 0.f;
        val = a + (b - a) * m;
        if (j < 64) val = 1.f - 2.f / (fexp(2.f * val) + 1.f);
      }
      LA[(size_t)row * 192 + j] = (bf16_t)f2bf(val);
    }
  }
  __syncthreads();
  {
    const bf16_t* WuqT = (const bf16_t*)(ws + OFF_WUQ + l * SZ_WUQ);
    const bf16_t* WukvT = (const bf16_t*)(ws + OFF_WUKV + l * SZ_WUKV);
    EpiQ eq{Qm, sRq, row0};
    for (int ct = 0; ct < 5; ++ct) gemm_tile<2>(lds, pB, LDPB, WuqT, 256, 256, row0, ct * 128, eq);
    EpiKV ek{Km, VtM, sRkv, row0};
    for (int ct = 0; ct < 6; ++ct) gemm_tile<2>(lds, pB + 256, LDPB, WukvT, 128, 128, row0, ct * 128, ek);
  }
  {
    const bf16_t* w2T = (const bf16_t*)(ws + OFF_W2 + l * SZ_L);
    const bf16_t* a2T = (const bf16_t*)(ws + OFF_A2 + l * SZ_L);
    const bf16_t* v2T = (const bf16_t*)(ws + OFF_V2);
    EpiW ew{wbuf, p.in[14] + l * 384};
    for (int ct = 0; ct < 3; ++ct) gemm_tile<2>(lds, LA, 192, w2T, 64, 64, row0, ct * 128, ew);
    EpiA ea{abuf, kbuf, p.in[16] + l * 384, p.in[21] + l * 384};
    for (int ct = 0; ct < 3; ++ct) gemm_tile<2>(lds, LA + 64, 192, a2T, 64, 64, row0, ct * 128, ea);
    if (l > 0) {
      EpiV ev{vbuf, pB, p.in[18], p.in[12] + l * 1280};
      for (int ct = 0; ct < 3; ++ct) gemm_tile<2>(lds, LA + 128, 192, v2T, 64, 64, row0, ct * 128, ev);
    }
  }
  __syncthreads();
  {
    for (int idx = tid; idx < 64 * 16; idx += NTH) {
      const int r = idx >> 4, i = idx & 15, row = row0 + r, s = row & 2047;
      const float c = tab[s * 32 + i], sn = tab[s * 32 + 16 + i];
      bf16_t* q = Qm + (size_t)row * 576 + 64;
#pragma unroll
      for (int h = 0; h < 6; ++h) { const float t1 = bf2f(q[h * 96 + i]), t2 = bf2f(q[h * 96 + 16 + i]); q[h * 96 + i] = (bf16_t)f2bf(t1 * c - t2 * sn); q[h * 96 + 16 + i] = (bf16_t)f2bf(t1 * sn + t2 * c); }
      const float k1 = bf2f(pB[(size_t)row * LDPB + 384 + i]), k2 = bf2f(pB[(size_t)row * LDPB + 400 + i]);
      const bf16_t o1 = (bf16_t)f2bf(k1 * c - k2 * sn), o2 = (bf16_t)f2bf(k1 * sn + k2 * c);
      bf16_t* kq = Km + (size_t)row * 576 + 64;
#pragma unroll
      for (int h = 0; h < 6; ++h) { kq[h * 96 + i] = o1; kq[h * 96 + 16 + i] = o2; }
    }
  }
}

DI void scan_unit(unsigned char* lds, const KP& p, int unit) {
  unsigned char* ws = p.ws;
  float* sm = (float*)lds;
  const int tid = otid(), lane = tid & 63, w16 = tid >> 6, rg = lane >> 4, cg_ = lane & 15;
  const int hid = unit >> 1, half = unit & 1, b = hid / 6, h = hid - b * 6;
  const bf16_t* rbuf = (const bf16_t*)(ws + OFF_SC); const bf16_t* kbuf = rbuf + (size_t)T * 384; const bf16_t* vbuf = kbuf + (size_t)T * 384;
  const bf16_t* wbuf = vbuf + (size_t)T * 384; const bf16_t* kkbuf = wbuf + (size_t)T * 384; const bf16_t* abuf = kkbuf + (size_t)T * 384;
  bf16_t* ybuf = (bf16_t*)(ws + OFF_R2);
  const int st = tid >> 4, sp = tid & 15;
  const size_t gbase = ((size_t)b * 2048) * 384 + h * 64 + sp * 4;
  uint2 qw, qk, qkk, qa, qr, qv;
#define SCAN_LOAD(t0) do { const size_t o_ = gbase + (size_t)((t0) + st) * 384; qw = *(const uint2*)(wbuf + o_); qk = *(const uint2*)(kbuf + o_); qkk = *(const uint2*)(kkbuf + o_); \
    qa = *(const uint2*)(abuf + o_); qr = *(const uint2*)(rbuf + o_); qv = *(const uint2*)(vbuf + o_); } while (0)
  f32x4 S0 = (f32x4){0.f, 0.f, 0.f, 0.f}, S1 = (f32x4){0.f, 0.f, 0.f, 0.f};
  SCAN_LOAD(0);
  const int rowoff = half * 32 + w16 * 8 + rg * 2;
  bf16_t* yout = ybuf + ((size_t)b * 2048) * 384 + h * 64 + rowoff;
  __builtin_amdgcn_s_setprio(3);
  for (int ch = 0; ch < 128; ++ch) {
    __syncthreads();
    {
      float* d = sm + st * 400 + sp * 4;
      const f32x4 fw = up4(qw), fk = up4(qk), fkk = up4(qkk), fa = up4(qa), fr = up4(qr), fv = up4(qv);
      f32x4 dec;
#pragma unroll
      for (int i = 0; i < 4; ++i) dec[i] = fexp(fw[i]);
      const f32x4 bp = fkk * fa;
      float be = bp[0] * fr[0] + bp[1] * fr[1] + bp[2] * fr[2] + bp[3] * fr[3];
      float ka = fk[0] * fr[0] + fk[1] * fr[1] + fk[2] * fr[2] + fk[3] * fr[3];
      be = rowsum16(be); ka = rowsum16(ka);
      *(f32x4*)(d) = dec; *(f32x4*)(d + 64) = fk; *(f32x4*)(d + 128) = -fkk; *(f32x4*)(d + 192) = bp; *(f32x4*)(d + 256) = dec * fr; *(f32x4*)(d + 320) = fv;
      if (sp == 0) { sm[st * 400 + 384] = be; sm[st * 400 + 385] = ka; }
    }
    __syncthreads();
    if (ch + 1 < 128) SCAN_LOAD((ch + 1) * 16);
#pragma unroll 4
    for (int t = 0; t < 16; ++t) {
      const float* q = sm + t * 400;
      const f32x4 w4 = *(const f32x4*)(q + 4 * cg_), k4 = *(const f32x4*)(q + 64 + 4 * cg_), a4 = *(const f32x4*)(q + 128 + 4 * cg_);
      const f32x4 b4 = *(const f32x4*)(q + 192 + 4 * cg_), r4 = *(const f32x4*)(q + 256 + 4 * cg_);
      const float v0 = q[320 + rowoff], v1 = q[321 + rowoff], be = q[384], ka = q[385];
      float sa0 = S0[0] * a4[0] + S0[1] * a4[1] + S0[2] * a4[2] + S0[3] * a4[3];
      float sa1 = S1[0] * a4[0] + S1[1] * a4[1] + S1[2] * a4[2] + S1[3] * a4[3];
      float y0 = S0[0] * r4[0] + S0[1] * r4[1] + S0[2] * r4[2] + S0[3] * r4[3];
      float y1 = S1[0] * r4[0] + S1[1] * r4[1] + S1[2] * r4[2] + S1[3] * r4[3];
      sa0 = rowsum16(sa0); sa1 = rowsum16(sa1); y0 = rowsum16(y0); y1 = rowsum16(y1);
      S0 = S0 * w4 + (b4 * sa0 + k4 * v0);
      S1 = S1 * w4 + (b4 * sa1 + k4 * v1);
      y0 += sa0 * be + v0 * ka; y1 += sa1 * be + v1 * ka;
      if (cg_ == 0) *(unsigned*)(yout + (size_t)(ch * 16 + t) * 384) = pk2(y0, y1);
    }
  }
  __builtin_amdgcn_s_setprio(0);
#undef SCAN_LOAD
}

template <bool DIFF>
DI void attn_unit(unsigned char* lds, const bf16_t* __restrict__ Qb, const bf16_t* __restrict__ Kb, int ld, const bf16_t* __restrict__ Vt,
                  const bf16_t* __restrict__ gate, bf16_t* mixed, const int* __restrict__ pos, int qb, int h, int rowb,
                  float lam_full, float lam_init, const float* __restrict__ gsub) {
  constexpr int KS = DIFF ? 1 : 3, NM = DIFF ? 2 : 1, KW = DIFF ? 72 : 104, NQT = DIFF ? 1 : 2, QU = 64 * NQT;
  bf16_t* sK = (bf16_t*)lds; bf16_t* sV = sK + 64 * KW;
  const int tid = otid(), lane = tid & 63, w = tid >> 6, lr = lane & 15, g = lane >> 4;
  const int q0 = qb * QU, qw0 = q0 + 16 * NQT * w;
  bf16x8 qf[NM][NQT][KS];
#pragma unroll
  for (int m = 0; m < NM; ++m)
#pragma unroll
    for (int qt = 0; qt < NQT; ++qt)
#pragma unroll
      for (int ks = 0; ks < KS; ++ks) qf[m][qt][ks] = *(const bf16x8*)(Qb + (size_t)(qw0 + 16 * qt + lr) * ld + m * 32 + ks * 32 + g * 8);
  f32x4 O[NM][4][NQT]; float mrun[NM][NQT], lrun[NM][NQT];
#pragma unroll
  for (int m = 0; m < NM; ++m)
#pragma unroll
    for (int qt = 0; qt < NQT; ++qt) { mrun[m][qt] = -INFINITY; lrun[m][qt] = 0.f;
#pragma unroll
      for (int dt = 0; dt < 4; ++dt) O[m][dt][qt] = (f32x4){0.f, 0.f, 0.f, 0.f}; }
  float posq[2] = {0.f, 0.f};
  if (DIFF) { posq[0] = (float)pos[qw0 + lr]; if (NQT > 1) posq[1] = (float)pos[qw0 + 16 + lr]; }
  const float sc = DIFF ? (0.17677669529663687f * 1.4426950408889634f) : (0.10206207261596575f * 1.4426950408889634f);
  const float slope2 = DIFF ? ex2(-2.f * (float)(h + 1)) * 1.4426950408889634f : 0.f;
  const int nkt = (q0 + QU) / 64;
  const int vr = tid >> 3, vc = tid & 7;
  int kr0, kc0, kr1, kc1, kr2 = 0, kc2 = 0;
  if (DIFF) { kr0 = vr; kc0 = vc; kr1 = vr + 32; kc1 = vc; }
  else { kr0 = tid / 12; kc0 = tid - kr0 * 12; kr1 = (tid + 256) / 12; kc1 = (tid + 256) - kr1 * 12; kr2 = (tid + 512) / 12; kc2 = (tid + 512) - kr2 * 12; }
  uint4 rk0, rk1, rk2 = {0u, 0u, 0u, 0u}, rv0, rv1;
#define ATT_LOAD(j_) do { rk0 = *(const uint4*)(Kb + (size_t)(64 * (j_) + kr0) * ld + kc0 * 8); rk1 = *(const uint4*)(Kb + (size_t)(64 * (j_) + kr1) * ld + kc1 * 8); \
    if (!DIFF) rk2 = *(const uint4*)(Kb + (size_t)(64 * (j_) + kr2) * ld + kc2 * 8); \
    rv0 = *(const uint4*)(Vt + (size_t)vr * 2048 + 64 * (j_) + vc * 8); rv1 = *(const uint4*)(Vt + (size_t)(vr + 32) * 2048 + 64 * (j_) + vc * 8); } while (0)
  ATT_LOAD(0);
  for (int j = 0; j < nkt; ++j) {
    __syncthreads();
    *(uint4*)(sK + kr0 * KW + kc0 * 8) = rk0; *(uint4*)(sK + kr1 * KW + kc1 * 8) = rk1; if (!DIFF) *(uint4*)(sK + kr2 * KW + kc2 * 8) = rk2;
    *(uint4*)(sV + vr * 72 + vc * 8) = rv0; *(uint4*)(sV + (vr + 32) * 72 + vc * 8) = rv1;
    __syncthreads();
    if (j + 1 < nkt) ATT_LOAD(j + 1);
    if (64 * j <= qw0 + 16 * NQT - 1) {
      const bool domask = (64 * j + 63 > qw0);
      int4 pk[4];
      if (DIFF) {
#pragma unroll
        for (int kt = 0; kt < 4; ++kt) pk[kt] = *(const int4*)(pos + 64 * j + 16 * kt + 4 * g);
      }
#pragma unroll
      for (int m = 0; m < NM; ++m) {
        f32x4 s[4][NQT];
#pragma unroll
        for (int kt = 0; kt < 4; ++kt) {
#pragma unroll
          for (int qt = 0; qt < NQT; ++qt) s[kt][qt] = (f32x4){0.f, 0.f, 0.f, 0.f};
#pragma unroll
          for (int ks = 0; ks < KS; ++ks) {
            const bf16x8 kf = *(const bf16x8*)(sK + (16 * kt + lr) * KW + m * 32 + ks * 32 + g * 8);
#pragma unroll
            for (int qt = 0; qt < NQT; ++qt) s[kt][qt] = MFMA16(kf, qf[m][qt][ks], s[kt][qt]);
          }
        }
#pragma unroll
        for (int kt = 0; kt < 4; ++kt)
#pragma unroll
          for (int qt = 0; qt < NQT; ++qt)
#pragma unroll
            for (int i = 0; i < 4; ++i) {
              float v = s[kt][qt][i] * sc;
              if (DIFF) { const int pki = (i == 0) ? pk[kt].x : (i == 1) ? pk[kt].y : (i == 2) ? pk[kt].z : pk[kt].w; v -= slope2 * fabsf(posq[qt] - (float)pki); }
              if (domask && (64 * j + 16 * kt + 4 * g + i > qw0 + 16 * qt + lr)) v = -INFINITY;
              s[kt][qt][i] = v;
            }
#pragma unroll
        for (int qt = 0; qt < NQT; ++qt) {
          float mx = -INFINITY;
#pragma unroll
          for (int kt = 0; kt < 4; ++kt)
#pragma unroll
            for (int i = 0; i < 4; ++i) mx = fmaxf(mx, s[kt][qt][i]);
          mx = fmaxf(mx, __shfl_xor(mx, 16)); mx = fmaxf(mx, __shfl_xor(mx, 32));
          const float mn = fmaxf(mrun[m][qt], mx), alpha = ex2(mrun[m][qt] - mn); mrun[m][qt] = mn;
          float ls = 0.f;
#pragma unroll
          for (int kt = 0; kt < 4; ++kt)
#pragma unroll
            for (int i = 0; i < 4; ++i) { const float pv = ex2(s[kt][qt][i] - mn); ls += pv; s[kt][qt][i] = pv; }
          lrun[m][qt] = lrun[m][qt] * alpha + ls;
#pragma unroll
          for (int dt = 0; dt < 4; ++dt) O[m][dt][qt] = O[m][dt][qt] * alpha;
        }
#pragma unroll
        for (int s2 = 0; s2 < 2; ++s2) {
          bf16x8 pf[NQT];
#pragma unroll
          for (int qt = 0; qt < NQT; ++qt) {
            uint4 u; u.x = pk2(s[2 * s2][qt][0], s[2 * s2][qt][1]); u.y = pk2(s[2 * s2][qt][2], s[2 * s2][qt][3]);
            u.z = pk2(s[2 * s2 + 1][qt][0], s[2 * s2 + 1][qt][1]); u.w = pk2(s[2 * s2 + 1][qt][2], s[2 * s2 + 1][qt][3]);
            pf[qt] = __builtin_bit_cast(bf16x8, u);
          }
#pragma unroll
          for (int dt = 0; dt < 4; ++dt) {
            const uint2 lo = *(const uint2*)(sV + (16 * dt + lr) * 72 + 32 * s2 + 4 * g), hi = *(const uint2*)(sV + (16 * dt + lr) * 72 + 32 * s2 + 16 + 4 * g);
            uint4 u; u.x = lo.x; u.y = lo.y; u.z = hi.x; u.w = hi.y;
            const bf16x8 vf = __builtin_bit_cast(bf16x8, u);
#pragma unroll
            for (int qt = 0; qt < NQT; ++qt) O[m][dt][qt] = MFMA16(vf, pf[qt], O[m][dt][qt]);
          }
        }
      }
    }
  }
#undef ATT_LOAD
#pragma unroll
  for (int qt = 0; qt < NQT; ++qt) {
    const size_t row = (size_t)rowb + qw0 + 16 * qt + lr;
    float inv[NM];
#pragma unroll
    for (int m = 0; m < NM; ++m) { float lt = lrun[m][qt]; lt += __shfl_xor(lt, 16); lt += __shfl_xor(lt, 32); inv[m] = 1.f / lt; }
    if (!DIFF) {
#pragma unroll
      for (int dt = 0; dt < 4; ++dt) {
        const int col = h * 64 + 16 * dt + 4 * g;
        const f32x4 gt = load4bf(gate + row * LDPA + 512 + col); f32x4 o = O[0][dt][qt] * inv[0];
#pragma unroll
        for (int i = 0; i < 4; ++i) o[i] *= silu(gt[i]);
        store4bf(mixed + row * 1024 + col, o);
      }
    } else {
      f32x4 o[4]; float ss = 0.f;
#pragma unroll
      for (int dt = 0; dt < 4; ++dt) { o[dt] = O[0][dt][qt] * inv[0] - O[NM - 1][dt][qt] * (lam_full * inv[NM - 1]); ss += o[dt][0] * o[dt][0] + o[dt][1] * o[dt][1] + o[dt][2] * o[dt][2] + o[dt][3] * o[dt][3]; }
      ss += __shfl_xor(ss, 16); ss += __shfl_xor(ss, 32);
      const float rs = (1.f / sqrtf(ss * (1.f / 64.f) + 1e-5f)) * (1.f - lam_init);
#pragma unroll
      for (int dt = 0; dt < 4; ++dt) {
        const int dvc = 16 * dt + 4 * g, col = h * 64 + dvc;
        const f32x4 gs = *(const f32x4*)(gsub + dvc); const f32x4 gt = load4bf(gate + row * LDPA + 512 + 384 + col);
        f32x4 r;
#pragma unroll
        for (int i = 0; i < 4; ++i) r[i] = o[dt][i] * rs * gs[i] * silu(gt[i]);
        store4bf(mixed + row * 1024 + 384 + col, r);
      }
    }
  }
}

DI void p4_unit(unsigned char* lds, const KP& p, int l, int rt) {
  unsigned char* ws = p.ws;
  const int tid = otid(), lane = tid & 63, w = tid >> 6, row0 = rt * 64;
  const bf16_t* rbuf = (const bf16_t*)(ws + OFF_SC); const bf16_t* kbuf = rbuf + (size_t)T * 384; const bf16_t* vbuf = kbuf + (size_t)T * 384;
  const bf16_t* ybuf = (const bf16_t*)(ws + OFF_R2); bf16_t* mixed = (bf16_t*)(ws + OFF_R2 + SZ_SC);
  const bf16_t* pA = (const bf16_t*)(ws + OFF_PA);
  const float* lnw = p.in[23] + l * 384; const float* lnb = p.in[24] + l * 384; const float* rk = p.in[22] + l * 384;
  for (int it = w; it < 64 * 6; it += 4) {
    const int t = it / 6, h = it - t * 6, row = row0 + t, col = h * 64 + lane; const size_t o = (size_t)row * 384 + col;
    const float y = bf2f(ybuf[o]), r = bf2f(rbuf[o]), k = bf2f(kbuf[o]), v = bf2f(vbuf[o]);
    const float mean = wave_sum(y) * (1.f / 64.f); const float d = y - mean; const float var = wave_sum(d * d) * (1.f / 64.f);
    const float dot = wave_sum(r * k * rk[col]);
    float outv = d * (1.f / sqrtf(var + 64e-5f)) * lnw[col] + lnb[col] + dot * v;
    const float gt = bf2f(pA[(size_t)row * LDPA + 512 + 640 + col]);
    mixed[(size_t)row * 1024 + 640 + col] = (bf16_t)f2bf(outv * silu(gt));
  }
  __syncthreads();
  const bf16_t* WoT = (const bf16_t*)(ws + OFF_WO + l * SZ_WO);
  EpiOut eo{l == 0 ? p.in[0] : p.out, p.out};
  for (int ct = 0; ct < 8; ++ct) gemm_tile<2>(lds, mixed, 1024, WoT, 1024, 1024, row0, ct * 128, eo);
  __syncthreads();
  if (l == 0) norm_rows_bf16(p.out, p.in[2] + 1024, (bf16_t*)(ws + OFF_R1), row0, row0 + 64, w, 4, lane);
  else {
    const float* fg = p.in[25];
    for (int row = row0 + w; row < row0 + 64; row += 4) {
      f32x4* xr = (f32x4*)(p.out + (size_t)row * 1024) + lane;
      f32x4 v[4]; float s = 0.f;
#pragma unroll
      for (int j = 0; j < 4; ++j) { v[j] = xr[64 * j]; s += v[j][0] * v[j][0] + v[j][1] * v[j][1] + v[j][2] * v[j][2] + v[j][3] * v[j][3]; }
      const float rstd = 1.f / sqrtf(wave_sum(s) * (1.f / 1024.f) + 1e-6f);
#pragma unroll
      for (int j = 0; j < 4; ++j) { const f32x4 gg = *((const f32x4*)fg + lane + 64 * j); xr[64 * j] = v[j] * rstd * gg; }
    }
  }
}

DI void p3_run(unsigned char* lds, int* s_unit, const KP& p, int l) {
  unsigned char* ws = p.ws;
  const int tid = otid();
  unsigned* ctrS = (unsigned*)(ws + OFF_CTL) + 16 * (2 * l + 1);
  unsigned* ctrA = (unsigned*)(ws + OFF_CTL) + 16 * (2 * l + 2);
  unsigned* cucnt = (unsigned*)(ws + OFF_CU) + 4096 * l;
  const bf16_t* pA = (const bf16_t*)(ws + OFF_PA);
  const bf16_t* Qm = (const bf16_t*)(ws + OFF_R1); const bf16_t* Km = Qm + (size_t)T * 576;
  bf16_t* mixed = (bf16_t*)(ws + OFF_R2 + SZ_SC);
  const int* pos = (const int*)p.in[1];
  const float* lam = p.in[10] + l * 128;
  float d0 = 0.f, d1 = 0.f;
  for (int i = 0; i < 32; ++i) { d0 += lam[i] * lam[32 + i]; d1 += lam[64 + i] * lam[96 + i]; }
  const float lam_init = 0.8f - 0.6f * expf(-0.3f * (float)(l + 1));
  const float lam_full = expf(d0) - expf(d1) + lam_init;
  bool prefer_scan = false, sdone = false;
  if (tid == 0) {
    const unsigned xcc = (unsigned)__builtin_amdgcn_s_getreg((3 << 11) | 20) & 0xFu;
    const unsigned cu = (unsigned)__builtin_amdgcn_s_getreg((7 << 11) | (8 << 6) | 4) & 0xFFu;
    prefer_scan = (atomicAdd(cucnt + ((xcc << 8) | cu), 1u) == 0u);
  }
  for (;;) {
    __syncthreads();
    if (tid == 0) {
      int code = -1;
      if (prefer_scan && !sdone) { const unsigned u = atomicAdd(ctrS, 1u); if (u < (unsigned)NSCAN) code = (int)u; else sdone = true; }
      if (code < 0) { const unsigned u = atomicAdd(ctrA, 1u); if (u < (unsigned)NATT) code = NSCAN + (int)u; }
      if (code < 0 && !sdone) { const unsigned u = atomicAdd(ctrS, 1u); if (u < (unsigned)NSCAN) code = (int)u; else sdone = true; }
      *s_unit = code;
    }
    __syncthreads();
    const int u = *s_unit;
    if (u < 0) break;
    if (u < NSCAN) scan_unit(lds, p, u);
    else if (u < NSCAN + NMLA) {
      const int v = u - NSCAN, qb = 15 - v / 96, bh = v % 96, b = bh / 6, h = bh - b * 6;
      attn_unit<false>(lds, Qm + (size_t)b * 2048 * 576 + h * 96, Km + (size_t)b * 2048 * 576 + h * 96, 576, (const bf16_t*)(ws + OFF_VTM) + (size_t)bh * 64 * 2048,
                       pA, mixed, pos, qb, h, b * 2048, 0.f, 0.f, nullptr);
    } else {
      const int v = u - NSCAN - NMLA, qb = 31 - v / 64, bh = v % 64, b = bh >> 2, h = bh & 3;
      attn_unit<true>(lds, pA + (size_t)b * 2048 * LDPA + h * 64, pA + (size_t)b * 2048 * LDPA + 256 + h * 64, LDPA, (const bf16_t*)(ws + OFF_VTD) + (size_t)bh * 64 * 2048,
                      pA, mixed, pos, qb, h, b * 2048, lam_full, lam_init, p.in[11] + l * 64);
    }
  }
}

__global__ void __launch_bounds__(NTH, 2) mk_fwd(KP p) {
  __shared__ __attribute__((aligned(16))) unsigned char lds[36864 + 1024];
  __shared__ int s_unit;
  cg::grid_group grid = cg::this_grid();
  unsigned char* ws = p.ws;
  const int tid = otid(), lane = tid & 63, w = tid >> 6;
  const int G = gridDim.x, bid = blockIdx.x;
#define RUN(k) (p.ph_lo <= (k) && (k) < p.ph_hi)
#define SEAM(k) do { if (RUN(k) && RUN((k) + 1)) grid.sync(); } while (0)

  if (RUN(0)) {
    const int gt = bid * NTH + tid, ngt = G * NTH;
    if (gt < 128) ((unsigned*)(ws + OFF_CTL))[gt] = 0u;
    for (int i = gt; i < 2 * 4096; i += ngt) ((unsigned*)(ws + OFF_CU))[i] = 0u;
    for (int l = 0; l < 2; ++l) {
      bf16_t* Wc = (bf16_t*)(ws + OFF_WC + l * SZ_WC);
      if (l == 0) convT(p.in[3], 1024, 3488, Wc, 1024, NP, nullptr, gt, ngt);
      else { convT(p.in[3] + (size_t)1024 * 3488, 1024, 3488, Wc, 1024, 3488, nullptr, gt, ngt); convT(p.in[4], 1024, 32, Wc + (size_t)3488 * 1024, 1024, 96, nullptr, gt, ngt); }
      convT(p.in[5] + (size_t)l * 1024 * 1024, 1024, 1024, (bf16_t*)(ws + OFF_WO + l * SZ_WO), 1024, 1024, nullptr, gt, ngt);
      convT(p.in[8] + (size_t)l * 256 * 576, 256, 576, (bf16_t*)(ws + OFF_WUQ + l * SZ_WUQ), 256, 640, p.in[6] + l * 256, gt, ngt);
      convT(p.in[9] + (size_t)l * 128 * 768, 128, 768, (bf16_t*)(ws + OFF_WUKV + l * SZ_WUKV), 128, 768, p.in[7] + l * 128, gt, ngt);
      convT(p.in[15] + (size_t)l * 64 * 384, 64, 384, (bf16_t*)(ws + OFF_W2 + l * SZ_L), 64, 384, nullptr, gt, ngt);
      convT(p.in[17] + (size_t)l * 64 * 384, 64, 384, (bf16_t*)(ws + OFF_A2 + l * SZ_L), 64, 384, nullptr, gt, ngt);
    }
    convT(p.in[19], 32, 384, (bf16_t*)(ws + OFF_V2), 64, 384, nullptr, gt, ngt);
    {
      float* tab = (float*)(ws + OFF_TAB); const int* pos = (const int*)p.in[1];
      for (int idx = gt; idx < 2048 * 16; idx += ngt) {
        const int s = idx >> 4, i = idx & 15;
        const float inv = exp2f(-(float)i * (13.287712379549449f / 16.f));
        const float ang = (float)pos[s] * inv;
        double rev = (double)ang * 0.15915494309189535; rev -= __builtin_rint(rev);
        tab[s * 32 + i] = __builtin_amdgcn_cosf((float)rev); tab[s * 32 + 16 + i] = __builtin_amdgcn_sinf((float)rev);
      }
    }
    norm_rows_bf16(p.in[0], p.in[2], (bf16_t*)(ws + OFF_R1), 0, T, bid * 4 + w, G * 4, lane);
  }
  SEAM(0);
  for (int l = 0; l < 2; ++l) {
    const int pb = 1 + 4 * l;
    if (RUN(pb)) {
      EpiRoute e{(bf16_t*)(ws + OFF_PA), (bf16_t*)(ws + OFF_R2), (bf16_t*)(ws + OFF_VTD), l ? 3520 : 3488};
      const bf16_t* hb = (const bf16_t*)(ws + OFF_R1); const bf16_t* Wc = (const bf16_t*)(ws + OFF_WC + l * SZ_WC);
      for (int rep = 0; rep < ((PROBE == 1 && l == 0) ? 2 : 1); ++rep)
      for (int u = bid; u < 256 * 28; u += G) { const int rt = u / 28, ct = u - rt * 28; gemm_tile<4>(lds, hb, 1024, Wc, 1024, 1024, rt * 128, ct * 128, e); }
    }
    SEAM(pb);
    if (RUN(pb + 1)) { for (int rep = 0; rep < ((PROBE == 2 && l == 0) ? 2 : 1); ++rep) { if (rep) grid.sync(); for (int rt = bid; rt < 512; rt += G) p2_unit(lds, p, l, rt); } }
    SEAM(pb + 1);
    if (RUN(pb + 2)) {
      p3_run(lds, &s_unit, p, l);
#if PROBE == 3
      if (l == 0) { grid.sync(); for (int u = bid; u < NSCAN; u += G) { __syncthreads(); scan_unit(lds, p, u); } }
#endif
    }
    SEAM(pb + 2);
    if (RUN(pb + 3)) { for (int rep = 0; rep < ((PROBE == 5 && l == 0) ? 2 : 1); ++rep) { if (rep) grid.sync(); for (int rt = bid; rt < 512; rt += G) p4_unit(lds, p, l, rt); } }
    SEAM(pb + 3);
  }
#undef RUN
#undef SEAM
}

extern "C" void kernel_launch(void* const* d_in, const int* in_sizes, int n_in, void* d_out, int out_size, void* d_ws, size_t ws_size, hipStream_t stream) {
  static int grid = 0;
  if (grid == 0) {
    if (n_in != 26 || ws_size < WS_END) { fprintf(stderr, "kernel_launch: need 26 inputs and %zu bytes of workspace (got %d, %zu)\n", (size_t)WS_END, n_in, ws_size); grid = -1; return; }
    int dev = 0, cus = 0, per_cu = 0;
    (void)hipGetDevice(&dev);
    (void)hipDeviceGetAttribute(&cus, hipDeviceAttributeMultiprocessorCount, dev);
    (void)hipOccupancyMaxActiveBlocksPerMultiprocessor(&per_cu, (const void*)mk_fwd, NTH, 0);
    if (per_cu > 2) per_cu = 2;
    if (per_cu < 1) { fprintf(stderr, "kernel_launch: occupancy query returned %d\n", per_cu); per_cu = 1; }
    grid = cus * per_cu;
  }
  if (grid < 0) return;
  KP p{};
  for (int i = 0; i < 26; ++i) p.in[i] = (const float*)d_in[i];
  p.out = (float*)d_out; p.ws = (unsigned char*)d_ws;
  if (MK_LAUNCHES == 1) {
    p.ph_lo = 0; p.ph_hi = NPHASE;
    void* args[] = {&p};
    hipError_t e = hipLaunchCooperativeKernel((const void*)mk_fwd, dim3(grid), dim3(NTH), args, 0, stream);
    if (e != hipSuccess) fprintf(stderr, "cooperative launch failed: %s (grid %d)\n", hipGetErrorString(e), grid);
  } else {
    for (int k = 0; k < NPHASE; ++k) { p.ph_lo = k; p.ph_hi = k + 1; hipLaunchKernelGGL(mk_fwd, dim3(grid), dim3(NTH), 0, stream, p); }
  }
}
```

```cpp
#include <hip/hip_runtime.h>
#include <hip/hip_cooperative_groups.h>
#include <cstdio>
#include <cstdint>
namespace cg = cooperative_groups;

#ifndef PROBE
#define PROBE 0
#endif
#ifndef MK_LAUNCHES
#define MK_LAUNCHES 1
#endif

typedef unsigned short bf16_t;
typedef short bf16x8 __attribute__((ext_vector_type(8)));
typedef float f32x4 __attribute__((ext_vector_type(4)));
#define DI __device__ __forceinline__

constexpr int NB = 16, SEQ = 2048, T = NB * SEQ, DM = 1024;
constexpr int NP = 3584;
constexpr int LDPA = 1536;
constexpr int LDPB = 1728;
constexpr int NPHASE = 9;
constexpr int NTH = 256;
constexpr int NSCAN = 192, NMLA = 96 * 16, NDIFF = 64 * 32, NATT = NMLA + NDIFF;

constexpr size_t OFF_CTL = 0;
constexpr size_t OFF_TAB = 4096;
constexpr size_t SZ_WC = (size_t)NP * 1024 * 2;
constexpr size_t OFF_WC = OFF_TAB + 262144;
constexpr size_t SZ_WO = (size_t)1024 * 1024 * 2;
constexpr size_t OFF_WO = OFF_WC + 2 * SZ_WC;
constexpr size_t SZ_WUQ = (size_t)640 * 256 * 2;
constexpr size_t OFF_WUQ = OFF_WO + 2 * SZ_WO;
constexpr size_t SZ_WUKV = (size_t)768 * 128 * 2;
constexpr size_t OFF_WUKV = OFF_WUQ + 2 * SZ_WUQ;
constexpr size_t SZ_L = (size_t)384 * 64 * 2;
constexpr size_t OFF_W2 = OFF_WUKV + 2 * SZ_WUKV;
constexpr size_t OFF_A2 = OFF_W2 + 2 * SZ_L;
constexpr size_t OFF_V2 = OFF_A2 + 2 * SZ_L;
constexpr size_t OFF_R1 = OFF_V2 + SZ_L;
constexpr size_t SZ_QK = (size_t)T * 576 * 2;
constexpr size_t OFF_PA = OFF_R1 + 2 * SZ_QK;
constexpr size_t OFF_R2 = OFF_PA + (size_t)T * LDPA * 2;
constexpr size_t OFF_VTM = OFF_R2 + (size_t)T * LDPB * 2;
constexpr size_t OFF_VTD = OFF_VTM + (size_t)T * 384 * 2;
constexpr size_t SZ_SC = (size_t)T * 384 * 2;
constexpr size_t OFF_SC = OFF_VTD + (size_t)T * 256 * 2;
constexpr size_t OFF_LA = OFF_SC + 6 * SZ_SC;
constexpr size_t OFF_CU = OFF_LA + (size_t)T * 192 * 2;
constexpr size_t WS_END = OFF_CU + 2 * 4096 * 4;
static_assert(OFF_R1 % 256 == 0, "align");

struct KP { const float* in[26]; float* out; unsigned char* ws; int ph_lo, ph_hi; };

DI unsigned f2bf(float f) { unsigned u = __float_as_uint(f); return (u + 0x7fffu + ((u >> 16) & 1u)) >> 16; }
DI float bf2f(bf16_t h) { return __uint_as_float(((unsigned)h) << 16); }
DI unsigned pk2(float a, float b) { return f2bf(a) | (f2bf(b) << 16); }
DI void store4bf(bf16_t* p, f32x4 v) { uint2 u; u.x = pk2(v[0], v[1]); u.y = pk2(v[2], v[3]); *(uint2*)p = u; }
DI f32x4 up4(uint2 u) { f32x4 r; r[0] = __uint_as_float(u.x << 16); r[1] = __uint_as_float(u.x & 0xffff0000u); r[2] = __uint_as_float(u.y << 16); r[3] = __uint_as_float(u.y & 0xffff0000u); return r; }
DI f32x4 load4bf(const bf16_t* p) { return up4(*(const uint2*)p); }
DI float wave_sum(float v) {
#pragma unroll
  for (int o = 1; o < 64; o <<= 1) v += __shfl_xor(v, o);
  return v;
}
DI float ex2(float x) { return __builtin_amdgcn_exp2f(x); }
DI float fexp(float x) { return __builtin_amdgcn_exp2f(x * 1.4426950408889634f); }
DI float sigm(float x) { return 1.f / (1.f + fexp(-x)); }
DI float silu(float x) { return x / (1.f + fexp(-x)); }
template <int CTRL> DI float dppmov(float x) { return __builtin_bit_cast(float, __builtin_amdgcn_update_dpp(0, __builtin_bit_cast(int, x), CTRL, 0xF, 0xF, true)); }
DI float rowsum16(float x) {
  x += dppmov<0xB1>(x);
  x += dppmov<0x4E>(x);
  x += dppmov<0x124>(x);
  x += dppmov<0x128>(x);
  return x;
}
DI int otid() { int t = threadIdx.x; asm volatile("" : "+v"(t)); return t; }
#define MFMA16(a, b, c) __builtin_amdgcn_mfma_f32_16x16x32_bf16((a), (b), (c), 0, 0, 0)

template <int MI, class Epi>
DI void gemm_tile(unsigned char* lds, const bf16_t* __restrict__ A, int lda, const bf16_t* __restrict__ Bt, int ldb, int K, int row0, int col0, const Epi& epi) {
  constexpr int BM = 32 * MI;
  bf16_t* sA = (bf16_t*)lds;
  bf16_t* sB = sA + BM * 72;
  const int tid = otid(), lane = tid & 63, w = tid >> 6, wm = w >> 1, wn = w & 1, lr = lane & 15, g = lane >> 4;
  const int sr = tid >> 3, skc = tid & 7;
  const bf16_t* gA = A + (size_t)(row0 + sr) * lda + skc * 8;
  const bf16_t* gB = Bt + (size_t)(col0 + sr) * ldb + skc * 8;
  uint4 ra0, ra1, ra2 = {0u, 0u, 0u, 0u}, ra3 = {0u, 0u, 0u, 0u}, rb0, rb1, rb2, rb3;
#define G_LOAD(k0_) do { ra0 = *(const uint4*)(gA + (k0_)); ra1 = *(const uint4*)(gA + (size_t)32 * lda + (k0_)); \
    if (MI == 4) { ra2 = *(const uint4*)(gA + (size_t)64 * lda + (k0_)); ra3 = *(const uint4*)(gA + (size_t)96 * lda + (k0_)); } \
    rb0 = *(const uint4*)(gB + (k0_)); rb1 = *(const uint4*)(gB + (size_t)32 * ldb + (k0_)); rb2 = *(const uint4*)(gB + (size_t)64 * ldb + (k0_)); rb3 = *(const uint4*)(gB + (size_t)96 * ldb + (k0_)); } while (0)
  G_LOAD(0);
  f32x4 acc[MI][4];
#pragma unroll
  for (int mi = 0; mi < MI; ++mi)
#pragma unroll
    for (int ni = 0; ni < 4; ++ni) acc[mi][ni] = (f32x4){0.f, 0.f, 0.f, 0.f};
  const int nk = K >> 6;
  for (int kt = 0; kt < nk; ++kt) {
    __syncthreads();
    *(uint4*)(sA + sr * 72 + skc * 8) = ra0; *(uint4*)(sA + (sr + 32) * 72 + skc * 8) = ra1;
    if (MI == 4) { *(uint4*)(sA + (sr + 64) * 72 + skc * 8) = ra2; *(uint4*)(sA + (sr + 96) * 72 + skc * 8) = ra3; }
    *(uint4*)(sB + sr * 72 + skc * 8) = rb0; *(uint4*)(sB + (sr + 32) * 72 + skc * 8) = rb1; *(uint4*)(sB + (sr + 64) * 72 + skc * 8) = rb2; *(uint4*)(sB + (sr + 96) * 72 + skc * 8) = rb3;
    __syncthreads();
    if (kt + 1 < nk) G_LOAD((kt + 1) * 64);
#pragma unroll
    for (int ks = 0; ks < 2; ++ks) {
      bf16x8 af[MI], bfr[4];
#pragma unroll
      for (int mi = 0; mi < MI; ++mi) af[mi] = *(const bf16x8*)(sA + (wm * 16 * MI + mi * 16 + lr) * 72 + ks * 32 + g * 8);
#pragma unroll
      for (int ni = 0; ni < 4; ++ni) bfr[ni] = *(const bf16x8*)(sB + (wn * 64 + ni * 16 + lr) * 72 + ks * 32 + g * 8);
#pragma unroll
      for (int mi = 0; mi < MI; ++mi)
#pragma unroll
        for (int ni = 0; ni < 4; ++ni) acc[mi][ni] = MFMA16(bfr[ni], af[mi], acc[mi][ni]);
    }
  }
#pragma unroll
  for (int mi = 0; mi < MI; ++mi)
#pragma unroll
    for (int ni = 0; ni < 4; ++ni) epi(row0 + wm * 16 * MI + mi * 16 + lr, col0 + wn * 64 + ni * 16 + 4 * g, acc[mi][ni]);
#undef G_LOAD
}

struct EpiRoute {
  bf16_t* pA; bf16_t* pB; bf16_t* VtD; int ncols;
  DI void operator()(int row, int col, f32x4 v) const {
    if (col >= ncols) return;
    if (col < 416) store4bf(pB + (size_t)row * LDPB + col, v);
    else if (col < 928) store4bf(pA + (size_t)row * LDPA + (col - 416), v);
    else if (col < 1184) {
      const int c = col - 928, h = c >> 6, dv = c & 63, b = row >> 11, s = row & 2047;
      bf16_t* q = VtD + ((size_t)((b * 4 + h) * 64 + dv)) * 2048 + s;
      q[0] = (bf16_t)f2bf(v[0]); q[2048] = (bf16_t)f2bf(v[1]); q[4096] = (bf16_t)f2bf(v[2]); q[6144] = (bf16_t)f2bf(v[3]);
    }
    else if (col < 2208) store4bf(pA + (size_t)row * LDPA + 512 + (col - 1184), v);
    else store4bf(pB + (size_t)row * LDPB + 416 + (col - 2208), v);
  }
};
struct EpiQ {
  bf16_t* Qm; const float* rs; int row0;
  DI void operator()(int row, int col, f32x4 v) const {
    if (col >= 576) return;
    const float r = rs[row - row0]; v = v * r;
    store4bf(Qm + (size_t)row * 576 + col, v);
  }
};
struct EpiKV {
  bf16_t* Km; bf16_t* VtM; const float* rs; int row0;
  DI void operator()(int row, int col, f32x4 v) const {
    const float r = rs[row - row0]; v = v * r;
    const int head = col >> 7, c = col & 127;
    if (c < 64) store4bf(Km + (size_t)row * 576 + head * 96 + c, v);
    else {
      const int b = row >> 11, s = row & 2047;
      bf16_t* q = VtM + ((size_t)((b * 6 + head) * 64 + (c - 64))) * 2048 + s;
      q[0] = (bf16_t)f2bf(v[0]); q[2048] = (bf16_t)f2bf(v[1]); q[4096] = (bf16_t)f2bf(v[2]); q[6144] = (bf16_t)f2bf(v[3]);
    }
  }
};
struct EpiW {
  bf16_t* wbuf; const float* w0;
  DI void operator()(int row, int col, f32x4 v) const {
    f32x4 o;
#pragma unroll
    for (int i = 0; i < 4; ++i) { const float val = v[i] + w0[col + i]; const float wv = -__logf(1.f + fexp(-val)) - 0.5f; o[i] = -fexp(wv); }
    store4bf(wbuf + (size_t)row * 384 + col, o);
  }
};
struct EpiA {
  bf16_t* abuf; bf16_t* kbuf; const float* a0; const float* ka;
  DI void operator()(int row, int col, f32x4 v) const {
    f32x4 kr = load4bf(kbuf + (size_t)row * 384 + col), a, kn;
#pragma unroll
    for (int i = 0; i < 4; ++i) { a[i] = sigm(v[i] + a0[col + i]); kn[i] = kr[i] * (1.f + (a[i] - 1.f) * ka[col + i]); }
    store4bf(abuf + (size_t)row * 384 + col, a);
    store4bf(kbuf + (size_t)row * 384 + col, kn);
  }
};
struct EpiV {
  bf16_t* vbuf; const bf16_t* pB; const float* v0; const float* mu;
  DI void operator()(int row, int col, f32x4 v) const {
    const int s = row & 2047;
    f32x4 p = load4bf(pB + (size_t)row * LDPB + 416 + 768 + col), pr = (f32x4){0.f, 0.f, 0.f, 0.f};
    if (s > 0) pr = load4bf(pB + (size_t)(row - 1) * LDPB + 416 + 768 + col);
    f32x4 vf = load4bf(vbuf + (size_t)row * 384 + col), o;
#pragma unroll
    for (int i = 0; i < 4; ++i) { const float xv = p[i] + (pr[i] - p[i]) * mu[768 + col + i]; const float sg = sigm(v[i] + v0[col + i]); o[i] = xv + (vf[i] - xv) * sg; }
    store4bf(vbuf + (size_t)row * 384 + col, o);
  }
};
struct EpiOut {
  const float* xin; float* xout;
  DI void operator()(int row, int col, f32x4 v) const {
    const f32x4 x = *(const f32x4*)(xin + (size_t)row * 1024 + col);
    *(f32x4*)(xout + (size_t)row * 1024 + col) = x + v;
  }
};

DI void convT(const float* __restrict__ src, int K, int N, bf16_t* dst, int Kpad, int NR, const float* scale, int gt, int ngt) {
  const int kcN = Kpad >> 3, total = NR * kcN;
  for (int idx = gt; idx < total; idx += ngt) {
    const int n = idx % NR, kc = idx / NR; uint4 o = {0u, 0u, 0u, 0u};
    if (n < N) {
      float v[8];
#pragma unroll
      for (int j = 0; j < 8; ++j) { const int k = kc * 8 + j; v[j] = (k < K) ? src[(size_t)k * N + n] * (scale ? scale[k] : 1.f) : 0.f; }
      o.x = pk2(v[0], v[1]); o.y = pk2(v[2], v[3]); o.z = pk2(v[4], v[5]); o.w = pk2(v[6], v[7]);
    }
    *(uint4*)(dst + (size_t)n * Kpad + kc * 8) = o;
  }
}
DI void norm_rows_bf16(const float* x, const float* gain, bf16_t* hb, int rbeg, int rend, int gw, int ngw, int lane) {
  for (int row = rbeg + gw; row < rend; row += ngw) {
    const f32x4* xr = (const f32x4*)(x + (size_t)row * 1024) + lane;
    f32x4 v[4]; float s = 0.f;
#pragma unroll
    for (int j = 0; j < 4; ++j) { v[j] = xr[64 * j]; s += v[j][0] * v[j][0] + v[j][1] * v[j][1] + v[j][2] * v[j][2] + v[j][3] * v[j][3]; }
    const float rstd = 1.f / sqrtf(wave_sum(s) * (1.f / 1024.f) + 1e-6f);
#pragma unroll
    for (int j = 0; j < 4; ++j) { const f32x4 gg = *((const f32x4*)gain + lane + 64 * j); store4bf(hb + (size_t)row * 1024 + 4 * lane + 256 * j, v[j] * rstd * gg); }
  }
}

DI void p2_unit(unsigned char* lds, const KP& p, int l, int rt) {
  unsigned char* ws = p.ws;
  const int tid = otid(), lane = tid & 63, w = tid >> 6, row0 = rt * 64;
  bf16_t* pB = (bf16_t*)(ws + OFF_R2);
  bf16_t* Qm = (bf16_t*)(ws + OFF_R1); bf16_t* Km = Qm + (size_t)T * 576;
  bf16_t* VtM = (bf16_t*)(ws + OFF_VTM);
  bf16_t* rbuf = (bf16_t*)(ws + OFF_SC); bf16_t* kbuf = rbuf + (size_t)T * 384; bf16_t* vbuf = kbuf + (size_t)T * 384;
  bf16_t* wbuf = vbuf + (size_t)T * 384; bf16_t* kkbuf = wbuf + (size_t)T * 384; bf16_t* abuf = kkbuf + (size_t)T * 384;
  bf16_t* LA = (bf16_t*)(ws + OFF_LA);
  const float* tab = (const float*)(ws + OFF_TAB);
  float* sRq = (float*)(lds + 36864); float* sRkv = sRq + 64;
  __syncthreads();
  {
    const int r = tid >> 2, part = tid & 3; const bf16_t* pr = pB + (size_t)(row0 + r) * LDPB;
    float sq = 0.f, sk = 0.f;
#pragma unroll
    for (int j = 0; j < 16; ++j) { f32x4 v = load4bf(pr + part * 64 + j * 4); sq += v[0] * v[0] + v[1] * v[1] + v[2] * v[2] + v[3] * v[3]; }
#pragma unroll
    for (int j = 0; j < 8; ++j) { f32x4 v = load4bf(pr + 256 + part * 32 + j * 4); sk += v[0] * v[0] + v[1] * v[1] + v[2] * v[2] + v[3] * v[3]; }
    sq += __shfl_xor(sq, 1); sq += __shfl_xor(sq, 2); sk += __shfl_xor(sk, 1); sk += __shfl_xor(sk, 2);
    if (part == 0) { sRq[r] = 1.f / sqrtf(sq * (1.f / 256.f) + 1e-6f); sRkv[r] = 1.f / sqrtf(sk * (1.f / 128.f) + 1e-6f); }
  }
  {
    const float* mu = p.in[12] + l * 1280; const float* kkw = p.in[20] + l * 384;
    float mur[6], muk[6], muv_[6], kkw_[6];
#pragma unroll
    for (int h = 0; h < 6; ++h) { mur[h] = mu[h * 64 + lane]; muk[h] = mu[384 + h * 64 + lane]; muv_[h] = mu[768 + h * 64 + lane]; kkw_[h] = kkw[h * 64 + lane]; }
    for (int t = w; t < 64; t += 4) {
      const int row = row0 + t, s = row & 2047;
      const bf16_t* pc = pB + (size_t)row * LDPB + 416 + lane;
      const bf16_t* pp = (s > 0) ? pc - LDPB : pc;
      const float pm = (s > 0) ? 1.f : 0.f;
      float cr[6], ck[6], cv[6], qr[6], qk[6], qv[6];
#pragma unroll
      for (int h = 0; h < 6; ++h) { cr[h] = bf2f(pc[h * 64]); ck[h] = bf2f(pc[384 + h * 64]); cv[h] = bf2f(pc[768 + h * 64]); qr[h] = bf2f(pp[h * 64]) * pm; qk[h] = bf2f(pp[384 + h * 64]) * pm; qv[h] = bf2f(pp[768 + h * 64]) * pm; }
#pragma unroll
      for (int h = 0; h < 6; ++h) {
        const float xr = cr[h] + (qr[h] - cr[h]) * mur[h], xk = ck[h] + (qk[h] - ck[h]) * muk[h], xv = cv[h] + (qv[h] - cv[h]) * muv_[h];
        const float kv_ = xk * kkw_[h]; const float ss = wave_sum(kv_ * kv_);
        const float kk = kv_ / fmaxf(sqrtf(ss), 1e-12f);
        const size_t o = (size_t)row * 384 + h * 64 + lane;
        rbuf[o] = (bf16_t)f2bf(xr); kbuf[o] = (bf16_t)f2bf(xk); kkbuf[o] = (bf16_t)f2bf(kk);
        if (l == 0) vbuf[o] = (bf16_t)f2bf(xv);
      }
    }
    const float* muv = p.in[13];
    if (tid < 192) {
      const int j = tid; const bool act = (j < 128) || (j < 160 && l > 0);
      const int sc_ = 1152 + j;
      const float m = (j < 128) ? mu[sc_] : (j < 160 ? muv[j - 128] : 0.f);
      for (int tb = 0; tb < 64; tb += 8) {
        float a[8], bq[8];
#pragma unroll
        for (int u = 0; u < 8; ++u) {
          const int row = row0 + tb + u, s = row & 2047;
          const bf16_t* pc = pB + (size_t)row * LDPB + 416 + sc_;
          a[u] = act ? bf2f(pc[0]) : 0.f; bq[u] = (act && s > 0) ? bf2f(pc[-LDPB]) : 0.f;
        }
#pragma unroll
        for (int u = 0; u < 8; ++u) {
          float val = a[u] + (bq[u] - a[u]) * m;
          if (j < 64) val = 1.f - 2.f / (fexp(2.f * val) + 1.f);
          LA[(size_t)(row0 + tb + u) * 192 + j] = (bf16_t)f2bf(val);
        }
      }
    }
  }
  __syncthreads();
  {
    const bf16_t* WuqT = (const bf16_t*)(ws + OFF_WUQ + l * SZ_WUQ);
    const bf16_t* WukvT = (const bf16_t*)(ws + OFF_WUKV + l * SZ_WUKV);
    EpiQ eq{Qm, sRq, row0};
    for (int ct = 0; ct < 5; ++ct) gemm_tile<2>(lds, pB, LDPB, WuqT, 256, 256, row0, ct * 128, eq);
    EpiKV ek{Km, VtM, sRkv, row0};
    for (int ct = 0; ct < 6; ++ct) gemm_tile<2>(lds, pB + 256, LDPB, WukvT, 128, 128, row0, ct * 128, ek);
  }
  {
    const bf16_t* w2T = (const bf16_t*)(ws + OFF_W2 + l * SZ_L);
    const bf16_t* a2T = (const bf16_t*)(ws + OFF_A2 + l * SZ_L);
    const bf16_t* v2T = (const bf16_t*)(ws + OFF_V2);
    EpiW ew{wbuf, p.in[14] + l * 384};
    for (int ct = 0; ct < 3; ++ct) gemm_tile<2>(lds, LA, 192, w2T, 64, 64, row0, ct * 128, ew);
    EpiA ea{abuf, kbuf, p.in[16] + l * 384, p.in[21] + l * 384};
    for (int ct = 0; ct < 3; ++ct) gemm_tile<2>(lds, LA + 64, 192, a2T, 64, 64, row0, ct * 128, ea);
    if (l > 0) {
      EpiV ev{vbuf, pB, p.in[18], p.in[12] + l * 1280};
      for (int ct = 0; ct < 3; ++ct) gemm_tile<2>(lds, LA + 128, 192, v2T, 64, 64, row0, ct * 128, ev);
    }
  }
  __syncthreads();
  {
    for (int idx = tid; idx < 64 * 16; idx += NTH) {
      const int r = idx >> 4, i = idx & 15, row = row0 + r, s = row & 2047;
      const float c = tab[s * 32 + i], sn = tab[s * 32 + 16 + i];
      bf16_t* q = Qm + (size_t)row * 576 + 64;
#pragma unroll
      for (int h = 0; h < 6; ++h) { const float t1 = bf2f(q[h * 96 + i]), t2 = bf2f(q[h * 96 + 16 + i]); q[h * 96 + i] = (bf16_t)f2bf(t1 * c - t2 * sn); q[h * 96 + 16 + i] = (bf16_t)f2bf(t1 * sn + t2 * c); }
      const float k1 = bf2f(pB[(size_t)row * LDPB + 384 + i]), k2 = bf2f(pB[(size_t)row * LDPB + 400 + i]);
      const bf16_t o1 = (bf16_t)f2bf(k1 * c - k2 * sn), o2 = (bf16_t)f2bf(k1 * sn + k2 * c);
      bf16_t* kq = Km + (size_t)row * 576 + 64;
#pragma unroll
      for (int h = 0; h < 6; ++h) { kq[h * 96 + i] = o1; kq[h * 96 + 16 + i] = o2; }
    }
  }
}

DI void scan_unit(unsigned char* lds, const KP& p, int unit) {
  unsigned char* ws = p.ws;
  float* sm = (float*)lds;
  const int tid = otid(), lane = tid & 63, w16 = tid >> 6, rg = lane >> 4, cg_ = lane & 15;
  const int hid = unit >> 1, half = unit & 1, b = hid / 6, h = hid - b * 6;
  const bf16_t* rbuf = (const bf16_t*)(ws + OFF_SC); const bf16_t* kbuf = rbuf + (size_t)T * 384; const bf16_t* vbuf = kbuf + (size_t)T * 384;
  const bf16_t* wbuf = vbuf + (size_t)T * 384; const bf16_t* kkbuf = wbuf + (size_t)T * 384; const bf16_t* abuf = kkbuf + (size_t)T * 384;
  bf16_t* ybuf = (bf16_t*)(ws + OFF_R2);
  const int st = tid >> 4, sp = tid & 15;
  const size_t gbase = ((size_t)b * 2048) * 384 + h * 64 + sp * 4;
  uint2 qw, qk, qkk, qa, qr, qv;
#define SCAN_LOAD(t0) do { const size_t o_ = gbase + (size_t)((t0) + st) * 384; qw = *(const uint2*)(wbuf + o_); qk = *(const uint2*)(kbuf + o_); qkk = *(const uint2*)(kkbuf + o_); \
    qa = *(const uint2*)(abuf + o_); qr = *(const uint2*)(rbuf + o_); qv = *(const uint2*)(vbuf + o_); } while (0)
  f32x4 S0 = (f32x4){0.f, 0.f, 0.f, 0.f}, S1 = (f32x4){0.f, 0.f, 0.f, 0.f};
  SCAN_LOAD(0);
  const int rowoff = half * 32 + w16 * 8 + rg * 2;
  bf16_t* yout = ybuf + ((size_t)b * 2048) * 384 + h * 64 + rowoff;
  __builtin_amdgcn_s_setprio(3);
  for (int ch = 0; ch < 128; ++ch) {
    __syncthreads();
    {
      float* d = sm + st * 400 + sp * 4;
      const f32x4 fw = up4(qw), fk = up4(qk), fkk = up4(qkk), fa = up4(qa), fr = up4(qr), fv = up4(qv);
      f32x4 dec;
#pragma unroll
      for (int i = 0; i < 4; ++i) dec[i] = fexp(fw[i]);
      const f32x4 bp = fkk * fa;
      float be = bp[0] * fr[0] + bp[1] * fr[1] + bp[2] * fr[2] + bp[3] * fr[3];
      float ka = fk[0] * fr[0] + fk[1] * fr[1] + fk[2] * fr[2] + fk[3] * fr[3];
      be = rowsum16(be); ka = rowsum16(ka);
      *(f32x4*)(d) = dec; *(f32x4*)(d + 64) = fk; *(f32x4*)(d + 128) = -fkk; *(f32x4*)(d + 192) = bp; *(f32x4*)(d + 256) = dec * fr; *(f32x4*)(d + 320) = fv;
      if (sp == 0) { sm[st * 400 + 384] = be; sm[st * 400 + 385] = ka; }
    }
    __syncthreads();
    if (ch + 1 < 128) SCAN_LOAD((ch + 1) * 16);
#pragma unroll 4
    for (int t = 0; t < 16; ++t) {
      const float* q = sm + t * 400;
      const f32x4 w4 = *(const f32x4*)(q + 4 * cg_), k4 = *(const f32x4*)(q + 64 + 4 * cg_), a4 = *(const f32x4*)(q + 128 + 4 * cg_);
      const f32x4 b4 = *(const f32x4*)(q + 192 + 4 * cg_), r4 = *(const f32x4*)(q + 256 + 4 * cg_);
      const float v0 = q[320 + rowoff], v1 = q[321 + rowoff], be = q[384], ka = q[385];
      float sa0 = S0[0] * a4[0] + S0[1] * a4[1] + S0[2] * a4[2] + S0[3] * a4[3];
      float sa1 = S1[0] * a4[0] + S1[1] * a4[1] + S1[2] * a4[2] + S1[3] * a4[3];
      float y0 = S0[0] * r4[0] + S0[1] * r4[1] + S0[2] * r4[2] + S0[3] * r4[3];
      float y1 = S1[0] * r4[0] + S1[1] * r4[1] + S1[2] * r4[2] + S1[3] * r4[3];
      sa0 = rowsum16(sa0); sa1 = rowsum16(sa1); y0 = rowsum16(y0); y1 = rowsum16(y1);
      S0 = S0 * w4 + (b4 * sa0 + k4 * v0);
      S1 = S1 * w4 + (b4 * sa1 + k4 * v1);
      y0 += sa0 * be + v0 * ka; y1 += sa1 * be + v1 * ka;
      if (cg_ == 0) *(unsigned*)(yout + (size_t)(ch * 16 + t) * 384) = pk2(y0, y1);
    }
  }
  __builtin_amdgcn_s_setprio(0);
#undef SCAN_LOAD
}

template <bool DIFF>
DI void attn_unit(unsigned char* lds, const bf16_t* __restrict__ Qb, const bf16_t* __restrict__ Kb, int ld, const bf16_t* __restrict__ Vt,
                  const bf16_t* __restrict__ gate, bf16_t* mixed, const int* __restrict__ pos, int qb, int h, int rowb,
                  float lam_full, float lam_init, const float* __restrict__ gsub) {
  constexpr int KS = DIFF ? 1 : 3, NM = DIFF ? 2 : 1, KW = DIFF ? 72 : 104, NQT = DIFF ? 1 : 2, QU = 64 * NQT;
  bf16_t* sK = (bf16_t*)lds; bf16_t* sV = sK + 64 * KW;
  const int tid = otid(), lane = tid & 63, w = tid >> 6, lr = lane & 15, g = lane >> 4;
  const int q0 = qb * QU, qw0 = q0 + 16 * NQT * w;
  bf16x8 qf[NM][NQT][KS];
#pragma unroll
  for (int m = 0; m < NM; ++m)
#pragma unroll
    for (int qt = 0; qt < NQT; ++qt)
#pragma unroll
      for (int ks = 0; ks < KS; ++ks) qf[m][qt][ks] = *(const bf16x8*)(Qb + (size_t)(qw0 + 16 * qt + lr) * ld + m * 32 + ks * 32 + g * 8);
  f32x4 O[NM][4][NQT]; float mrun[NM][NQT], lrun[NM][NQT];
#pragma unroll
  for (int m = 0; m < NM; ++m)
#pragma unroll
    for (int qt = 0; qt < NQT; ++qt) { mrun[m][qt] = -INFINITY; lrun[m][qt] = 0.f;
#pragma unroll
      for (int dt = 0; dt < 4; ++dt) O[m][dt][qt] = (f32x4){0.f, 0.f, 0.f, 0.f}; }
  float posq[2] = {0.f, 0.f};
  if (DIFF) { posq[0] = (float)pos[qw0 + lr]; if (NQT > 1) posq[1] = (float)pos[qw0 + 16 + lr]; }
  const float sc = DIFF ? (0.17677669529663687f * 1.4426950408889634f) : (0.10206207261596575f * 1.4426950408889634f);
  const float slope2 = DIFF ? ex2(-2.f * (float)(h + 1)) * 1.4426950408889634f : 0.f;
  const int nkt = (q0 + QU) / 64;
  const int vr = tid >> 3, vc = tid & 7;
  int kr0, kc0, kr1, kc1, kr2 = 0, kc2 = 0;
  if (DIFF) { kr0 = vr; kc0 = vc; kr1 = vr + 32; kc1 = vc; }
  else { kr0 = tid / 12; kc0 = tid - kr0 * 12; kr1 = (tid + 256) / 12; kc1 = (tid + 256) - kr1 * 12; kr2 = (tid + 512) / 12; kc2 = (tid + 512) - kr2 * 12; }
  uint4 rk0, rk1, rk2 = {0u, 0u, 0u, 0u}, rv0, rv1;
#define ATT_LOAD(j_) do { rk0 = *(const uint4*)(Kb + (size_t)(64 * (j_) + kr0) * ld + kc0 * 8); rk1 = *(const uint4*)(Kb + (size_t)(64 * (j_) + kr1) * ld + kc1 * 8); \
    if (!DIFF) rk2 = *(const uint4*)(Kb + (size_t)(64 * (j_) + kr2) * ld + kc2 * 8); \
    rv0 = *(const uint4*)(Vt + (size_t)vr * 2048 + 64 * (j_) + vc * 8); rv1 = *(const uint4*)(Vt + (size_t)(vr + 32) * 2048 + 64 * (j_) + vc * 8); } while (0)
  ATT_LOAD(0);
  for (int j = 0; j < nkt; ++j) {
    __syncthreads();
    *(uint4*)(sK + kr0 * KW + kc0 * 8) = rk0; *(uint4*)(sK + kr1 * KW + kc1 * 8) = rk1; if (!DIFF) *(uint4*)(sK + kr2 * KW + kc2 * 8) = rk2;
    *(uint4*)(sV + vr * 72 + vc * 8) = rv0; *(uint4*)(sV + (vr + 32) * 72 + vc * 8) = rv1;
    __syncthreads();
    if (j + 1 < nkt) ATT_LOAD(j + 1);
    if (64 * j <= qw0 + 16 * NQT - 1) {
      const bool domask = (64 * j + 63 > qw0);
      int4 pk[4];
      if (DIFF) {
#pragma unroll
        for (int kt = 0; kt < 4; ++kt) pk[kt] = *(const int4*)(pos + 64 * j + 16 * kt + 4 * g);
      }
#pragma unroll
      for (int m = 0; m < NM; ++m) {
        f32x4 s[4][NQT];
#pragma unroll
        for (int kt = 0; kt < 4; ++kt) {
#pragma unroll
          for (int qt = 0; qt < NQT; ++qt) s[kt][qt] = (f32x4){0.f, 0.f, 0.f, 0.f};
#pragma unroll
          for (int ks = 0; ks < KS; ++ks) {
            const bf16x8 kf = *(const bf16x8*)(sK + (16 * kt + lr) * KW + m * 32 + ks * 32 + g * 8);
#pragma unroll
            for (int qt = 0; qt < NQT; ++qt) s[kt][qt] = MFMA16(kf, qf[m][qt][ks], s[kt][qt]);
          }
        }
#pragma unroll
        for (int kt = 0; kt < 4; ++kt)
#pragma unroll
          for (int qt = 0; qt < NQT; ++qt)
#pragma unroll
            for (int i = 0; i < 4; ++i) {
              float v = s[kt][qt][i] * sc;
              if (DIFF) { const int pki = (i == 0) ? pk[kt].x : (i == 1) ? pk[kt].y : (i == 2) ? pk[kt].z : pk[kt].w; v -= slope2 * fabsf(posq[qt] - (float)pki); }
              if (domask && (64 * j + 16 * kt + 4 * g + i > qw0 + 16 * qt + lr)) v = -INFINITY;
              s[kt][qt][i] = v;
            }
#pragma unroll
        for (int qt = 0; qt < NQT; ++qt) {
          float mx = -INFINITY;
#pragma unroll
          for (int kt = 0; kt < 4; ++kt)
#pragma unroll
            for (int i = 0; i < 4; ++i) mx = fmaxf(mx, s[kt][qt][i]);
          mx = fmaxf(mx, __shfl_xor(mx, 16)); mx = fmaxf(mx, __shfl_xor(mx, 32));
          const float mn = fmaxf(mrun[m][qt], mx), alpha = ex2(mrun[m][qt] - mn); mrun[m][qt] = mn;
          float ls = 0.f;
#pragma unroll
          for (int kt = 0; kt < 4; ++kt)
#pragma unroll
            for (int i = 0; i < 4; ++i) { const float pv = ex2(s[kt][qt][i] - mn); ls += pv; s[kt][qt][i] = pv; }
          lrun[m][qt] = lrun[m][qt] * alpha + ls;
#pragma unroll
          for (int dt = 0; dt < 4; ++dt) O[m][dt][qt] = O[m][dt][qt] * alpha;
        }
#pragma unroll
        for (int s2 = 0; s2 < 2; ++s2) {
          bf16x8 pf[NQT];
#pragma unroll
          for (int qt = 0; qt < NQT; ++qt) {
            uint4 u; u.x = pk2(s[2 * s2][qt][0], s[2 * s2][qt][1]); u.y = pk2(s[2 * s2][qt][2], s[2 * s2][qt][3]);
            u.z = pk2(s[2 * s2 + 1][qt][0], s[2 * s2 + 1][qt][1]); u.w = pk2(s[2 * s2 + 1][qt][2], s[2 * s2 + 1][qt][3]);
            pf[qt] = __builtin_bit_cast(bf16x8, u);
          }
#pragma unroll
          for (int dt = 0; dt < 4; ++dt) {
            const uint2 lo = *(const uint2*)(sV + (16 * dt + lr) * 72 + 32 * s2 + 4 * g), hi = *(const uint2*)(sV + (16 * dt + lr) * 72 + 32 * s2 + 16 + 4 * g);
            uint4 u; u.x = lo.x; u.y = lo.y; u.z = hi.x; u.w = hi.y;
            const bf16x8 vf = __builtin_bit_cast(bf16x8, u);
#pragma unroll
            for (int qt = 0; qt < NQT; ++qt) O[m][dt][qt] = MFMA16(vf, pf[qt], O[m][dt][qt]);
          }
        }
      }
    }
  }
#undef ATT_LOAD
#pragma unroll
  for (int qt = 0; qt < NQT; ++qt) {
    const size_t row = (size_t)rowb + qw0 + 16 * qt + lr;
    float inv[NM];
#pragma unroll
    for (int m = 0; m < NM; ++m) { float lt = lrun[m][qt]; lt += __shfl_xor(lt, 16); lt += __shfl_xor(lt, 32); inv[m] = 1.f / lt; }
    if (!DIFF) {
#pragma unroll
      for (int dt = 0; dt < 4; ++dt) {
        const int col = h * 64 + 16 * dt + 4 * g;
        const f32x4 gt = load4bf(gate + row * LDPA + 512 + col); f32x4 o = O[0][dt][qt] * inv[0];
#pragma unroll
        for (int i = 0; i < 4; ++i) o[i] *= silu(gt[i]);
        store4bf(mixed + row * 1024 + col, o);
      }
    } else {
      f32x4 o[4]; float ss = 0.f;
#pragma unroll
      for (int dt = 0; dt < 4; ++dt) { o[dt] = O[0][dt][qt] * inv[0] - O[NM - 1][dt][qt] * (lam_full * inv[NM - 1]); ss += o[dt][0] * o[dt][0] + o[dt][1] * o[dt][1] + o[dt][2] * o[dt][2] + o[dt][3] * o[dt][3]; }
      ss += __shfl_xor(ss, 16); ss += __shfl_xor(ss, 32);
      const float rs = (1.f / sqrtf(ss * (1.f / 64.f) + 1e-5f)) * (1.f - lam_init);
#pragma unroll
      for (int dt = 0; dt < 4; ++dt) {
        const int dvc = 16 * dt + 4 * g, col = h * 64 + dvc;
        const f32x4 gs = *(const f32x4*)(gsub + dvc); const f32x4 gt = load4bf(gate + row * LDPA + 512 + 384 + col);
        f32x4 r;
#pragma unroll
        for (int i = 0; i < 4; ++i) r[i] = o[dt][i] * rs * gs[i] * silu(gt[i]);
        store4bf(mixed + row * 1024 + 384 + col, r);
      }
    }
  }
}

DI void p4_unit(unsigned char* lds, const KP& p, int l, int rt) {
  unsigned char* ws = p.ws;
  const int tid = otid(), lane = tid & 63, w = tid >> 6, row0 = rt * 64;
  const bf16_t* rbuf = (const bf16_t*)(ws + OFF_SC); const bf16_t* kbuf = rbuf + (size_t)T * 384; const bf16_t* vbuf = kbuf + (size_t)T * 384;
  const bf16_t* ybuf = (const bf16_t*)(ws + OFF_R2); bf16_t* mixed = (bf16_t*)(ws + OFF_R2 + SZ_SC);
  const bf16_t* pA = (const bf16_t*)(ws + OFF_PA);
  const float* lnw = p.in[23] + l * 384; const float* lnb = p.in[24] + l * 384; const float* rk = p.in[22] + l * 384;
  {
    float lw[6], lb[6], rkk[6];
#pragma unroll
    for (int h = 0; h < 6; ++h) { lw[h] = lnw[h * 64 + lane]; lb[h] = lnb[h * 64 + lane]; rkk[h] = rk[h * 64 + lane]; }
    for (int t = w; t < 64; t += 4) {
      const int row = row0 + t; const size_t o = (size_t)row * 384 + lane;
      float y[6], r[6], k[6], v[6], gt[6];
#pragma unroll
      for (int h = 0; h < 6; ++h) { y[h] = bf2f(ybuf[o + h * 64]); r[h] = bf2f(rbuf[o + h * 64]); k[h] = bf2f(kbuf[o + h * 64]); v[h] = bf2f(vbuf[o + h * 64]); gt[h] = bf2f(pA[(size_t)row * LDPA + 512 + 640 + h * 64 + lane]); }
#pragma unroll
      for (int h = 0; h < 6; ++h) {
        const float mean = wave_sum(y[h]) * (1.f / 64.f); const float d = y[h] - mean; const float var = wave_sum(d * d) * (1.f / 64.f);
        const float dot = wave_sum(r[h] * k[h] * rkk[h]);
        const float outv = d * (1.f / sqrtf(var + 64e-5f)) * lw[h] + lb[h] + dot * v[h];
        mixed[(size_t)row * 1024 + 640 + h * 64 + lane] = (bf16_t)f2bf(outv * silu(gt[h]));
      }
    }
  }
  __syncthreads();
  const bf16_t* WoT = (const bf16_t*)(ws + OFF_WO + l * SZ_WO);
  EpiOut eo{l == 0 ? p.in[0] : p.out, p.out};
  for (int ct = 0; ct < 8; ++ct) gemm_tile<2>(lds, mixed, 1024, WoT, 1024, 1024, row0, ct * 128, eo);
  __syncthreads();
  if (l == 0) norm_rows_bf16(p.out, p.in[2] + 1024, (bf16_t*)(ws + OFF_R1), row0, row0 + 64, w, 4, lane);
  else {
    const float* fg = p.in[25];
    for (int row = row0 + w; row < row0 + 64; row += 4) {
      f32x4* xr = (f32x4*)(p.out + (size_t)row * 1024) + lane;
      f32x4 v[4]; float s = 0.f;
#pragma unroll
      for (int j = 0; j < 4; ++j) { v[j] = xr[64 * j]; s += v[j][0] * v[j][0] + v[j][1] * v[j][1] + v[j][2] * v[j][2] + v[j][3] * v[j][3]; }
      const float rstd = 1.f / sqrtf(wave_sum(s) * (1.f / 1024.f) + 1e-6f);
#pragma unroll
      for (int j = 0; j < 4; ++j) { const f32x4 gg = *((const f32x4*)fg + lane + 64 * j); xr[64 * j] = v[j] * rstd * gg; }
    }
  }
}

DI void p3_run(unsigned char* lds, int* s_unit, const KP& p, int l) {
  unsigned char* ws = p.ws;
  const int tid = otid();
  unsigned* ctrS = (unsigned*)(ws + OFF_CTL) + 16 * (2 * l + 1);
  unsigned* ctrA = (unsigned*)(ws + OFF_CTL) + 16 * (2 * l + 2);
  unsigned* cucnt = (unsigned*)(ws + OFF_CU) + 4096 * l;
  const bf16_t* pA = (const bf16_t*)(ws + OFF_PA);
  const bf16_t* Qm = (const bf16_t*)(ws + OFF_R1); const bf16_t* Km = Qm + (size_t)T * 576;
  bf16_t* mixed = (bf16_t*)(ws + OFF_R2 + SZ_SC);
  const int* pos = (const int*)p.in[1];
  const float* lam = p.in[10] + l * 128;
  float d0 = 0.f, d1 = 0.f;
  for (int i = 0; i < 32; ++i) { d0 += lam[i] * lam[32 + i]; d1 += lam[64 + i] * lam[96 + i]; }
  const float lam_init = 0.8f - 0.6f * expf(-0.3f * (float)(l + 1));
  const float lam_full = expf(d0) - expf(d1) + lam_init;
  bool prefer_scan = false, sdone = false;
  if (tid == 0) {
    const unsigned xcc = (unsigned)__builtin_amdgcn_s_getreg((3 << 11) | 20) & 0xFu;
    const unsigned cu = (unsigned)__builtin_amdgcn_s_getreg((7 << 11) | (8 << 6) | 4) & 0xFFu;
    prefer_scan = (atomicAdd(cucnt + ((xcc << 8) | cu), 1u) == 0u);
  }
  for (;;) {
    __syncthreads();
    if (tid == 0) {
      int code = -1;
      if (prefer_scan && !sdone) { const unsigned u = atomicAdd(ctrS, 1u); if (u < (unsigned)NSCAN) code = (int)u; else sdone = true; }
      if (code < 0) { const unsigned u = atomicAdd(ctrA, 1u); if (u < (unsigned)NATT) code = NSCAN + (int)u; }
      if (code < 0 && !sdone) { const unsigned u = atomicAdd(ctrS, 1u); if (u < (unsigned)NSCAN) code = (int)u; else sdone = true; }
      *s_unit = code;
    }
    __syncthreads();
    const int u = *s_unit;
    if (u < 0) break;
    if (u < NSCAN) scan_unit(lds, p, u);
    else if (u < NSCAN + NMLA) {
      const int v = u - NSCAN, qb = 15 - v / 96, bh = v % 96, b = bh / 6, h = bh - b * 6;
      attn_unit<false>(lds, Qm + (size_t)b * 2048 * 576 + h * 96, Km + (size_t)b * 2048 * 576 + h * 96, 576, (const bf16_t*)(ws + OFF_VTM) + (size_t)bh * 64 * 2048,
                       pA, mixed, pos, qb, h, b * 2048, 0.f, 0.f, nullptr);
    } else {
      const int v = u - NSCAN - NMLA, qb = 31 - v / 64, bh = v % 64, b = bh >> 2, h = bh & 3;
      attn_unit<true>(lds, pA + (size_t)b * 2048 * LDPA + h * 64, pA + (size_t)b * 2048 * LDPA + 256 + h * 64, LDPA, (const bf16_t*)(ws + OFF_VTD) + (size_t)bh * 64 * 2048,
                      pA, mixed, pos, qb, h, b * 2048, lam_full, lam_init, p.in[11] + l * 64);
    }
  }
}

DI void gbar(unsigned* bw, unsigned nblk) {
  asm volatile("s_waitcnt vmcnt(0)" ::: "memory");
  __syncthreads();
  if (threadIdx.x == 0) {
    __builtin_amdgcn_fence(__ATOMIC_RELEASE, "agent");
    asm volatile("s_waitcnt vmcnt(0)" ::: "memory");
    const unsigned g = __hip_atomic_load(bw + 64, __ATOMIC_RELAXED, __HIP_MEMORY_SCOPE_AGENT);
    const unsigned prev = __hip_atomic_fetch_add(bw, 1u, __ATOMIC_RELAXED, __HIP_MEMORY_SCOPE_AGENT);
    if (prev == nblk - 1u) {
      __hip_atomic_store(bw, 0u, __ATOMIC_RELAXED, __HIP_MEMORY_SCOPE_AGENT);
      __builtin_amdgcn_fence(__ATOMIC_RELEASE, "agent");
      __hip_atomic_fetch_add(bw + 64, 1u, __ATOMIC_RELAXED, __HIP_MEMORY_SCOPE_AGENT);
    } else {
      while (__hip_atomic_load(bw + 64, __ATOMIC_RELAXED, __HIP_MEMORY_SCOPE_AGENT) == g) __builtin_amdgcn_s_sleep(1);
    }
    __builtin_amdgcn_fence(__ATOMIC_ACQUIRE, "agent");
    asm volatile("s_waitcnt vmcnt(0)" ::: "memory");
  }
  __syncthreads();
}

__global__ void __launch_bounds__(NTH, 2) mk_fwd(KP p) {
  __shared__ __attribute__((aligned(16))) unsigned char lds[36864 + 1024];
  __shared__ int s_unit;
  cg::grid_group grid = cg::this_grid();
  unsigned char* ws = p.ws;
  const int tid = otid(), lane = tid & 63, w = tid >> 6;
  const int G = gridDim.x, bid = blockIdx.x;
#define RUN(k) (p.ph_lo <= (k) && (k) < p.ph_hi)
#define SEAM(k) do { if (RUN(k) && RUN((k) + 1)) { if ((k) == 0) grid.sync(); else gbar((unsigned*)(ws + OFF_CTL) + 512, (unsigned)G); } } while (0)

  if (RUN(0)) {
    const int gt = bid * NTH + tid, ngt = G * NTH;
    for (int i = gt; i < 2 * 4096; i += ngt) ((unsigned*)(ws + OFF_CU))[i] = 0u;
    for (int l = 0; l < 2; ++l) {
      bf16_t* Wc = (bf16_t*)(ws + OFF_WC + l * SZ_WC);
      if (l == 0) convT(p.in[3], 1024, 3488, Wc, 1024, NP, nullptr, gt, ngt);
      else { convT(p.in[3] + (size_t)1024 * 3488, 1024, 3488, Wc, 1024, 3488, nullptr, gt, ngt); convT(p.in[4], 1024, 32, Wc + (size_t)3488 * 1024, 1024, 96, nullptr, gt, ngt); }
      convT(p.in[5] + (size_t)l * 1024 * 1024, 1024, 1024, (bf16_t*)(ws + OFF_WO + l * SZ_WO), 1024, 1024, nullptr, gt, ngt);
      convT(p.in[8] + (size_t)l * 256 * 576, 256, 576, (bf16_t*)(ws + OFF_WUQ + l * SZ_WUQ), 256, 640, p.in[6] + l * 256, gt, ngt);
      convT(p.in[9] + (size_t)l * 128 * 768, 128, 768, (bf16_t*)(ws + OFF_WUKV + l * SZ_WUKV), 128, 768, p.in[7] + l * 128, gt, ngt);
      convT(p.in[15] + (size_t)l * 64 * 384, 64, 384, (bf16_t*)(ws + OFF_W2 + l * SZ_L), 64, 384, nullptr, gt, ngt);
      convT(p.in[17] + (size_t)l * 64 * 384, 64, 384, (bf16_t*)(ws + OFF_A2 + l * SZ_L), 64, 384, nullptr, gt, ngt);
    }
    convT(p.in[19], 32, 384, (bf16_t*)(ws + OFF_V2), 64, 384, nullptr, gt, ngt);
    {
      float* tab = (float*)(ws + OFF_TAB); const int* pos = (const int*)p.in[1];
      for (int idx = gt; idx < 2048 * 16; idx += ngt) {
        const int s = idx >> 4, i = idx & 15;
        const float inv = exp2f(-(float)i * (13.287712379549449f / 16.f));
        const float ang = (float)pos[s] * inv;
        double rev = (double)ang * 0.15915494309189535; rev -= __builtin_rint(rev);
        tab[s * 32 + i] = __builtin_amdgcn_cosf((float)rev); tab[s * 32 + 16 + i] = __builtin_amdgcn_sinf((float)rev);
      }
    }
    norm_rows_bf16(p.in[0], p.in[2], (bf16_t*)(ws + OFF_R1), 0, T, bid * 4 + w, G * 4, lane);
  }
  SEAM(0);
#if PROBE == 8
  for (int i = 0; i < 10; ++i) grid.sync();
#endif
#if PROBE == 6
  if (RUN(0)) { norm_rows_bf16(p.in[0], p.in[2], (bf16_t*)(ws + OFF_R1), 0, T, bid * 4 + w, G * 4, lane); grid.sync(); }
#endif
  for (int l = 0; l < 2; ++l) {
    const int pb = 1 + 4 * l;
    if (RUN(pb)) {
      EpiRoute e{(bf16_t*)(ws + OFF_PA), (bf16_t*)(ws + OFF_R2), (bf16_t*)(ws + OFF_VTD), l ? 3520 : 3488};
      const bf16_t* hb = (const bf16_t*)(ws + OFF_R1); const bf16_t* Wc = (const bf16_t*)(ws + OFF_WC + l * SZ_WC);
      for (int rep = 0; rep < ((PROBE == 1 && l == 0) ? 2 : 1); ++rep)
      for (int u = bid; u < 256 * 28; u += G) { const int rt = u / 28, ct = u - rt * 28; gemm_tile<4>(lds, hb, 1024, Wc, 1024, 1024, rt * 128, ct * 128, e); }
    }
    SEAM(pb);
    if (RUN(pb + 1)) { for (int rep = 0; rep < ((PROBE == 2 && l == 0) ? 2 : 1); ++rep) { if (rep) grid.sync(); for (int rt = bid; rt < 512; rt += G) p2_unit(lds, p, l, rt); } }
    SEAM(pb + 1);
    if (RUN(pb + 2)) {
      p3_run(lds, &s_unit, p, l);
#if PROBE == 3
      if (l == 0) { grid.sync(); for (int u = bid; u < NSCAN; u += G) { __syncthreads(); scan_unit(lds, p, u); } }
#endif
    }
    SEAM(pb + 2);
    if (RUN(pb + 3)) { for (int rep = 0; rep < ((PROBE == 5 && l == 0) ? 2 : 1); ++rep) { if (rep) grid.sync(); for (int rt = bid; rt < 512; rt += G) p4_unit(lds, p, l, rt); } }
    SEAM(pb + 3);
  }
#undef RUN
#undef SEAM
}

extern "C" void kernel_launch(void* const* d_in, const int* in_sizes, int n_in, void* d_out, int out_size, void* d_ws, size_t ws_size, hipStream_t stream) {
  static int grid = 0;
  if (grid == 0) {
    if (n_in != 26 || ws_size < WS_END) { fprintf(stderr, "kernel_launch: need 26 inputs and %zu bytes of workspace (got %d, %zu)\n", (size_t)WS_END, n_in, ws_size); grid = -1; return; }
    int dev = 0, cus = 0, per_cu = 0;
    (void)hipGetDevice(&dev);
    (void)hipDeviceGetAttribute(&cus, hipDeviceAttributeMultiprocessorCount, dev);
    (void)hipOccupancyMaxActiveBlocksPerMultiprocessor(&per_cu, (const void*)mk_fwd, NTH, 0);
    if (per_cu > 2) per_cu = 2;
    if (per_cu < 1) { fprintf(stderr, "kernel_launch: occupancy query returned %d\n", per_cu); per_cu = 1; }
    grid = cus * per_cu;
  }
  if (grid < 0) return;
  (void)hipMemsetAsync(d_ws, 0, 4096, stream);
  KP p{};
  for (int i = 0; i < 26; ++i) p.in[i] = (const float*)d_in[i];
  p.out = (float*)d_out; p.ws = (unsigned char*)d_ws;
  if (MK_LAUNCHES == 1) {
    p.ph_lo = 0; p.ph_hi = NPHASE;
    void* args[] = {&p};
    hipError_t e = hipLaunchCooperativeKernel((const void*)mk_fwd, dim3(grid), dim3(NTH), args, 0, stream);
    if (e != hipSuccess) fprintf(stderr, "cooperative launch failed: %s (grid %d)\n", hipGetErrorString(e), grid);
  } else {
    for (int k = 0; k < NPHASE; ++k) { p.ph_lo = k; p.ph_hi = k + 1; hipLaunchKernelGGL(mk_fwd, dim3(grid), dim3(NTH), 0, stream, p); }
  }
}
```

```cpp
#include <hip/hip_runtime.h>
#include <hip/hip_cooperative_groups.h>
#include <cstdio>
#include <cstdint>
namespace cg = cooperative_groups;

#ifndef PROBE
#define PROBE 0
#endif
#ifndef MK_LAUNCHES
#define MK_LAUNCHES 1
#endif

typedef unsigned short bf16_t;
typedef short bf16x8 __attribute__((ext_vector_type(8)));
typedef float f32x4 __attribute__((ext_vector_type(4)));
#define DI __device__ __forceinline__

constexpr int NB = 16, SEQ = 2048, T = NB * SEQ, DM = 1024;
constexpr int NP = 3584;
constexpr int LDPA = 1536;
constexpr int LDPB = 1728;
constexpr int NPHASE = 9;
constexpr int LDS_BYTES = 73728 + 1024 + 1024;
constexpr int NTH = 256;
constexpr int NSCAN = 192, NMLA = 96 * 16, NDIFF = 64 * 32, NATT = NMLA + NDIFF;

constexpr size_t OFF_CTL = 0;
constexpr size_t OFF_TAB = 4096;
constexpr size_t SZ_WC = (size_t)NP * 1024 * 2;
constexpr size_t OFF_WC = OFF_TAB + 262144;
constexpr size_t SZ_WO = (size_t)1024 * 1024 * 2;
constexpr size_t OFF_WO = OFF_WC + 2 * SZ_WC;
constexpr size_t SZ_WUQ = (size_t)640 * 256 * 2;
constexpr size_t OFF_WUQ = OFF_WO + 2 * SZ_WO;
constexpr size_t SZ_WUKV = (size_t)768 * 128 * 2;
constexpr size_t OFF_WUKV = OFF_WUQ + 2 * SZ_WUQ;
constexpr size_t SZ_L = (size_t)384 * 64 * 2;
constexpr size_t OFF_W2 = OFF_WUKV + 2 * SZ_WUKV;
constexpr size_t OFF_A2 = OFF_W2 + 2 * SZ_L;
constexpr size_t OFF_V2 = OFF_A2 + 2 * SZ_L;
constexpr size_t OFF_R1 = OFF_V2 + SZ_L;
constexpr size_t SZ_QK = (size_t)T * 576 * 2;
constexpr size_t OFF_PA = OFF_R1 + 2 * SZ_QK;
constexpr size_t OFF_R2 = OFF_PA + (size_t)T * LDPA * 2;
constexpr size_t OFF_VTM = OFF_R2 + (size_t)T * LDPB * 2;
constexpr size_t OFF_VTD = OFF_VTM + (size_t)T * 384 * 2;
constexpr size_t SZ_SC = (size_t)T * 384 * 2;
constexpr size_t OFF_SC = OFF_VTD + (size_t)T * 256 * 2;
constexpr size_t OFF_LA = OFF_SC + 6 * SZ_SC;
constexpr size_t OFF_CU = OFF_LA + (size_t)T * 192 * 2;
constexpr size_t WS_END = OFF_CU + 3 * 4096 * 4;
static_assert(OFF_R1 % 256 == 0, "align");

struct KP { const float* in[26]; float* out; unsigned char* ws; int ph_lo, ph_hi; };

DI unsigned f2bf(float f) { unsigned u = __float_as_uint(f); return (u + 0x7fffu + ((u >> 16) & 1u)) >> 16; }
DI float bf2f(bf16_t h) { return __uint_as_float(((unsigned)h) << 16); }
typedef __bf16 bf2v_t __attribute__((ext_vector_type(2)));
typedef float f2v_t __attribute__((ext_vector_type(2)));
DI unsigned pk2(float a, float b) { f2v_t f = {a, b}; return __builtin_bit_cast(unsigned, __builtin_convertvector(f, bf2v_t)); }
DI void store4bf(bf16_t* p, f32x4 v) { uint2 u; u.x = pk2(v[0], v[1]); u.y = pk2(v[2], v[3]); *(uint2*)p = u; }
DI f32x4 up4(uint2 u) { f32x4 r; r[0] = __uint_as_float(u.x << 16); r[1] = __uint_as_float(u.x & 0xffff0000u); r[2] = __uint_as_float(u.y << 16); r[3] = __uint_as_float(u.y & 0xffff0000u); return r; }
DI f32x4 load4bf(const bf16_t* p) { return up4(*(const uint2*)p); }
DI float wave_sum(float v) {
#pragma unroll
  for (int o = 1; o < 64; o <<= 1) v += __shfl_xor(v, o);
  return v;
}
DI float ex2(float x) { return __builtin_amdgcn_exp2f(x); }
DI float fexp(float x) { return __builtin_amdgcn_exp2f(x * 1.4426950408889634f); }
DI float sigm(float x) { return 1.f / (1.f + fexp(-x)); }
DI float silu(float x) { return x / (1.f + fexp(-x)); }
template <int CTRL> DI float dppmov(float x) { return __builtin_bit_cast(float, __builtin_amdgcn_update_dpp(0, __builtin_bit_cast(int, x), CTRL, 0xF, 0xF, true)); }
DI float rowsum16(float x) {
  x += dppmov<0xB1>(x);
  x += dppmov<0x4E>(x);
  x += dppmov<0x124>(x);
  x += dppmov<0x128>(x);
  return x;
}
DI int otid() { int t = threadIdx.x; asm volatile("" : "+v"(t)); return t; }
#define MFMA16(a, b, c) __builtin_amdgcn_mfma_f32_16x16x32_bf16((a), (b), (c), 0, 0, 0)

template <int MI, class Epi>
DI void gemm_tile(unsigned char* lds, const bf16_t* __restrict__ A, int lda, const bf16_t* __restrict__ Bt, int ldb, int K, int row0, int col0, const Epi& epi) {
  constexpr int BM = 32 * MI;
  constexpr int BUFE = (BM + 128) * 72;
  bf16_t* sbase = (bf16_t*)lds;
  const int tid = otid(), lane = tid & 63, w = tid >> 6, wm = w >> 1, wn = w & 1, lr = lane & 15, g = lane >> 4;
  const int sr = tid >> 3, skc = tid & 7;
  const bf16_t* gA = A + (size_t)(row0 + sr) * lda + skc * 8;
  const bf16_t* gB = Bt + (size_t)(col0 + sr) * ldb + skc * 8;
  uint4 ra0, ra1, ra2 = {0u, 0u, 0u, 0u}, ra3 = {0u, 0u, 0u, 0u}, rb0, rb1, rb2, rb3;
#define G_LOAD(k0_) do { ra0 = *(const uint4*)(gA + (k0_)); ra1 = *(const uint4*)(gA + (size_t)32 * lda + (k0_)); \
    if (MI == 4) { ra2 = *(const uint4*)(gA + (size_t)64 * lda + (k0_)); ra3 = *(const uint4*)(gA + (size_t)96 * lda + (k0_)); } \
    rb0 = *(const uint4*)(gB + (k0_)); rb1 = *(const uint4*)(gB + (size_t)32 * ldb + (k0_)); rb2 = *(const uint4*)(gB + (size_t)64 * ldb + (k0_)); rb3 = *(const uint4*)(gB + (size_t)96 * ldb + (k0_)); } while (0)
#define G_STORE(buf_) do { bf16_t* sA_ = sbase + (buf_) * BUFE; bf16_t* sB_ = sA_ + BM * 72; \
    *(uint4*)(sA_ + sr * 72 + skc * 8) = ra0; *(uint4*)(sA_ + (sr + 32) * 72 + skc * 8) = ra1; \
    if (MI == 4) { *(uint4*)(sA_ + (sr + 64) * 72 + skc * 8) = ra2; *(uint4*)(sA_ + (sr + 96) * 72 + skc * 8) = ra3; } \
    *(uint4*)(sB_ + sr * 72 + skc * 8) = rb0; *(uint4*)(sB_ + (sr + 32) * 72 + skc * 8) = rb1; *(uint4*)(sB_ + (sr + 64) * 72 + skc * 8) = rb2; *(uint4*)(sB_ + (sr + 96) * 72 + skc * 8) = rb3; } while (0)
  f32x4 acc[MI][4];
#pragma unroll
  for (int mi = 0; mi < MI; ++mi)
#pragma unroll
    for (int ni = 0; ni < 4; ++ni) acc[mi][ni] = (f32x4){0.f, 0.f, 0.f, 0.f};
  const int nk = K >> 6;
  G_LOAD(0);
  G_STORE(0);
  if (nk > 1) G_LOAD(64);
  __syncthreads();
  for (int kt = 0; kt < nk; ++kt) {
    const int cur = kt & 1;
    if (kt + 1 < nk) { G_STORE(cur ^ 1); if (kt + 2 < nk) G_LOAD((kt + 2) * 64); }
    const bf16_t* sA = sbase + cur * BUFE; const bf16_t* sB = sA + BM * 72;
#pragma unroll
    for (int ks = 0; ks < 2; ++ks) {
      bf16x8 af[MI], bfr[4];
#pragma unroll
      for (int mi = 0; mi < MI; ++mi) af[mi] = *(const bf16x8*)(sA + (wm * 16 * MI + mi * 16 + lr) * 72 + ks * 32 + g * 8);
#pragma unroll
      for (int ni = 0; ni < 4; ++ni) bfr[ni] = *(const bf16x8*)(sB + (wn * 64 + ni * 16 + lr) * 72 + ks * 32 + g * 8);
#pragma unroll
      for (int mi = 0; mi < MI; ++mi)
#pragma unroll
        for (int ni = 0; ni < 4; ++ni) acc[mi][ni] = MFMA16(bfr[ni], af[mi], acc[mi][ni]);
    }
    __syncthreads();
  }
#undef G_STORE
#pragma unroll
  for (int mi = 0; mi < MI; ++mi)
#pragma unroll
    for (int ni = 0; ni < 4; ++ni) epi(row0 + wm * 16 * MI + mi * 16 + lr, col0 + wn * 64 + ni * 16 + 4 * g, acc[mi][ni]);
#undef G_LOAD
}

struct EpiRoute {
  bf16_t* pA; bf16_t* pB; bf16_t* VtD; int ncols;
  DI void operator()(int row, int col, f32x4 v) const {
    if (col >= ncols) return;
    if (col < 416) store4bf(pB + (size_t)row * LDPB + col, v);
    else if (col < 928) store4bf(pA + (size_t)row * LDPA + (col - 416), v);
    else if (col < 1184) {
      const int c = col - 928, h = c >> 6, dv = c & 63, b = row >> 11, s = row & 2047;
      bf16_t* q = VtD + ((size_t)((b * 4 + h) * 64 + dv)) * 2048 + s;
      q[0] = (bf16_t)f2bf(v[0]); q[2048] = (bf16_t)f2bf(v[1]); q[4096] = (bf16_t)f2bf(v[2]); q[6144] = (bf16_t)f2bf(v[3]);
    }
    else if (col < 2208) store4bf(pA + (size_t)row * LDPA + 512 + (col - 1184), v);
    else store4bf(pB + (size_t)row * LDPB + 416 + (col - 2208), v);
  }
};
struct EpiQ {
  bf16_t* __restrict__ Qm; const float* __restrict__ rs; int row0;
  DI void operator()(int row, int col, f32x4 v) const {
    if (col >= 576) return;
    const float r = rs[row - row0]; v = v * r;
    store4bf(Qm + (size_t)row * 576 + col, v);
  }
};
struct EpiKV {
  bf16_t* __restrict__ Km; bf16_t* __restrict__ VtM; const float* __restrict__ rs; int row0;
  DI void operator()(int row, int col, f32x4 v) const {
    const float r = rs[row - row0]; v = v * r;
    const int head = col >> 7, c = col & 127;
    if (c < 64) store4bf(Km + (size_t)row * 576 + head * 96 + c, v);
    else {
      const int b = row >> 11, s = row & 2047;
      bf16_t* q = VtM + ((size_t)((b * 6 + head) * 64 + (c - 64))) * 2048 + s;
      q[0] = (bf16_t)f2bf(v[0]); q[2048] = (bf16_t)f2bf(v[1]); q[4096] = (bf16_t)f2bf(v[2]); q[6144] = (bf16_t)f2bf(v[3]);
    }
  }
};
struct EpiW {
  bf16_t* __restrict__ wbuf; const float* __restrict__ w0;
  DI void operator()(int row, int col, f32x4 v) const {
    f32x4 o;
#pragma unroll
    for (int i = 0; i < 4; ++i) { const float val = v[i] + w0[col + i]; const float wv = -__logf(1.f + fexp(-val)) - 0.5f; o[i] = -fexp(wv); }
    store4bf(wbuf + (size_t)row * 384 + col, o);
  }
};
struct EpiA {
  bf16_t* __restrict__ abuf; bf16_t* __restrict__ kbuf; const bf16_t* __restrict__ kraw; const float* __restrict__ a0; const float* __restrict__ ka;
  DI void operator()(int row, int col, f32x4 v) const {
    f32x4 kr = load4bf(kraw + (size_t)row * 384 + col), a, kn;
#pragma unroll
    for (int i = 0; i < 4; ++i) { a[i] = sigm(v[i] + a0[col + i]); kn[i] = kr[i] * (1.f + (a[i] - 1.f) * ka[col + i]); }
    store4bf(abuf + (size_t)row * 384 + col, a);
    store4bf(kbuf + (size_t)row * 384 + col, kn);
  }
};
struct EpiV {
  bf16_t* vbuf; const bf16_t* pB; const float* v0; const float* mu;
  DI void operator()(int row, int col, f32x4 v) const {
    const int s = row & 2047;
    f32x4 p = load4bf(pB + (size_t)row * LDPB + 416 + 768 + col), pr = (f32x4){0.f, 0.f, 0.f, 0.f};
    if (s > 0) pr = load4bf(pB + (size_t)(row - 1) * LDPB + 416 + 768 + col);
    f32x4 vf = load4bf(vbuf + (size_t)row * 384 + col), o;
#pragma unroll
    for (int i = 0; i < 4; ++i) { const float xv = p[i] + (pr[i] - p[i]) * mu[768 + col + i]; const float sg = sigm(v[i] + v0[col + i]); o[i] = xv + (vf[i] - xv) * sg; }
    store4bf(vbuf + (size_t)row * 384 + col, o);
  }
};
struct EpiOut {
  const float* xin; float* xout;
  DI void operator()(int row, int col, f32x4 v) const {
    const f32x4 x = *(const f32x4*)(xin + (size_t)row * 1024 + col);
    *(f32x4*)(xout + (size_t)row * 1024 + col) = x + v;
  }
};

DI void convT(const float* __restrict__ src, int K, int N, bf16_t* dst, int Kpad, int NR, const float* scale, int gt, int ngt) {
  const int kcN = Kpad >> 3, total = NR * kcN;
  for (int idx = gt; idx < total; idx += ngt) {
    const int n = idx % NR, kc = idx / NR; uint4 o = {0u, 0u, 0u, 0u};
    if (n < N) {
      float v[8];
#pragma unroll
      for (int j = 0; j < 8; ++j) { const int k = kc * 8 + j; v[j] = (k < K) ? src[(size_t)k * N + n] * (scale ? scale[k] : 1.f) : 0.f; }
      o.x = pk2(v[0], v[1]); o.y = pk2(v[2], v[3]); o.z = pk2(v[4], v[5]); o.w = pk2(v[6], v[7]);
    }
    *(uint4*)(dst + (size_t)n * Kpad + kc * 8) = o;
  }
}
DI void norm_rows_bf16(const float* x, const float* gain, bf16_t* hb, int rbeg, int rend, int gw, int ngw, int lane) {
  for (int row = rbeg + gw; row < rend; row += ngw) {
    const f32x4* xr = (const f32x4*)(x + (size_t)row * 1024) + lane;
    f32x4 v[4]; float s = 0.f;
#pragma unroll
    for (int j = 0; j < 4; ++j) { v[j] = xr[64 * j]; s += v[j][0] * v[j][0] + v[j][1] * v[j][1] + v[j][2] * v[j][2] + v[j][3] * v[j][3]; }
    const float rstd = 1.f / sqrtf(wave_sum(s) * (1.f / 1024.f) + 1e-6f);
#pragma unroll
    for (int j = 0; j < 4; ++j) { const f32x4 gg = *((const f32x4*)gain + lane + 64 * j); store4bf(hb + (size_t)row * 1024 + 4 * lane + 256 * j, v[j] * rstd * gg); }
  }
}

DI void p2_unit(unsigned char* lds, const KP& p, int l, int rt, int parts = 3) {
  unsigned char* ws = p.ws;
  const int tid = otid(), lane = tid & 63, w = tid >> 6, row0 = rt * 64;
  bf16_t* pB = (bf16_t*)(ws + OFF_R2);
  bf16_t* Qm = (bf16_t*)(ws + OFF_R1); bf16_t* Km = Qm + (size_t)T * 576;
  bf16_t* VtM = (bf16_t*)(ws + OFF_VTM);
  bf16_t* rbuf = (bf16_t*)(ws + OFF_SC); bf16_t* kbuf = rbuf + (size_t)T * 384; bf16_t* vbuf = kbuf + (size_t)T * 384;
  bf16_t* wbuf = vbuf + (size_t)T * 384; bf16_t* kkbuf = wbuf + (size_t)T * 384; bf16_t* abuf = kkbuf + (size_t)T * 384;
  bf16_t* LA = (bf16_t*)(ws + OFF_LA);
  const float* tab = (const float*)(ws + OFF_TAB);
  float* sRq = (float*)(lds + 73728); float* sRkv = sRq + 64;
  __syncthreads();
  if (parts & 1) {
    const int r = tid >> 2, part = tid & 3; const bf16_t* pr = pB + (size_t)(row0 + r) * LDPB;
    float sq = 0.f, sk = 0.f;
#pragma unroll
    for (int j = 0; j < 16; ++j) { f32x4 v = load4bf(pr + part * 64 + j * 4); sq += v[0] * v[0] + v[1] * v[1] + v[2] * v[2] + v[3] * v[3]; }
#pragma unroll
    for (int j = 0; j < 8; ++j) { f32x4 v = load4bf(pr + 256 + part * 32 + j * 4); sk += v[0] * v[0] + v[1] * v[1] + v[2] * v[2] + v[3] * v[3]; }
    sq += __shfl_xor(sq, 1); sq += __shfl_xor(sq, 2); sk += __shfl_xor(sk, 1); sk += __shfl_xor(sk, 2);
    if (part == 0) { sRq[r] = 1.f / sqrtf(sq * (1.f / 256.f) + 1e-6f); sRkv[r] = 1.f / sqrtf(sk * (1.f / 128.f) + 1e-6f); }
  }
  if (parts & 2) {
    const float* mu = p.in[12] + l * 1280; const float* kkw = p.in[20] + l * 384;
    float mur[6], muk[6], muv_[6], kkw_[6];
#pragma unroll
    for (int h = 0; h < 6; ++h) { mur[h] = mu[h * 64 + lane]; muk[h] = mu[384 + h * 64 + lane]; muv_[h] = mu[768 + h * 64 + lane]; kkw_[h] = kkw[h * 64 + lane]; }
    for (int t = w; t < 64; t += 4) {
      const int row = row0 + t, s = row & 2047;
      const bf16_t* pc = pB + (size_t)row * LDPB + 416 + lane;
      const bf16_t* pp = (s > 0) ? pc - LDPB : pc;
      const float pm = (s > 0) ? 1.f : 0.f;
      float cr[6], ck[6], cv[6], qr[6], qk[6], qv[6];
#pragma unroll
      for (int h = 0; h < 6; ++h) { cr[h] = bf2f(pc[h * 64]); ck[h] = bf2f(pc[384 + h * 64]); cv[h] = bf2f(pc[768 + h * 64]); qr[h] = bf2f(pp[h * 64]) * pm; qk[h] = bf2f(pp[384 + h * 64]) * pm; qv[h] = bf2f(pp[768 + h * 64]) * pm; }
#pragma unroll
      for (int h = 0; h < 6; ++h) {
        const float xr = cr[h] + (qr[h] - cr[h]) * mur[h], xk = ck[h] + (qk[h] - ck[h]) * muk[h], xv = cv[h] + (qv[h] - cv[h]) * muv_[h];
        const float kv_ = xk * kkw_[h]; const float ss = wave_sum(kv_ * kv_);
        const float kk = kv_ / fmaxf(sqrtf(ss), 1e-12f);
        const size_t o = (size_t)row * 384 + h * 64 + lane;
        rbuf[o] = (bf16_t)f2bf(xr); wbuf[o] = (bf16_t)f2bf(xk); kkbuf[o] = (bf16_t)f2bf(kk);
        if (l == 0) vbuf[o] = (bf16_t)f2bf(xv);
      }
    }
    const float* muv = p.in[13];
    if (tid < 192) {
      const int j = tid; const bool act = (j < 128) || (j < 160 && l > 0);
      const int sc_ = 1152 + j;
      const float m = (j < 128) ? mu[sc_] : (j < 160 ? muv[j - 128] : 0.f);
      for (int tb = 0; tb < 64; tb += 8) {
        float a[8], bq[8];
#pragma unroll
        for (int u = 0; u < 8; ++u) {
          const int row = row0 + tb + u, s = row & 2047;
          const bf16_t* pc = pB + (size_t)row * LDPB + 416 + sc_;
          a[u] = act ? bf2f(pc[0]) : 0.f; bq[u] = (act && s > 0) ? bf2f(pc[-LDPB]) : 0.f;
        }
#pragma unroll
        for (int u = 0; u < 8; ++u) {
          float val = a[u] + (bq[u] - a[u]) * m;
          if (j < 64) val = 1.f - 2.f / (fexp(2.f * val) + 1.f);
          LA[(size_t)(row0 + tb + u) * 192 + j] = (bf16_t)f2bf(val);
        }
      }
    }
  }
  __syncthreads();
  if (parts & 1) {
    const bf16_t* WuqT = (const bf16_t*)(ws + OFF_WUQ + l * SZ_WUQ);
    const bf16_t* WukvT = (const bf16_t*)(ws + OFF_WUKV + l * SZ_WUKV);
    EpiQ eq{Qm, sRq, row0};
    for (int ct = 0; ct < 5; ++ct) gemm_tile<2>(lds, pB, LDPB, WuqT, 256, 256, row0, ct * 128, eq);
    EpiKV ek{Km, VtM, sRkv, row0};
    for (int ct = 0; ct < 6; ++ct) gemm_tile<2>(lds, pB + 256, LDPB, WukvT, 128, 128, row0, ct * 128, ek);
  }
  if (parts & 2) {
    const bf16_t* w2T = (const bf16_t*)(ws + OFF_W2 + l * SZ_L);
    const bf16_t* a2T = (const bf16_t*)(ws + OFF_A2 + l * SZ_L);
    const bf16_t* v2T = (const bf16_t*)(ws + OFF_V2);
    EpiA ea{abuf, kbuf, wbuf, p.in[16] + l * 384, p.in[21] + l * 384};
    for (int ct = 0; ct < 3; ++ct) gemm_tile<2>(lds, LA + 64, 192, a2T, 64, 64, row0, ct * 128, ea);
    __syncthreads();
    EpiW ew{wbuf, p.in[14] + l * 384};
    for (int ct = 0; ct < 3; ++ct) gemm_tile<2>(lds, LA, 192, w2T, 64, 64, row0, ct * 128, ew);
    if (l > 0) {
      EpiV ev{vbuf, pB, p.in[18], p.in[12] + l * 1280};
      for (int ct = 0; ct < 3; ++ct) gemm_tile<2>(lds, LA + 128, 192, v2T, 64, 64, row0, ct * 128, ev);
    }
  }
  __syncthreads();
  if (parts & 1) {
    for (int idx = tid; idx < 64 * 16; idx += NTH) {
      const int r = idx >> 4, i = idx & 15, row = row0 + r, s = row & 2047;
      const float c = tab[s * 32 + i], sn = tab[s * 32 + 16 + i];
      bf16_t* q = Qm + (size_t)row * 576 + 64;
#pragma unroll
      for (int h = 0; h < 6; ++h) { const float t1 = bf2f(q[h * 96 + i]), t2 = bf2f(q[h * 96 + 16 + i]); q[h * 96 + i] = (bf16_t)f2bf(t1 * c - t2 * sn); q[h * 96 + 16 + i] = (bf16_t)f2bf(t1 * sn + t2 * c); }
      const float k1 = bf2f(pB[(size_t)row * LDPB + 384 + i]), k2 = bf2f(pB[(size_t)row * LDPB + 400 + i]);
      const bf16_t o1 = (bf16_t)f2bf(k1 * c - k2 * sn), o2 = (bf16_t)f2bf(k1 * sn + k2 * c);
      bf16_t* kq = Km + (size_t)row * 576 + 64;
#pragma unroll
      for (int h = 0; h < 6; ++h) { kq[h * 96 + i] = o1; kq[h * 96 + 16 + i] = o2; }
    }
  }
}

DI void scan_unit(unsigned char* lds, const KP& p, int unit) {
  unsigned char* ws = p.ws;
  float* sm = (float*)lds;
  const int tid = otid(), lane = tid & 63, w16 = tid >> 6, rg = lane >> 4, cg_ = lane & 15;
  const int hid = unit >> 1, half = unit & 1, b = hid / 6, h = hid - b * 6;
  const bf16_t* rbuf = (const bf16_t*)(ws + OFF_SC); const bf16_t* kbuf = rbuf + (size_t)T * 384; const bf16_t* vbuf = kbuf + (size_t)T * 384;
  const bf16_t* wbuf = vbuf + (size_t)T * 384; const bf16_t* kkbuf = wbuf + (size_t)T * 384; const bf16_t* abuf = kkbuf + (size_t)T * 384;
  bf16_t* ybuf = (bf16_t*)(ws + OFF_R2);
  const int st = tid >> 4, sp = tid & 15;
  const size_t gbase = ((size_t)b * 2048) * 384 + h * 64 + sp * 4;
  uint2 qw, qk, qkk, qa, qr, qv;
#define SCAN_LOAD(t0) do { const size_t o_ = gbase + (size_t)((t0) + st) * 384; qw = *(const uint2*)(wbuf + o_); qk = *(const uint2*)(kbuf + o_); qkk = *(const uint2*)(kkbuf + o_); \
    qa = *(const uint2*)(abuf + o_); qr = *(const uint2*)(rbuf + o_); qv = *(const uint2*)(vbuf + o_); } while (0)
  f32x4 S0 = (f32x4){0.f, 0.f, 0.f, 0.f}, S1 = (f32x4){0.f, 0.f, 0.f, 0.f};
  SCAN_LOAD(0);
  const int rowoff = half * 32 + w16 * 8 + rg * 2;
  bf16_t* yout = ybuf + ((size_t)b * 2048) * 384 + h * 64 + rowoff;
  __builtin_amdgcn_s_setprio(3);
  for (int ch = 0; ch < 128; ++ch) {
    __syncthreads();
    {
      float* d = sm + st * 400 + sp * 4;
      const f32x4 fw = up4(qw), fk = up4(qk), fkk = up4(qkk), fa = up4(qa), fr = up4(qr), fv = up4(qv);
      f32x4 dec;
#pragma unroll
      for (int i = 0; i < 4; ++i) dec[i] = fexp(fw[i]);
      const f32x4 bp = fkk * fa;
      float be = bp[0] * fr[0] + bp[1] * fr[1] + bp[2] * fr[2] + bp[3] * fr[3];
      float ka = fk[0] * fr[0] + fk[1] * fr[1] + fk[2] * fr[2] + fk[3] * fr[3];
      be = rowsum16(be); ka = rowsum16(ka);
      *(f32x4*)(d) = dec; *(f32x4*)(d + 64) = fk; *(f32x4*)(d + 128) = -fkk; *(f32x4*)(d + 192) = bp; *(f32x4*)(d + 256) = dec * fr; *(f32x4*)(d + 320) = fv;
      if (sp == 0) { sm[st * 400 + 384] = be; sm[st * 400 + 385] = ka; }
    }
    __syncthreads();
    if (ch + 1 < 128) SCAN_LOAD((ch + 1) * 16);
#pragma unroll 4
    for (int t = 0; t < 16; ++t) {
      const float* q = sm + t * 400;
      const f32x4 w4 = *(const f32x4*)(q + 4 * cg_), k4 = *(const f32x4*)(q + 64 + 4 * cg_), a4 = *(const f32x4*)(q + 128 + 4 * cg_);
      const f32x4 b4 = *(const f32x4*)(q + 192 + 4 * cg_), r4 = *(const f32x4*)(q + 256 + 4 * cg_);
      const float v0 = q[320 + rowoff], v1 = q[321 + rowoff], be = q[384], ka = q[385];
      float sa0 = S0[0] * a4[0] + S0[1] * a4[1] + S0[2] * a4[2] + S0[3] * a4[3];
      float sa1 = S1[0] * a4[0] + S1[1] * a4[1] + S1[2] * a4[2] + S1[3] * a4[3];
      float y0 = S0[0] * r4[0] + S0[1] * r4[1] + S0[2] * r4[2] + S0[3] * r4[3];
      float y1 = S1[0] * r4[0] + S1[1] * r4[1] + S1[2] * r4[2] + S1[3] * r4[3];
      sa0 = rowsum16(sa0); sa1 = rowsum16(sa1); y0 = rowsum16(y0); y1 = rowsum16(y1);
      S0 = S0 * w4 + (b4 * sa0 + k4 * v0);
      S1 = S1 * w4 + (b4 * sa1 + k4 * v1);
      y0 += sa0 * be + v0 * ka; y1 += sa1 * be + v1 * ka;
      if (cg_ == 0) *(unsigned*)(yout + (size_t)(ch * 16 + t) * 384) = pk2(y0, y1);
    }
  }
  __builtin_amdgcn_s_setprio(0);
#undef SCAN_LOAD
}

template <bool DIFF>
DI void attn_unit(unsigned char* lds, const bf16_t* __restrict__ Qb, const bf16_t* __restrict__ Kb, int ld, const bf16_t* __restrict__ Vt,
                  const bf16_t* __restrict__ gate, bf16_t* mixed, const int* __restrict__ pos, int qb, int h, int rowb,
                  float lam_full, float lam_init, const float* __restrict__ gsub) {
  constexpr int KS = DIFF ? 1 : 3, NM = DIFF ? 2 : 1, KW = DIFF ? 72 : 104, NQT = DIFF ? 1 : 2, QU = 64 * NQT;
  bf16_t* sK = (bf16_t*)lds; bf16_t* sV = sK + 64 * KW;
  const int tid = otid(), lane = tid & 63, w = tid >> 6, lr = lane & 15, g = lane >> 4;
  const int q0 = qb * QU, qw0 = q0 + 16 * NQT * w;
  bf16x8 qf[NM][NQT][KS];
#pragma unroll
  for (int m = 0; m < NM; ++m)
#pragma unroll
    for (int qt = 0; qt < NQT; ++qt)
#pragma unroll
      for (int ks = 0; ks < KS; ++ks) qf[m][qt][ks] = *(const bf16x8*)(Qb + (size_t)(qw0 + 16 * qt + lr) * ld + m * 32 + ks * 32 + g * 8);
  f32x4 O[NM][4][NQT]; float mrun[NM][NQT], lrun[NM][NQT];
#pragma unroll
  for (int m = 0; m < NM; ++m)
#pragma unroll
    for (int qt = 0; qt < NQT; ++qt) { mrun[m][qt] = -INFINITY; lrun[m][qt] = 0.f;
#pragma unroll
      for (int dt = 0; dt < 4; ++dt) O[m][dt][qt] = (f32x4){0.f, 0.f, 0.f, 0.f}; }
  float posq[2] = {0.f, 0.f};
  if (DIFF) { posq[0] = (float)pos[qw0 + lr]; if (NQT > 1) posq[1] = (float)pos[qw0 + 16 + lr]; }
  const float sc = DIFF ? (0.17677669529663687f * 1.4426950408889634f) : (0.10206207261596575f * 1.4426950408889634f);
  const float slope2 = DIFF ? ex2(-2.f * (float)(h + 1)) * 1.4426950408889634f : 0.f;
  const int nkt = (q0 + QU) / 64;
  const int vr = tid >> 3, vc = tid & 7;
  int kr0, kc0, kr1, kc1, kr2 = 0, kc2 = 0;
  if (DIFF) { kr0 = vr; kc0 = vc; kr1 = vr + 32; kc1 = vc; }
  else { kr0 = tid / 12; kc0 = tid - kr0 * 12; kr1 = (tid + 256) / 12; kc1 = (tid + 256) - kr1 * 12; kr2 = (tid + 512) / 12; kc2 = (tid + 512) - kr2 * 12; }
  uint4 rk0, rk1, rk2 = {0u, 0u, 0u, 0u}, rv0, rv1;
#define ATT_LOAD(j_) do { rk0 = *(const uint4*)(Kb + (size_t)(64 * (j_) + kr0) * ld + kc0 * 8); rk1 = *(const uint4*)(Kb + (size_t)(64 * (j_) + kr1) * ld + kc1 * 8); \
    if (!DIFF) rk2 = *(const uint4*)(Kb + (size_t)(64 * (j_) + kr2) * ld + kc2 * 8); \
    rv0 = *(const uint4*)(Vt + (size_t)vr * 2048 + 64 * (j_) + vc * 8); rv1 = *(const uint4*)(Vt + (size_t)(vr + 32) * 2048 + 64 * (j_) + vc * 8); } while (0)
  ATT_LOAD(0);
  for (int j = 0; j < nkt; ++j) {
    __syncthreads();
    *(uint4*)(sK + kr0 * KW + kc0 * 8) = rk0; *(uint4*)(sK + kr1 * KW + kc1 * 8) = rk1; if (!DIFF) *(uint4*)(sK + kr2 * KW + kc2 * 8) = rk2;
    *(uint4*)(sV + vr * 72 + vc * 8) = rv0; *(uint4*)(sV + (vr + 32) * 72 + vc * 8) = rv1;
    __syncthreads();
    if (j + 1 < nkt) ATT_LOAD(j + 1);
    if (64 * j <= qw0 + 16 * NQT - 1) {
      const bool domask = (64 * j + 63 > qw0);
      int4 pk[4];
      if (DIFF) {
#pragma unroll
        for (int kt = 0; kt < 4; ++kt) pk[kt] = *(const int4*)(pos + 64 * j + 16 * kt + 4 * g);
      }
#pragma unroll
      for (int m = 0; m < NM; ++m) {
        f32x4 s[4][NQT];
#pragma unroll
        for (int kt = 0; kt < 4; ++kt) {
#pragma unroll
          for (int qt = 0; qt < NQT; ++qt) s[kt][qt] = (f32x4){0.f, 0.f, 0.f, 0.f};
#pragma unroll
          for (int ks = 0; ks < KS; ++ks) {
            const bf16x8 kf = *(const bf16x8*)(sK + (16 * kt + lr) * KW + m * 32 + ks * 32 + g * 8);
#pragma unroll
            for (int qt = 0; qt < NQT; ++qt) s[kt][qt] = MFMA16(kf, qf[m][qt][ks], s[kt][qt]);
          }
        }
#pragma unroll
        for (int kt = 0; kt < 4; ++kt)
#pragma unroll
          for (int qt = 0; qt < NQT; ++qt)
#pragma unroll
            for (int i = 0; i < 4; ++i) {
              float v = s[kt][qt][i] * sc;
              if (DIFF) { const int pki = (i == 0) ? pk[kt].x : (i == 1) ? pk[kt].y : (i == 2) ? pk[kt].z : pk[kt].w; v -= slope2 * fabsf(posq[qt] - (float)pki); }
              s[kt][qt][i] = v;
            }
        if (domask) {
#pragma unroll
          for (int kt = 0; kt < 4; ++kt)
#pragma unroll
            for (int qt = 0; qt < NQT; ++qt)
#pragma unroll
              for (int i = 0; i < 4; ++i) if (64 * j + 16 * kt + 4 * g + i > qw0 + 16 * qt + lr) s[kt][qt][i] = -INFINITY;
        }
#pragma unroll
        for (int qt = 0; qt < NQT; ++qt) {
          float mx = -INFINITY;
#pragma unroll
          for (int kt = 0; kt < 4; ++kt)
#pragma unroll
            for (int i = 0; i < 4; ++i) mx = fmaxf(mx, s[kt][qt][i]);
          mx = fmaxf(mx, __shfl_xor(mx, 16)); mx = fmaxf(mx, __shfl_xor(mx, 32));
          const float mn = fmaxf(mrun[m][qt], mx), alpha = ex2(mrun[m][qt] - mn); mrun[m][qt] = mn;
          float ls = 0.f;
#pragma unroll
          for (int kt = 0; kt < 4; ++kt)
#pragma unroll
            for (int i = 0; i < 4; ++i) { const float pv = ex2(s[kt][qt][i] - mn); ls += pv; s[kt][qt][i] = pv; }
          lrun[m][qt] = lrun[m][qt] * alpha + ls;
#pragma unroll
          for (int dt = 0; dt < 4; ++dt) O[m][dt][qt] = O[m][dt][qt] * alpha;
        }
#pragma unroll
        for (int s2 = 0; s2 < 2; ++s2) {
          bf16x8 pf[NQT];
#pragma unroll
          for (int qt = 0; qt < NQT; ++qt) {
            uint4 u; u.x = pk2(s[2 * s2][qt][0], s[2 * s2][qt][1]); u.y = pk2(s[2 * s2][qt][2], s[2 * s2][qt][3]);
            u.z = pk2(s[2 * s2 + 1][qt][0], s[2 * s2 + 1][qt][1]); u.w = pk2(s[2 * s2 + 1][qt][2], s[2 * s2 + 1][qt][3]);
            pf[qt] = __builtin_bit_cast(bf16x8, u);
          }
#pragma unroll
          for (int dt = 0; dt < 4; ++dt) {
            const uint2 lo = *(const uint2*)(sV + (16 * dt + lr) * 72 + 32 * s2 + 4 * g), hi = *(const uint2*)(sV + (16 * dt + lr) * 72 + 32 * s2 + 16 + 4 * g);
            uint4 u; u.x = lo.x; u.y = lo.y; u.z = hi.x; u.w = hi.y;
            const bf16x8 vf = __builtin_bit_cast(bf16x8, u);
#pragma unroll
            for (int qt = 0; qt < NQT; ++qt) O[m][dt][qt] = MFMA16(vf, pf[qt], O[m][dt][qt]);
          }
        }
      }
    }
  }
#undef ATT_LOAD
#pragma unroll
  for (int qt = 0; qt < NQT; ++qt) {
    const size_t row = (size_t)rowb + qw0 + 16 * qt + lr;
    float inv[NM];
#pragma unroll
    for (int m = 0; m < NM; ++m) { float lt = lrun[m][qt]; lt += __shfl_xor(lt, 16); lt += __shfl_xor(lt, 32); inv[m] = 1.f / lt; }
    if (!DIFF) {
#pragma unroll
      for (int dt = 0; dt < 4; ++dt) {
        const int col = h * 64 + 16 * dt + 4 * g;
        const f32x4 gt = load4bf(gate + row * LDPA + 512 + col); f32x4 o = O[0][dt][qt] * inv[0];
#pragma unroll
        for (int i = 0; i < 4; ++i) o[i] *= silu(gt[i]);
        store4bf(mixed + row * 1024 + col, o);
      }
    } else {
      f32x4 o[4]; float ss = 0.f;
#pragma unroll
      for (int dt = 0; dt < 4; ++dt) { o[dt] = O[0][dt][qt] * inv[0] - O[NM - 1][dt][qt] * (lam_full * inv[NM - 1]); ss += o[dt][0] * o[dt][0] + o[dt][1] * o[dt][1] + o[dt][2] * o[dt][2] + o[dt][3] * o[dt][3]; }
      ss += __shfl_xor(ss, 16); ss += __shfl_xor(ss, 32);
      const float rs = (1.f / sqrtf(ss * (1.f / 64.f) + 1e-5f)) * (1.f - lam_init);
#pragma unroll
      for (int dt = 0; dt < 4; ++dt) {
        const int dvc = 16 * dt + 4 * g, col = h * 64 + dvc;
        const f32x4 gs = *(const f32x4*)(gsub + dvc); const f32x4 gt = load4bf(gate + row * LDPA + 512 + 384 + col);
        f32x4 r;
#pragma unroll
        for (int i = 0; i < 4; ++i) r[i] = o[dt][i] * rs * gs[i] * silu(gt[i]);
        store4bf(mixed + row * 1024 + 384 + col, r);
      }
    }
  }
}

DI void p4_unit(unsigned char* lds, const KP& p, int l, int rt) {
  unsigned char* ws = p.ws;
  const int tid = otid(), lane = tid & 63, w = tid >> 6, row0 = rt * 64;
  const bf16_t* rbuf = (const bf16_t*)(ws + OFF_SC); const bf16_t* kbuf = rbuf + (size_t)T * 384; const bf16_t* vbuf = kbuf + (size_t)T * 384;
  const bf16_t* ybuf = (const bf16_t*)(ws + OFF_R2); bf16_t* mixed = (bf16_t*)(ws + OFF_R2 + SZ_SC);
  const bf16_t* pA = (const bf16_t*)(ws + OFF_PA);
  const float* lnw = p.in[23] + l * 384; const float* lnb = p.in[24] + l * 384; const float* rk = p.in[22] + l * 384;
  {
    float lw[6], lb[6], rkk[6];
#pragma unroll
    for (int h = 0; h < 6; ++h) { lw[h] = lnw[h * 64 + lane]; lb[h] = lnb[h * 64 + lane]; rkk[h] = rk[h * 64 + lane]; }
    for (int t = w; t < 64; t += 4) {
      const int row = row0 + t; const size_t o = (size_t)row * 384 + lane;
      float y[6], r[6], k[6], v[6], gt[6];
#pragma unroll
      for (int h = 0; h < 6; ++h) { y[h] = bf2f(ybuf[o + h * 64]); r[h] = bf2f(rbuf[o + h * 64]); k[h] = bf2f(kbuf[o + h * 64]); v[h] = bf2f(vbuf[o + h * 64]); gt[h] = bf2f(pA[(size_t)row * LDPA + 512 + 640 + h * 64 + lane]); }
#pragma unroll
      for (int h = 0; h < 6; ++h) {
        const float mean = wave_sum(y[h]) * (1.f / 64.f); const float d = y[h] - mean; const float var = wave_sum(d * d) * (1.f / 64.f);
        const float dot = wave_sum(r[h] * k[h] * rkk[h]);
        const float outv = d * (1.f / sqrtf(var + 64e-5f)) * lw[h] + lb[h] + dot * v[h];
        mixed[(size_t)row * 1024 + 640 + h * 64 + lane] = (bf16_t)f2bf(outv * silu(gt[h]));
      }
    }
  }
  __syncthreads();
  const bf16_t* WoT = (const bf16_t*)(ws + OFF_WO + l * SZ_WO);
  EpiOut eo{l == 0 ? p.in[0] : p.out, p.out};
  for (int ct = 0; ct < 8; ++ct) gemm_tile<2>(lds, mixed, 1024, WoT, 1024, 1024, row0, ct * 128, eo);
  __syncthreads();
  if (l == 0) norm_rows_bf16(p.out, p.in[2] + 1024, (bf16_t*)(ws + OFF_R1), row0, row0 + 64, w, 4, lane);
  else {
    const float* fg = p.in[25];
    for (int row = row0 + w; row < row0 + 64; row += 4) {
      f32x4* xr = (f32x4*)(p.out + (size_t)row * 1024) + lane;
      f32x4 v[4]; float s = 0.f;
#pragma unroll
      for (int j = 0; j < 4; ++j) { v[j] = xr[64 * j]; s += v[j][0] * v[j][0] + v[j][1] * v[j][1] + v[j][2] * v[j][2] + v[j][3] * v[j][3]; }
      const float rstd = 1.f / sqrtf(wave_sum(s) * (1.f / 1024.f) + 1e-6f);
#pragma unroll
      for (int j = 0; j < 4; ++j) { const f32x4 gg = *((const f32x4*)fg + lane + 64 * j); xr[64 * j] = v[j] * rstd * gg; }
    }
  }
}

DI void p3_run(unsigned char* lds, int* s_unit, const KP& p, int l, int cslot, bool do_scan, bool do_att) {
  unsigned char* ws = p.ws;
  const int tid = otid();
  unsigned* ctrS = (unsigned*)(ws + OFF_CTL) + 16 * (2 * cslot + 1);
  unsigned* ctrA = (unsigned*)(ws + OFF_CTL) + 16 * (2 * cslot + 2);
  unsigned* cucnt = (unsigned*)(ws + OFF_CU) + 4096 * cslot;
  const bf16_t* pA = (const bf16_t*)(ws + OFF_PA);
  const bf16_t* Qm = (const bf16_t*)(ws + OFF_R1); const bf16_t* Km = Qm + (size_t)T * 576;
  bf16_t* mixed = (bf16_t*)(ws + OFF_R2 + SZ_SC);
  const int* pos = (const int*)p.in[1];
  const float* lam = p.in[10] + l * 128;
  float d0 = 0.f, d1 = 0.f;
  for (int i = 0; i < 32; ++i) { d0 += lam[i] * lam[32 + i]; d1 += lam[64 + i] * lam[96 + i]; }
  const float lam_init = 0.8f - 0.6f * expf(-0.3f * (float)(l + 1));
  const float lam_full = expf(d0) - expf(d1) + lam_init;
  bool prefer_scan = false, sdone = !do_scan;
  if (tid == 0) {
    const unsigned xcc = (unsigned)__builtin_amdgcn_s_getreg((3 << 11) | 20) & 0xFu;
    const unsigned cu = (unsigned)__builtin_amdgcn_s_getreg((7 << 11) | (8 << 6) | 4) & 0xFFu;
    prefer_scan = (atomicAdd(cucnt + ((xcc << 8) | cu), 1u) == 0u);
  }
  for (;;) {
    __syncthreads();
    if (tid == 0) {
      int code = -1;
      if (prefer_scan && !sdone) { const unsigned u = atomicAdd(ctrS, 1u); if (u < (unsigned)NSCAN) code = (int)u; else sdone = true; }
      if (code < 0 && do_att) { const unsigned u = atomicAdd(ctrA, 1u); if (u < (unsigned)NATT) code = NSCAN + (int)u; }
      if (code < 0 && !sdone) { const unsigned u = atomicAdd(ctrS, 1u); if (u < (unsigned)NSCAN) code = (int)u; else sdone = true; }
      *s_unit = code;
    }
    __syncthreads();
    const int u = *s_unit;
    if (u < 0) break;
    if (u < NSCAN) scan_unit(lds, p, u);
    else if (u < NSCAN + NMLA) {
      const int v = u - NSCAN, qb = 15 - v / 96, bh = v % 96, b = bh / 6, h = bh - b * 6;
      attn_unit<false>(lds, Qm + (size_t)b * 2048 * 576 + h * 96, Km + (size_t)b * 2048 * 576 + h * 96, 576, (const bf16_t*)(ws + OFF_VTM) + (size_t)bh * 64 * 2048,
                       pA, mixed, pos, qb, h, b * 2048, 0.f, 0.f, nullptr);
    } else {
      const int v = u - NSCAN - NMLA, qb = 31 - v / 64, bh = v % 64, b = bh >> 2, h = bh & 3;
      attn_unit<true>(lds, pA + (size_t)b * 2048 * LDPA + h * 64, pA + (size_t)b * 2048 * LDPA + 256 + h * 64, LDPA, (const bf16_t*)(ws + OFF_VTD) + (size_t)bh * 64 * 2048,
                      pA, mixed, pos, qb, h, b * 2048, lam_full, lam_init, p.in[11] + l * 64);
    }
  }
}

DI void gbar(unsigned* bw, unsigned nblk) {
  asm volatile("s_waitcnt vmcnt(0)" ::: "memory");
  __syncthreads();
  if (threadIdx.x == 0) {
    __builtin_amdgcn_fence(__ATOMIC_RELEASE, "agent");
    asm volatile("s_waitcnt vmcnt(0)" ::: "memory");
    const unsigned g = __hip_atomic_load(bw + 64, __ATOMIC_RELAXED, __HIP_MEMORY_SCOPE_AGENT);
    const unsigned prev = __hip_atomic_fetch_add(bw, 1u, __ATOMIC_RELAXED, __HIP_MEMORY_SCOPE_AGENT);
    if (prev == nblk - 1u) {
      __hip_atomic_store(bw, 0u, __ATOMIC_RELAXED, __HIP_MEMORY_SCOPE_AGENT);
      __builtin_amdgcn_fence(__ATOMIC_RELEASE, "agent");
      __hip_atomic_fetch_add(bw + 64, 1u, __ATOMIC_RELAXED, __HIP_MEMORY_SCOPE_AGENT);
    } else {
      while (__hip_atomic_load(bw + 64, __ATOMIC_RELAXED, __HIP_MEMORY_SCOPE_AGENT) == g) __builtin_amdgcn_s_sleep(1);
    }
    __builtin_amdgcn_fence(__ATOMIC_ACQUIRE, "agent");
    asm volatile("s_waitcnt vmcnt(0)" ::: "memory");
  }
  __syncthreads();
}

__global__ void __launch_bounds__(NTH, 2) mk_fwd(KP p) {
  extern __shared__ __attribute__((aligned(16))) unsigned char lds[];
  int& s_unit = *(int*)(lds + 73728 + 1024);
  cg::grid_group grid = cg::this_grid();
  unsigned char* ws = p.ws;
  const int tid = otid(), lane = tid & 63, w = tid >> 6;
  const int G = gridDim.x, bid = blockIdx.x;
#define RUN(k) (p.ph_lo <= (k) && (k) < p.ph_hi)
#define SEAM(k) do { if (RUN(k) && RUN((k) + 1)) gbar((unsigned*)(ws + OFF_CTL) + 512, (unsigned)G); } while (0)
  if (p.ph_lo < 0) grid.sync();

  if (RUN(0)) {
    const int gt = bid * NTH + tid, ngt = G * NTH;
    for (int i = gt; i < 3 * 4096; i += ngt) ((unsigned*)(ws + OFF_CU))[i] = 0u;
    for (int l = 0; l < 2; ++l) {
      bf16_t* Wc = (bf16_t*)(ws + OFF_WC + l * SZ_WC);
      if (l == 0) convT(p.in[3], 1024, 3488, Wc, 1024, NP, nullptr, gt, ngt);
      else { convT(p.in[3] + (size_t)1024 * 3488, 1024, 3488, Wc, 1024, 3488, nullptr, gt, ngt); convT(p.in[4], 1024, 32, Wc + (size_t)3488 * 1024, 1024, 96, nullptr, gt, ngt); }
      convT(p.in[5] + (size_t)l * 1024 * 1024, 1024, 1024, (bf16_t*)(ws + OFF_WO + l * SZ_WO), 1024, 1024, nullptr, gt, ngt);
      convT(p.in[8] + (size_t)l * 256 * 576, 256, 576, (bf16_t*)(ws + OFF_WUQ + l * SZ_WUQ), 256, 640, p.in[6] + l * 256, gt, ngt);
      convT(p.in[9] + (size_t)l * 128 * 768, 128, 768, (bf16_t*)(ws + OFF_WUKV + l * SZ_WUKV), 128, 768, p.in[7] + l * 128, gt, ngt);
      convT(p.in[15] + (size_t)l * 64 * 384, 64, 384, (bf16_t*)(ws + OFF_W2 + l * SZ_L), 64, 384, nullptr, gt, ngt);
      convT(p.in[17] + (size_t)l * 64 * 384, 64, 384, (bf16_t*)(ws + OFF_A2 + l * SZ_L), 64, 384, nullptr, gt, ngt);
    }
    convT(p.in[19], 32, 384, (bf16_t*)(ws + OFF_V2), 64, 384, nullptr, gt, ngt);
    {
      float* tab = (float*)(ws + OFF_TAB); const int* pos = (const int*)p.in[1];
      for (int idx = gt; idx < 2048 * 16; idx += ngt) {
        const int s = idx >> 4, i = idx & 15;
        const float inv = exp2f(-(float)i * (13.287712379549449f / 16.f));
        const float ang = (float)pos[s] * inv;
        double rev = (double)ang * 0.15915494309189535; rev -= __builtin_rint(rev);
        tab[s * 32 + i] = __builtin_amdgcn_cosf((float)rev); tab[s * 32 + 16 + i] = __builtin_amdgcn_sinf((float)rev);
      }
    }
    norm_rows_bf16(p.in[0], p.in[2], (bf16_t*)(ws + OFF_R1), 0, T, bid * 4 + w, G * 4, lane);
  }
  SEAM(0);
#if PROBE == 8
  for (int i = 0; i < 10; ++i) grid.sync();
#endif
#if PROBE == 6
  if (RUN(0)) { norm_rows_bf16(p.in[0], p.in[2], (bf16_t*)(ws + OFF_R1), 0, T, bid * 4 + w, G * 4, lane); grid.sync(); }
#endif
  for (int l = 0; l < 2; ++l) {
    const int pb = 1 + 4 * l;
    if (RUN(pb)) {
      EpiRoute e{(bf16_t*)(ws + OFF_PA), (bf16_t*)(ws + OFF_R2), (bf16_t*)(ws + OFF_VTD), l ? 3520 : 3488};
      const bf16_t* hb = (const bf16_t*)(ws + OFF_R1); const bf16_t* Wc = (const bf16_t*)(ws + OFF_WC + l * SZ_WC);
      for (int rep = 0; rep < ((PROBE == 1 && l == 0) ? 2 : 1); ++rep)
      for (int u = bid; u < 256 * 28; u += G) { const int rt = u / 28, ct = u - rt * 28; gemm_tile<4>(lds, hb, 1024, Wc, 1024, 1024, rt * 128, ct * 128, e); }
    }
    SEAM(pb);
    if (RUN(pb + 1)) { for (int rt = bid; rt < 512; rt += G) p2_unit(lds, p, l, rt);
#if PROBE == 11 || PROBE == 12
      if (l == 0) { gbar((unsigned*)(ws + OFF_CTL) + 512, (unsigned)G); for (int rt = bid; rt < 512; rt += G) p2_unit(lds, p, l, rt, PROBE - 10); }
#endif
    }
    SEAM(pb + 1);
    if (RUN(pb + 2)) {
      p3_run(lds, &s_unit, p, l, l, true, true);
#if PROBE == 3
      if (l == 0) { grid.sync(); p3_run(lds, &s_unit, p, l, 2, true, false); }
#elif PROBE == 9
      if (l == 0) { grid.sync(); p3_run(lds, &s_unit, p, l, 2, true, true); }
#elif PROBE == 10
      if (l == 0) { grid.sync(); p3_run(lds, &s_unit, p, l, 2, false, true); }
#endif
    }
    SEAM(pb + 2);
    if (RUN(pb + 3)) { for (int rep = 0; rep < ((PROBE == 5 && l == 0) ? 2 : 1); ++rep) { if (rep) grid.sync(); for (int rt = bid; rt < 512; rt += G) p4_unit(lds, p, l, rt); } }
    SEAM(pb + 3);
  }
#undef RUN
#undef SEAM
}

extern "C" void kernel_launch(void* const* d_in, const int* in_sizes, int n_in, void* d_out, int out_size, void* d_ws, size_t ws_size, hipStream_t stream) {
  static int grid = 0;
  if (grid == 0) {
    if (n_in != 26 || ws_size < WS_END) { fprintf(stderr, "kernel_launch: need 26 inputs and %zu bytes of workspace (got %d, %zu)\n", (size_t)WS_END, n_in, ws_size); grid = -1; return; }
    int dev = 0, cus = 0, per_cu = 0;
    (void)hipGetDevice(&dev);
    (void)hipDeviceGetAttribute(&cus, hipDeviceAttributeMultiprocessorCount, dev);
    (void)hipFuncSetAttribute((const void*)mk_fwd, hipFuncAttributeMaxDynamicSharedMemorySize, LDS_BYTES);
    (void)hipOccupancyMaxActiveBlocksPerMultiprocessor(&per_cu, (const void*)mk_fwd, NTH, LDS_BYTES);
    if (per_cu > 2) per_cu = 2;
    if (per_cu < 1) { fprintf(stderr, "kernel_launch: occupancy query returned %d\n", per_cu); per_cu = 1; }
    grid = cus * per_cu;
  }
  if (grid < 0) return;
  (void)hipMemsetAsync(d_ws, 0, 4096, stream);
  KP p{};
  for (int i = 0; i < 26; ++i) p.in[i] = (const float*)d_in[i];
  p.out = (float*)d_out; p.ws = (unsigned char*)d_ws;
  if (MK_LAUNCHES == 1) {
    p.ph_lo = 0; p.ph_hi = NPHASE;
    void* args[] = {&p};
    hipError_t e = hipLaunchCooperativeKernel((const void*)mk_fwd, dim3(grid), dim3(NTH), args, LDS_BYTES, stream);
    if (e != hipSuccess) fprintf(stderr, "cooperative launch failed: %s (grid %d)\n", hipGetErrorString(e), grid);
  } else {
    for (int k = 0; k < NPHASE; ++k) { p.ph_lo = k; p.ph_hi = k + 1; hipLaunchKernelGGL(mk_fwd, dim3(grid), dim3(NTH), LDS_BYTES, stream, p); }
  }
}
```

```cpp
#include <hip/hip_runtime.h>
#include <hip/hip_cooperative_groups.h>
#include <cstdio>
#include <cstdint>
namespace cg = cooperative_groups;

#ifndef PROBE
#define PROBE 0
#endif
#ifndef MK_LAUNCHES
#define MK_LAUNCHES 1
#endif

typedef unsigned short bf16_t;
typedef short bf16x8 __attribute__((ext_vector_type(8)));
typedef float f32x4 __attribute__((ext_vector_type(4)));
#define DI __device__ __forceinline__

constexpr int NB = 16, SEQ = 2048, T = NB * SEQ, DM = 1024;
constexpr int NP = 3584;
constexpr int LDPA = 1536;
constexpr int LDPB = 1728;
constexpr int NPHASE = 9;
constexpr int LDS_BYTES = 73728 + 1024 + 1024;
constexpr int NTH = 256;
constexpr int NSCAN = 192, NMLA = 96 * 16, NDIFF = 64 * 32, NATT = NMLA + NDIFF;

constexpr size_t OFF_CTL = 0;
constexpr size_t OFF_TAB = 4096;
constexpr size_t SZ_WC = (size_t)NP * 1024 * 2;
constexpr size_t OFF_WC = OFF_TAB + 262144;
constexpr size_t SZ_WO = (size_t)1024 * 1024 * 2;
constexpr size_t OFF_WO = OFF_WC + 2 * SZ_WC;
constexpr size_t SZ_WUQ = (size_t)640 * 256 * 2;
constexpr size_t OFF_WUQ = OFF_WO + 2 * SZ_WO;
constexpr size_t SZ_WUKV = (size_t)768 * 128 * 2;
constexpr size_t OFF_WUKV = OFF_WUQ + 2 * SZ_WUQ;
constexpr size_t SZ_L = (size_t)384 * 64 * 2;
constexpr size_t OFF_W2 = OFF_WUKV + 2 * SZ_WUKV;
constexpr size_t OFF_A2 = OFF_W2 + 2 * SZ_L;
constexpr size_t OFF_V2 = OFF_A2 + 2 * SZ_L;
constexpr size_t OFF_R1 = OFF_V2 + SZ_L;
constexpr size_t SZ_QK = (size_t)T * 576 * 2;
constexpr size_t OFF_PA = OFF_R1 + 2 * SZ_QK;
constexpr size_t OFF_R2 = OFF_PA + (size_t)T * LDPA * 2;
constexpr size_t OFF_VTM = OFF_R2 + (size_t)T * LDPB * 2;
constexpr size_t OFF_VTD = OFF_VTM + (size_t)T * 384 * 2;
constexpr size_t SZ_SC = (size_t)T * 384 * 2;
constexpr size_t OFF_SC = OFF_VTD + (size_t)T * 256 * 2;
constexpr size_t OFF_LA = OFF_SC + 6 * SZ_SC;
constexpr size_t OFF_CU = OFF_LA + (size_t)T * 192 * 2;
constexpr size_t WS_END = OFF_CU + 3 * 4096 * 4;
static_assert(OFF_R1 % 256 == 0, "align");

struct KP { const float* in[26]; float* out; unsigned char* ws; int ph_lo, ph_hi; };

DI unsigned f2bf(float f) { unsigned u = __float_as_uint(f); return (u + 0x7fffu + ((u >> 16) & 1u)) >> 16; }
DI float bf2f(bf16_t h) { return __uint_as_float(((unsigned)h) << 16); }
typedef __bf16 bf2v_t __attribute__((ext_vector_type(2)));
typedef float f2v_t __attribute__((ext_vector_type(2)));
DI unsigned pk2(float a, float b) { f2v_t f = {a, b}; return __builtin_bit_cast(unsigned, __builtin_convertvector(f, bf2v_t)); }
DI void store4bf(bf16_t* p, f32x4 v) { uint2 u; u.x = pk2(v[0], v[1]); u.y = pk2(v[2], v[3]); *(uint2*)p = u; }
DI f32x4 up4(uint2 u) { f32x4 r; r[0] = __uint_as_float(u.x << 16); r[1] = __uint_as_float(u.x & 0xffff0000u); r[2] = __uint_as_float(u.y << 16); r[3] = __uint_as_float(u.y & 0xffff0000u); return r; }
DI f32x4 load4bf(const bf16_t* p) { return up4(*(const uint2*)p); }
DI float ex2(float x) { return __builtin_amdgcn_exp2f(x); }
DI float fexp(float x) { return __builtin_amdgcn_exp2f(x * 1.4426950408889634f); }
DI float sigm(float x) { return 1.f / (1.f + fexp(-x)); }
DI float silu(float x) { return x / (1.f + fexp(-x)); }
template <int CTRL> DI float dppmov(float x) { return __builtin_bit_cast(float, __builtin_amdgcn_update_dpp(0, __builtin_bit_cast(int, x), CTRL, 0xF, 0xF, true)); }
DI float rowsum16(float x) {
  x += dppmov<0xB1>(x);
  x += dppmov<0x4E>(x);
  x += dppmov<0x124>(x);
  x += dppmov<0x128>(x);
  return x;
}
DI int otid() { int t = threadIdx.x; asm volatile("" : "+v"(t)); return t; }
DI void swap16(unsigned& a, unsigned& b) { asm("s_nop 1\n\tv_permlane16_swap_b32 %0, %1" : "+v"(a), "+v"(b)); }
DI void swap32(unsigned& a, unsigned& b) { asm("s_nop 1\n\tv_permlane32_swap_b32 %0, %1" : "+v"(a), "+v"(b)); }
DI float xsum16(float x) { unsigned a = __float_as_uint(x), b = a; swap16(a, b); return __uint_as_float(a) + __uint_as_float(b); }
DI float xsum32(float x) { unsigned a = __float_as_uint(x), b = a; swap32(a, b); return __uint_as_float(a) + __uint_as_float(b); }
DI float xmax16(float x) { unsigned a = __float_as_uint(x), b = a; swap16(a, b); return fmaxf(__uint_as_float(a), __uint_as_float(b)); }
DI float xmax32(float x) { unsigned a = __float_as_uint(x), b = a; swap32(a, b); return fmaxf(__uint_as_float(a), __uint_as_float(b)); }
DI float wave_sum(float v) { return xsum32(xsum16(rowsum16(v))); }
#define MFMA16(a, b, c) __builtin_amdgcn_mfma_f32_16x16x32_bf16((a), (b), (c), 0, 0, 0)

template <int MI, class Epi>
DI void gemm_tile(unsigned char* lds, const bf16_t* __restrict__ A, int lda, const bf16_t* __restrict__ Bt, int ldb, int K, int row0, int col0, const Epi& epi) {
  constexpr int BM = 32 * MI;
  constexpr int BUFE = (BM + 128) * 72;
  bf16_t* sbase = (bf16_t*)lds;
  const int tid = otid(), lane = tid & 63, w = tid >> 6, wm = w >> 1, wn = w & 1, lr = lane & 15, g = lane >> 4;
  const int sr = tid >> 3, skc = tid & 7;
  const bf16_t* gA = A + (size_t)(row0 + sr) * lda + skc * 8;
  const bf16_t* gB = Bt + (size_t)(col0 + sr) * ldb + skc * 8;
  uint4 ra0, ra1, ra2 = {0u, 0u, 0u, 0u}, ra3 = {0u, 0u, 0u, 0u}, rb0, rb1, rb2, rb3;
#define G_LOAD(k0_) do { ra0 = *(const uint4*)(gA + (k0_)); ra1 = *(const uint4*)(gA + (size_t)32 * lda + (k0_)); \
    if (MI == 4) { ra2 = *(const uint4*)(gA + (size_t)64 * lda + (k0_)); ra3 = *(const uint4*)(gA + (size_t)96 * lda + (k0_)); } \
    rb0 = *(const uint4*)(gB + (k0_)); rb1 = *(const uint4*)(gB + (size_t)32 * ldb + (k0_)); rb2 = *(const uint4*)(gB + (size_t)64 * ldb + (k0_)); rb3 = *(const uint4*)(gB + (size_t)96 * ldb + (k0_)); } while (0)
#define G_STORE(buf_) do { bf16_t* sA_ = sbase + (buf_) * BUFE; bf16_t* sB_ = sA_ + BM * 72; \
    *(uint4*)(sA_ + sr * 72 + skc * 8) = ra0; *(uint4*)(sA_ + (sr + 32) * 72 + skc * 8) = ra1; \
    if (MI == 4) { *(uint4*)(sA_ + (sr + 64) * 72 + skc * 8) = ra2; *(uint4*)(sA_ + (sr + 96) * 72 + skc * 8) = ra3; } \
    *(uint4*)(sB_ + sr * 72 + skc * 8) = rb0; *(uint4*)(sB_ + (sr + 32) * 72 + skc * 8) = rb1; *(uint4*)(sB_ + (sr + 64) * 72 + skc * 8) = rb2; *(uint4*)(sB_ + (sr + 96) * 72 + skc * 8) = rb3; } while (0)
  f32x4 acc[MI][4];
#pragma unroll
  for (int mi = 0; mi < MI; ++mi)
#pragma unroll
    for (int ni = 0; ni < 4; ++ni) acc[mi][ni] = (f32x4){0.f, 0.f, 0.f, 0.f};
  const int nk = K >> 6;
  G_LOAD(0);
  G_STORE(0);
  if (nk > 1) G_LOAD(64);
  __syncthreads();
  for (int kt = 0; kt < nk; ++kt) {
    const int cur = kt & 1;
    if (kt + 1 < nk) { G_STORE(cur ^ 1); if (kt + 2 < nk) G_LOAD((kt + 2) * 64); }
    const bf16_t* sA = sbase + cur * BUFE; const bf16_t* sB = sA + BM * 72;
#pragma unroll
    for (int ks = 0; ks < 2; ++ks) {
      bf16x8 af[MI], bfr[4];
#pragma unroll
      for (int mi = 0; mi < MI; ++mi) af[mi] = *(const bf16x8*)(sA + (wm * 16 * MI + mi * 16 + lr) * 72 + ks * 32 + g * 8);
#pragma unroll
      for (int ni = 0; ni < 4; ++ni) bfr[ni] = *(const bf16x8*)(sB + (wn * 64 + ni * 16 + lr) * 72 + ks * 32 + g * 8);
#pragma unroll
      for (int mi = 0; mi < MI; ++mi)
#pragma unroll
        for (int ni = 0; ni < 4; ++ni) acc[mi][ni] = MFMA16(bfr[ni], af[mi], acc[mi][ni]);
    }
    __syncthreads();
  }
#undef G_STORE
#pragma unroll
  for (int mi = 0; mi < MI; ++mi)
#pragma unroll
    for (int ni = 0; ni < 4; ++ni) epi(row0 + wm * 16 * MI + mi * 16 + lr, col0 + wn * 64 + ni * 16 + 4 * g, acc[mi][ni]);
#undef G_LOAD
}

struct EpiRoute {
  bf16_t* pA; bf16_t* pB; bf16_t* VtD; int ncols;
  DI void operator()(int row, int col, f32x4 v) const {
    if (col >= ncols) return;
    if (col < 416) store4bf(pB + (size_t)row * LDPB + col, v);
    else if (col < 928) store4bf(pA + (size_t)row * LDPA + (col - 416), v);
    else if (col < 1184) {
      const int c = col - 928, h = c >> 6, dv = c & 63, b = row >> 11, s = row & 2047;
      bf16_t* q = VtD + ((size_t)((b * 4 + h) * 64 + dv)) * 2048 + s;
      q[0] = (bf16_t)f2bf(v[0]); q[2048] = (bf16_t)f2bf(v[1]); q[4096] = (bf16_t)f2bf(v[2]); q[6144] = (bf16_t)f2bf(v[3]);
    }
    else if (col < 2208) store4bf(pA + (size_t)row * LDPA + 512 + (col - 1184), v);
    else store4bf(pB + (size_t)row * LDPB + 416 + (col - 2208), v);
  }
};
struct EpiQ {
  bf16_t* __restrict__ Qm; const float* __restrict__ rs; int row0;
  DI void operator()(int row, int col, f32x4 v) const {
    if (col >= 576) return;
    const float r = rs[row - row0]; v = v * r;
    store4bf(Qm + (size_t)row * 576 + col, v);
  }
};
struct EpiKV {
  bf16_t* __restrict__ Km; bf16_t* __restrict__ VtM; const float* __restrict__ rs; int row0;
  DI void operator()(int row, int col, f32x4 v) const {
    const float r = rs[row - row0]; v = v * r;
    const int head = col >> 7, c = col & 127;
    if (c < 64) store4bf(Km + (size_t)row * 576 + head * 96 + c, v);
    else {
      const int b = row >> 11, s = row & 2047;
      bf16_t* q = VtM + ((size_t)((b * 6 + head) * 64 + (c - 64))) * 2048 + s;
      q[0] = (bf16_t)f2bf(v[0]); q[2048] = (bf16_t)f2bf(v[1]); q[4096] = (bf16_t)f2bf(v[2]); q[6144] = (bf16_t)f2bf(v[3]);
    }
  }
};
struct EpiW {
  bf16_t* __restrict__ wbuf; const float* __restrict__ w0;
  DI void operator()(int row, int col, f32x4 v) const {
    f32x4 o;
#pragma unroll
    for (int i = 0; i < 4; ++i) { const float val = v[i] + w0[col + i]; const float wv = -__logf(1.f + fexp(-val)) - 0.5f; o[i] = -fexp(wv); }
    store4bf(wbuf + (size_t)row * 384 + col, o);
  }
};
struct EpiA {
  bf16_t* __restrict__ abuf; bf16_t* __restrict__ kbuf; const bf16_t* __restrict__ kraw; const float* __restrict__ a0; const float* __restrict__ ka;
  DI void operator()(int row, int col, f32x4 v) const {
    f32x4 kr = load4bf(kraw + (size_t)row * 384 + col), a, kn;
#pragma unroll
    for (int i = 0; i < 4; ++i) { a[i] = sigm(v[i] + a0[col + i]); kn[i] = kr[i] * (1.f + (a[i] - 1.f) * ka[col + i]); }
    store4bf(abuf + (size_t)row * 384 + col, a);
    store4bf(kbuf + (size_t)row * 384 + col, kn);
  }
};
struct EpiV {
  bf16_t* vbuf; const bf16_t* pB; const float* v0; const float* mu;
  DI void operator()(int row, int col, f32x4 v) const {
    const int s = row & 2047;
    const bf16_t* pc = pB + (size_t)row * LDPB + 416 + 768 + col;
    f32x4 p = load4bf(pc), pr = load4bf(s > 0 ? pc - LDPB : pc);
    if (s == 0) pr = (f32x4){0.f, 0.f, 0.f, 0.f};
    f32x4 vf = load4bf(vbuf + (size_t)row * 384 + col), o;
#pragma unroll
    for (int i = 0; i < 4; ++i) { const float xv = p[i] + (pr[i] - p[i]) * mu[768 + col + i]; const float sg = sigm(v[i] + v0[col + i]); o[i] = xv + (vf[i] - xv) * sg; }
    store4bf(vbuf + (size_t)row * 384 + col, o);
  }
};
struct EpiOut {
  const float* xin; float* xout;
  DI void operator()(int row, int col, f32x4 v) const {
    const f32x4 x = *(const f32x4*)(xin + (size_t)row * 1024 + col);
    *(f32x4*)(xout + (size_t)row * 1024 + col) = x + v;
  }
};

DI void convT(const float* __restrict__ src, int K, int N, bf16_t* dst, int Kpad, int NR, const float* scale, int gt, int ngt) {
  const int kcN = Kpad >> 3, total = NR * kcN;
  for (int idx = gt; idx < total; idx += ngt) {
    const int n = idx % NR, kc = idx / NR; uint4 o = {0u, 0u, 0u, 0u};
    if (n < N) {
      float v[8];
#pragma unroll
      for (int j = 0; j < 8; ++j) { const int k = kc * 8 + j; v[j] = (k < K) ? src[(size_t)k * N + n] * (scale ? scale[k] : 1.f) : 0.f; }
      o.x = pk2(v[0], v[1]); o.y = pk2(v[2], v[3]); o.z = pk2(v[4], v[5]); o.w = pk2(v[6], v[7]);
    }
    *(uint4*)(dst + (size_t)n * Kpad + kc * 8) = o;
  }
}
DI void norm_rows_bf16(const float* x, const float* gain, bf16_t* hb, int rbeg, int rend, int gw, int ngw, int lane) {
  for (int row = rbeg + gw; row < rend; row += ngw) {
    const f32x4* xr = (const f32x4*)(x + (size_t)row * 1024) + lane;
    f32x4 v[4]; float s = 0.f;
#pragma unroll
    for (int j = 0; j < 4; ++j) { v[j] = xr[64 * j]; s += v[j][0] * v[j][0] + v[j][1] * v[j][1] + v[j][2] * v[j][2] + v[j][3] * v[j][3]; }
    const float rstd = 1.f / sqrtf(wave_sum(s) * (1.f / 1024.f) + 1e-6f);
#pragma unroll
    for (int j = 0; j < 4; ++j) { const f32x4 gg = *((const f32x4*)gain + lane + 64 * j); store4bf(hb + (size_t)row * 1024 + 4 * lane + 256 * j, v[j] * rstd * gg); }
  }
}

DI void p2_unit(unsigned char* lds, const KP& p, int l, int rt, int parts = 15, bool dummy = false) {
  unsigned char* ws = p.ws;
  const int tid = otid(), lane = tid & 63, w = tid >> 6, row0 = rt * 64;
  bf16_t* pB = (bf16_t*)(ws + OFF_R2);
  bf16_t* Qm = (bf16_t*)(ws + OFF_R1); bf16_t* Km = Qm + (size_t)T * 576;
  bf16_t* VtM = (bf16_t*)(ws + OFF_VTM);
  bf16_t* rbuf = (bf16_t*)(ws + OFF_SC); bf16_t* kbuf = rbuf + (size_t)T * 384; bf16_t* vbuf = kbuf + (size_t)T * 384;
  bf16_t* wbuf = vbuf + (size_t)T * 384; bf16_t* kkbuf = wbuf + (size_t)T * 384; bf16_t* abuf = kkbuf + (size_t)T * 384;
  bf16_t* LA = (bf16_t*)(ws + OFF_LA);
  const float* tab = (const float*)(ws + OFF_TAB);
  float* sRq = (float*)(lds + 73728); float* sRkv = sRq + 64;
  __syncthreads();
  if (parts & 1) {
    const int r = tid >> 2, part = tid & 3; const bf16_t* pr = pB + (size_t)(row0 + r) * LDPB;
    float sq = 0.f, sk = 0.f;
#pragma unroll
    for (int j = 0; j < 16; ++j) { f32x4 v = load4bf(pr + part * 64 + j * 4); sq += v[0] * v[0] + v[1] * v[1] + v[2] * v[2] + v[3] * v[3]; }
#pragma unroll
    for (int j = 0; j < 8; ++j) { f32x4 v = load4bf(pr + 256 + part * 32 + j * 4); sk += v[0] * v[0] + v[1] * v[1] + v[2] * v[2] + v[3] * v[3]; }
    sq += dppmov<0xB1>(sq); sq += dppmov<0x4E>(sq); sk += dppmov<0xB1>(sk); sk += dppmov<0x4E>(sk);
    if (part == 0) { sRq[r] = 1.f / sqrtf(sq * (1.f / 256.f) + 1e-6f); sRkv[r] = 1.f / sqrtf(sk * (1.f / 128.f) + 1e-6f); }
  }
  if (dummy) { rbuf = (bf16_t*)p.out; wbuf = rbuf + (size_t)T * 384; kkbuf = wbuf + (size_t)T * 384; vbuf = kkbuf + (size_t)T * 384; }
  if (parts & 2) {
    const float* mu = p.in[12] + l * 1280; const float* kkw = p.in[20] + l * 384;
    float mur[6], muk[6], muv_[6], kkw_[6];
#pragma unroll
    for (int h = 0; h < 6; ++h) { mur[h] = mu[h * 64 + lane]; muk[h] = mu[384 + h * 64 + lane]; muv_[h] = mu[768 + h * 64 + lane]; kkw_[h] = kkw[h * 64 + lane]; }
    for (int t = w; t < 64; t += 4) {
      const int row = row0 + t, s = row & 2047;
      const bf16_t* pc = pB + (size_t)row * LDPB + 416 + lane;
      const bf16_t* pp = (s > 0) ? pc - LDPB : pc;
      const float pm = (s > 0) ? 1.f : 0.f;
      float cr[6], ck[6], cv[6], qr[6], qk[6], qv[6];
#pragma unroll
      for (int h = 0; h < 6; ++h) { cr[h] = bf2f(pc[h * 64]); ck[h] = bf2f(pc[384 + h * 64]); cv[h] = bf2f(pc[768 + h * 64]); qr[h] = bf2f(pp[h * 64]) * pm; qk[h] = bf2f(pp[384 + h * 64]) * pm; qv[h] = bf2f(pp[768 + h * 64]) * pm; }
#pragma unroll
      for (int h = 0; h < 6; ++h) {
        const float xr = cr[h] + (qr[h] - cr[h]) * mur[h], xk = ck[h] + (qk[h] - ck[h]) * muk[h], xv = cv[h] + (qv[h] - cv[h]) * muv_[h];
        const float kv_ = xk * kkw_[h]; const float ss = wave_sum(kv_ * kv_);
        const float kk = kv_ / fmaxf(sqrtf(ss), 1e-12f);
        const size_t o = (size_t)row * 384 + h * 64 + lane;
        rbuf[o] = (bf16_t)f2bf(xr); wbuf[o] = (bf16_t)f2bf(xk); kkbuf[o] = (bf16_t)f2bf(kk);
        if (l == 0) vbuf[o] = (bf16_t)f2bf(xv);
      }
    }
  }
  if (parts & 4) {
    const float* mu = p.in[12] + l * 1280;
    const float* muv = p.in[13];
    f32x4 cur[12], prv[12];
#pragma unroll
    for (int i = 0; i < 12; ++i) {
      const int item = tid + 256 * i, r = item / 48, q = item - r * 48, row = row0 + r, s = row & 2047;
      const int qc = q < 40 ? q : 39;
      const bf16_t* pc = pB + (size_t)row * LDPB + 416 + 1152 + 4 * qc;
      cur[i] = load4bf(pc); prv[i] = load4bf(s > 0 ? pc - LDPB : pc);
    }
#pragma unroll
    for (int i = 0; i < 12; ++i) {
      const int item = tid + 256 * i, r = item / 48, q = item - r * 48, row = row0 + r, s = row & 2047;
      f32x4 o;
#pragma unroll
      for (int e = 0; e < 4; ++e) {
        const int j = 4 * q + e;
        const bool act = (j < 128) || (j < 160 && l > 0);
        const float m = (j < 128) ? mu[1152 + j] : muv[(j < 160 ? j : 159) - 128];
        const float pv = (s > 0) ? prv[i][e] : 0.f;
        float val = cur[i][e] + (pv - cur[i][e]) * m;
        if (j < 64) val = 1.f - 2.f / (fexp(2.f * val) + 1.f);
        o[e] = act ? val : 0.f;
      }
      store4bf(LA + (size_t)row * 192 + 4 * q, o);
    }
  }
  __syncthreads();
  if (parts & 1) {
    const bf16_t* WuqT = (const bf16_t*)(ws + OFF_WUQ + l * SZ_WUQ);
    const bf16_t* WukvT = (const bf16_t*)(ws + OFF_WUKV + l * SZ_WUKV);
    EpiQ eq{Qm, sRq, row0};
    for (int ct = 0; ct < 5; ++ct) gemm_tile<2>(lds, pB, LDPB, WuqT, 256, 256, row0, ct * 128, eq);
    EpiKV ek{Km, VtM, sRkv, row0};
    for (int ct = 0; ct < 6; ++ct) gemm_tile<2>(lds, pB + 256, LDPB, WukvT, 128, 128, row0, ct * 128, ek);
  }
  if (parts & 8) {
    const bf16_t* w2T = (const bf16_t*)(ws + OFF_W2 + l * SZ_L);
    const bf16_t* a2T = (const bf16_t*)(ws + OFF_A2 + l * SZ_L);
    const bf16_t* v2T = (const bf16_t*)(ws + OFF_V2);
    EpiA ea{dummy ? kkbuf : abuf, dummy ? vbuf : kbuf, wbuf, p.in[16] + l * 384, p.in[21] + l * 384};
    for (int ct = 0; ct < 3; ++ct) gemm_tile<2>(lds, LA + 64, 192, a2T, 64, 64, row0, ct * 128, ea);
    __syncthreads();
    EpiW ew{wbuf, p.in[14] + l * 384};
    for (int ct = 0; ct < 3; ++ct) gemm_tile<2>(lds, LA, 192, w2T, 64, 64, row0, ct * 128, ew);
    if (l > 0) {
      EpiV ev{vbuf, pB, p.in[18], p.in[12] + l * 1280};
      for (int ct = 0; ct < 3; ++ct) gemm_tile<2>(lds, LA + 128, 192, v2T, 64, 64, row0, ct * 128, ev);
    }
  }
  __syncthreads();
  if (parts & 1) {
    for (int idx = tid; idx < 64 * 16; idx += NTH) {
      const int r = idx >> 4, i = idx & 15, row = row0 + r, s = row & 2047;
      const float c = tab[s * 32 + i], sn = tab[s * 32 + 16 + i];
      bf16_t* q = Qm + (size_t)row * 576 + 64;
#pragma unroll
      for (int h = 0; h < 6; ++h) { const float t1 = bf2f(q[h * 96 + i]), t2 = bf2f(q[h * 96 + 16 + i]); q[h * 96 + i] = (bf16_t)f2bf(t1 * c - t2 * sn); q[h * 96 + 16 + i] = (bf16_t)f2bf(t1 * sn + t2 * c); }
      const float k1 = bf2f(pB[(size_t)row * LDPB + 384 + i]), k2 = bf2f(pB[(size_t)row * LDPB + 400 + i]);
      const bf16_t o1 = (bf16_t)f2bf(k1 * c - k2 * sn), o2 = (bf16_t)f2bf(k1 * sn + k2 * c);
      bf16_t* kq = Km + (size_t)row * 576 + 64;
#pragma unroll
      for (int h = 0; h < 6; ++h) { kq[h * 96 + i] = o1; kq[h * 96 + 16 + i] = o2; }
    }
  }
}

struct ScanOps { f32x4 w, k, a, b, r; f2v_t v, bk; };
DI void scan_unit(unsigned char* lds, const KP& p, int unit) {
  unsigned char* ws = p.ws;
  float* sm = (float*)lds;
  const int tid = otid(), lane = tid & 63, w16 = tid >> 6, rg = lane >> 4, cg_ = lane & 15;
  const int hid = unit >> 1, half = unit & 1, b = hid / 6, h = hid - b * 6;
  const bf16_t* rbuf = (const bf16_t*)(ws + OFF_SC); const bf16_t* kbuf = rbuf + (size_t)T * 384; const bf16_t* vbuf = kbuf + (size_t)T * 384;
  const bf16_t* wbuf = vbuf + (size_t)T * 384; const bf16_t* kkbuf = wbuf + (size_t)T * 384; const bf16_t* abuf = kkbuf + (size_t)T * 384;
  bf16_t* ybuf = (bf16_t*)(ws + OFF_R2);
  const int st = tid >> 4, sp = tid & 15;
  const size_t gbase = ((size_t)b * 2048) * 384 + h * 64 + sp * 4;
  uint2 qw, qk, qkk, qa, qr, qv;
#define SCAN_LOAD(t0) do { const size_t o_ = gbase + (size_t)((t0) + st) * 384; qw = *(const uint2*)(wbuf + o_); qk = *(const uint2*)(kbuf + o_); qkk = *(const uint2*)(kkbuf + o_); \
    qa = *(const uint2*)(abuf + o_); qr = *(const uint2*)(rbuf + o_); qv = *(const uint2*)(vbuf + o_); } while (0)
  f2v_t P0 = {0.f, 0.f}, P1 = {0.f, 0.f}, P2 = {0.f, 0.f}, P3 = {0.f, 0.f};
  SCAN_LOAD(0);
  const int rowoff = half * 32 + w16 * 8 + rg * 2;
  bf16_t* yout = ybuf + ((size_t)b * 2048) * 384 + h * 64 + rowoff;
  __builtin_amdgcn_s_setprio(3);
  for (int ch = 0; ch < 128; ++ch) {
    __syncthreads();
    {
      float* d = sm + st * 400 + sp * 4;
      const f32x4 fw = up4(qw), fk = up4(qk), fkk = up4(qkk), fa = up4(qa), fr = up4(qr), fv = up4(qv);
      f32x4 dec;
#pragma unroll
      for (int i = 0; i < 4; ++i) dec[i] = fexp(fw[i]);
      const f32x4 bp = fkk * fa;
      float be = bp[0] * fr[0] + bp[1] * fr[1] + bp[2] * fr[2] + bp[3] * fr[3];
      float ka = fk[0] * fr[0] + fk[1] * fr[1] + fk[2] * fr[2] + fk[3] * fr[3];
      be = rowsum16(be); ka = rowsum16(ka);
      *(f32x4*)(d) = dec; *(f32x4*)(d + 64) = fk; *(f32x4*)(d + 128) = -fkk; *(f32x4*)(d + 192) = bp; *(f32x4*)(d + 256) = dec * fr; *(f32x4*)(d + 320) = fv;
      if (sp == 0) { sm[st * 400 + 384] = be; sm[st * 400 + 385] = ka; }
    }
    __syncthreads();
    if (ch + 1 < 128) SCAN_LOAD((ch + 1) * 16);
#define SCAN_OPS(D, t_) do { const float* q_ = sm + (t_) * 400; D.w = *(const f32x4*)(q_ + 4 * cg_); D.k = *(const f32x4*)(q_ + 64 + 4 * cg_); D.a = *(const f32x4*)(q_ + 128 + 4 * cg_); \
      D.b = *(const f32x4*)(q_ + 192 + 4 * cg_); D.r = *(const f32x4*)(q_ + 256 + 4 * cg_); D.v = *(const f2v_t*)(q_ + 320 + rowoff); D.bk = *(const f2v_t*)(q_ + 384); } while (0)
    ScanOps cur, nxt;
    SCAN_OPS(cur, 0); nxt = cur;
#pragma unroll
    for (int t = 0; t < 16; ++t) {
      if (t < 15) SCAN_OPS(nxt, t + 1);
      asm volatile("" ::: "memory");
      const f32x4 w4 = cur.w, k4 = cur.k, a4 = cur.a, b4 = cur.b, r4 = cur.r; const f2v_t v2 = cur.v, bk = cur.bk;
      const f2v_t sa = (P0 * a4[0] + P1 * a4[1]) + (P2 * a4[2] + P3 * a4[3]);
      const f2v_t yd = (P0 * r4[0] + P1 * r4[1]) + (P2 * r4[2] + P3 * r4[3]);
      const f2v_t vk0 = v2 * k4[0], vk1 = v2 * k4[1], vk2 = v2 * k4[2], vk3 = v2 * k4[3];
      const f2v_t pw0 = P0 * w4[0], pw1 = P1 * w4[1], pw2 = P2 * w4[2], pw3 = P3 * w4[3];
      float sa0 = sa[0], sa1 = sa[1];
      sa0 += dppmov<0xB1>(sa0); sa1 += dppmov<0xB1>(sa1);
      sa0 += dppmov<0x4E>(sa0); sa1 += dppmov<0x4E>(sa1);
      sa0 += dppmov<0x124>(sa0); sa1 += dppmov<0x124>(sa1);
      sa0 += dppmov<0x128>(sa0); sa1 += dppmov<0x128>(sa1);
      const f2v_t sa2 = {sa0, sa1};
      P0 = pw0 + (sa2 * b4[0] + vk0); P1 = pw1 + (sa2 * b4[1] + vk1); P2 = pw2 + (sa2 * b4[2] + vk2); P3 = pw3 + (sa2 * b4[3] + vk3);
      float y0 = yd[0], y1 = yd[1];
      y0 += dppmov<0xB1>(y0); y1 += dppmov<0xB1>(y1);
      y0 += dppmov<0x4E>(y0); y1 += dppmov<0x4E>(y1);
      y0 += dppmov<0x124>(y0); y1 += dppmov<0x124>(y1);
      y0 += dppmov<0x128>(y0); y1 += dppmov<0x128>(y1);
      y0 += sa0 * bk[0] + v2[0] * bk[1]; y1 += sa1 * bk[0] + v2[1] * bk[1];
      *(unsigned*)(yout + (size_t)(ch * 16 + t) * 384) = pk2(y0, y1);
      cur = nxt;
    }
#undef SCAN_OPS
  }
  __builtin_amdgcn_s_setprio(0);
#undef SCAN_LOAD
}

template <bool DIFF>
DI void attn_unit(unsigned char* lds, const bf16_t* __restrict__ Qb, const bf16_t* __restrict__ Kb, int ld, const bf16_t* __restrict__ Vt,
                  const bf16_t* __restrict__ gate, bf16_t* mixed, const int* __restrict__ pos, int qb, int h, int rowb,
                  float lam_full, float lam_init, const float* __restrict__ gsub) {
  constexpr int KS = DIFF ? 1 : 3, NM = DIFF ? 2 : 1, KW = DIFF ? 72 : 104, NQT = DIFF ? 1 : 2, QU = 64 * NQT;
  bf16_t* sK = (bf16_t*)lds; bf16_t* sV = sK + 64 * KW;
  const int tid = otid(), lane = tid & 63, w = tid >> 6, lr = lane & 15, g = lane >> 4;
  const int q0 = qb * QU, qw0 = q0 + 16 * NQT * w;
  bf16x8 qf[NM][NQT][KS];
#pragma unroll
  for (int m = 0; m < NM; ++m)
#pragma unroll
    for (int qt = 0; qt < NQT; ++qt)
#pragma unroll
      for (int ks = 0; ks < KS; ++ks) qf[m][qt][ks] = *(const bf16x8*)(Qb + (size_t)(qw0 + 16 * qt + lr) * ld + m * 32 + ks * 32 + g * 8);
  f32x4 O[NM][4][NQT]; float mrun[NM][NQT], lrun[NM][NQT];
#pragma unroll
  for (int m = 0; m < NM; ++m)
#pragma unroll
    for (int qt = 0; qt < NQT; ++qt) { mrun[m][qt] = -INFINITY; lrun[m][qt] = 0.f;
#pragma unroll
      for (int dt = 0; dt < 4; ++dt) O[m][dt][qt] = (f32x4){0.f, 0.f, 0.f, 0.f}; }
  float posq[2] = {0.f, 0.f};
  if (DIFF) { posq[0] = (float)pos[qw0 + lr]; if (NQT > 1) posq[1] = (float)pos[qw0 + 16 + lr]; }
  const float sc = DIFF ? (0.17677669529663687f * 1.4426950408889634f) : (0.10206207261596575f * 1.4426950408889634f);
  const float slope2 = DIFF ? ex2(-2.f * (float)(h + 1)) * 1.4426950408889634f : 0.f;
  const int nkt = (q0 + QU) / 64;
  const int vr = tid >> 3, vc = tid & 7;
  int kr0, kc0, kr1, kc1, kr2 = 0, kc2 = 0;
  if (DIFF) { kr0 = vr; kc0 = vc; kr1 = vr + 32; kc1 = vc; }
  else { kr0 = tid / 12; kc0 = tid - kr0 * 12; kr1 = (tid + 256) / 12; kc1 = (tid + 256) - kr1 * 12; kr2 = (tid + 512) / 12; kc2 = (tid + 512) - kr2 * 12; }
  uint4 rk0, rk1, rk2 = {0u, 0u, 0u, 0u}, rv0, rv1;
#define ATT_LOAD(j_) do { rk0 = *(const uint4*)(Kb + (size_t)(64 * (j_) + kr0) * ld + kc0 * 8); rk1 = *(const uint4*)(Kb + (size_t)(64 * (j_) + kr1) * ld + kc1 * 8); \
    if (!DIFF) rk2 = *(const uint4*)(Kb + (size_t)(64 * (j_) + kr2) * ld + kc2 * 8); \
    rv0 = *(const uint4*)(Vt + (size_t)vr * 2048 + 64 * (j_) + vc * 8); rv1 = *(const uint4*)(Vt + (size_t)(vr + 32) * 2048 + 64 * (j_) + vc * 8); } while (0)
  ATT_LOAD(0);
  for (int j = 0; j < nkt; ++j) {
    __syncthreads();
    *(uint4*)(sK + kr0 * KW + kc0 * 8) = rk0; *(uint4*)(sK + kr1 * KW + kc1 * 8) = rk1; if (!DIFF) *(uint4*)(sK + kr2 * KW + kc2 * 8) = rk2;
    *(uint4*)(sV + vr * 72 + vc * 8) = rv0; *(uint4*)(sV + (vr + 32) * 72 + vc * 8) = rv1;
    __syncthreads();
    if (j + 1 < nkt) ATT_LOAD(j + 1);
    if (64 * j <= qw0 + 16 * NQT - 1) {
      const bool domask = (64 * j + 63 > qw0);
      int4 pk[4];
      if (DIFF) {
#pragma unroll
        for (int kt = 0; kt < 4; ++kt) pk[kt] = *(const int4*)(pos + 64 * j + 16 * kt + 4 * g);
      }
#pragma unroll
      for (int m = 0; m < NM; ++m) {
        f32x4 s[4][NQT];
#pragma unroll
        for (int kt = 0; kt < 4; ++kt) {
#pragma unroll
          for (int qt = 0; qt < NQT; ++qt) s[kt][qt] = (f32x4){0.f, 0.f, 0.f, 0.f};
#pragma unroll
          for (int ks = 0; ks < KS; ++ks) {
            const bf16x8 kf = *(const bf16x8*)(sK + (16 * kt + lr) * KW + m * 32 + ks * 32 + g * 8);
#pragma unroll
            for (int qt = 0; qt < NQT; ++qt) s[kt][qt] = MFMA16(kf, qf[m][qt][ks], s[kt][qt]);
          }
        }
#pragma unroll
        for (int kt = 0; kt < 4; ++kt)
#pragma unroll
          for (int qt = 0; qt < NQT; ++qt)
#pragma unroll
            for (int i = 0; i < 4; ++i) {
              float v = s[kt][qt][i] * sc;
              if (DIFF) { const int pki = (i == 0) ? pk[kt].x : (i == 1) ? pk[kt].y : (i == 2) ? pk[kt].z : pk[kt].w; v -= slope2 * fabsf(posq[qt] - (float)pki); }
              s[kt][qt][i] = v;
            }
        if (domask) {
#pragma unroll
          for (int kt = 0; kt < 4; ++kt)
#pragma unroll
            for (int qt = 0; qt < NQT; ++qt)
#pragma unroll
              for (int i = 0; i < 4; ++i) if (64 * j + 16 * kt + 4 * g + i > qw0 + 16 * qt + lr) s[kt][qt][i] = -INFINITY;
        }
#pragma unroll
        for (int qt = 0; qt < NQT; ++qt) {
          float mx = -INFINITY;
#pragma unroll
          for (int kt = 0; kt < 4; ++kt)
#pragma unroll
            for (int i = 0; i < 4; ++i) mx = fmaxf(mx, s[kt][qt][i]);
          mx = xmax32(xmax16(mx));
          const float mn = fmaxf(mrun[m][qt], mx), alpha = ex2(mrun[m][qt] - mn); mrun[m][qt] = mn;
          float ls = 0.f;
#pragma unroll
          for (int kt = 0; kt < 4; ++kt)
#pragma unroll
            for (int i = 0; i < 4; ++i) { const float pv = ex2(s[kt][qt][i] - mn); ls += pv; s[kt][qt][i] = pv; }
          lrun[m][qt] = lrun[m][qt] * alpha + ls;
#pragma unroll
          for (int dt = 0; dt < 4; ++dt) O[m][dt][qt] = O[m][dt][qt] * alpha;
        }
#pragma unroll
        for (int s2 = 0; s2 < 2; ++s2) {
          bf16x8 pf[NQT];
#pragma unroll
          for (int qt = 0; qt < NQT; ++qt) {
            uint4 u; u.x = pk2(s[2 * s2][qt][0], s[2 * s2][qt][1]); u.y = pk2(s[2 * s2][qt][2], s[2 * s2][qt][3]);
            u.z = pk2(s[2 * s2 + 1][qt][0], s[2 * s2 + 1][qt][1]); u.w = pk2(s[2 * s2 + 1][qt][2], s[2 * s2 + 1][qt][3]);
            pf[qt] = __builtin_bit_cast(bf16x8, u);
          }
#pragma unroll
          for (int dt = 0; dt < 4; ++dt) {
            const uint2 lo = *(const uint2*)(sV + (16 * dt + lr) * 72 + 32 * s2 + 4 * g), hi = *(const uint2*)(sV + (16 * dt + lr) * 72 + 32 * s2 + 16 + 4 * g);
            uint4 u; u.x = lo.x; u.y = lo.y; u.z = hi.x; u.w = hi.y;
            const bf16x8 vf = __builtin_bit_cast(bf16x8, u);
#pragma unroll
            for (int qt = 0; qt < NQT; ++qt) O[m][dt][qt] = MFMA16(vf, pf[qt], O[m][dt][qt]);
          }
        }
      }
    }
  }
#undef ATT_LOAD
#pragma unroll
  for (int qt = 0; qt < NQT; ++qt) {
    const size_t row = (size_t)rowb + qw0 + 16 * qt + lr;
    float inv[NM];
#pragma unroll
    for (int m = 0; m < NM; ++m) { const float lt = xsum32(xsum16(lrun[m][qt])); inv[m] = 1.f / lt; }
    if (!DIFF) {
#pragma unroll
      for (int dt = 0; dt < 4; ++dt) {
        const int col = h * 64 + 16 * dt + 4 * g;
        const f32x4 gt = load4bf(gate + row * LDPA + 512 + col); f32x4 o = O[0][dt][qt] * inv[0];
#pragma unroll
        for (int i = 0; i < 4; ++i) o[i] *= silu(gt[i]);
        store4bf(mixed + row * 1024 + col, o);
      }
    } else {
      f32x4 o[4]; float ss = 0.f;
#pragma unroll
      for (int dt = 0; dt < 4; ++dt) { o[dt] = O[0][dt][qt] * inv[0] - O[NM - 1][dt][qt] * (lam_full * inv[NM - 1]); ss += o[dt][0] * o[dt][0] + o[dt][1] * o[dt][1] + o[dt][2] * o[dt][2] + o[dt][3] * o[dt][3]; }
      ss = xsum32(xsum16(ss));
      const float rs = (1.f / sqrtf(ss * (1.f / 64.f) + 1e-5f)) * (1.f - lam_init);
#pragma unroll
      for (int dt = 0; dt < 4; ++dt) {
        const int dvc = 16 * dt + 4 * g, col = h * 64 + dvc;
        const f32x4 gs = *(const f32x4*)(gsub + dvc); const f32x4 gt = load4bf(gate + row * LDPA + 512 + 384 + col);
        f32x4 r;
#pragma unroll
        for (int i = 0; i < 4; ++i) r[i] = o[dt][i] * rs * gs[i] * silu(gt[i]);
        store4bf(mixed + row * 1024 + 384 + col, r);
      }
    }
  }
}

DI void p4_unit(unsigned char* lds, const KP& p, int l, int rt) {
  unsigned char* ws = p.ws;
  const int tid = otid(), lane = tid & 63, w = tid >> 6, row0 = rt * 64;
  const bf16_t* rbuf = (const bf16_t*)(ws + OFF_SC); const bf16_t* kbuf = rbuf + (size_t)T * 384; const bf16_t* vbuf = kbuf + (size_t)T * 384;
  const bf16_t* ybuf = (const bf16_t*)(ws + OFF_R2); bf16_t* mixed = (bf16_t*)(ws + OFF_R2 + SZ_SC);
  const bf16_t* pA = (const bf16_t*)(ws + OFF_PA);
  const float* lnw = p.in[23] + l * 384; const float* lnb = p.in[24] + l * 384; const float* rk = p.in[22] + l * 384;
  {
    float lw[6], lb[6], rkk[6];
#pragma unroll
    for (int h = 0; h < 6; ++h) { lw[h] = lnw[h * 64 + lane]; lb[h] = lnb[h * 64 + lane]; rkk[h] = rk[h * 64 + lane]; }
    for (int t = w; t < 64; t += 4) {
      const int row = row0 + t; const size_t o = (size_t)row * 384 + lane;
      float y[6], r[6], k[6], v[6], gt[6];
#pragma unroll
      for (int h = 0; h < 6; ++h) { y[h] = bf2f(ybuf[o + h * 64]); r[h] = bf2f(rbuf[o + h * 64]); k[h] = bf2f(kbuf[o + h * 64]); v[h] = bf2f(vbuf[o + h * 64]); gt[h] = bf2f(pA[(size_t)row * LDPA + 512 + 640 + h * 64 + lane]); }
#pragma unroll
      for (int h = 0; h < 6; ++h) {
        const float mean = wave_sum(y[h]) * (1.f / 64.f); const float d = y[h] - mean; const float var = wave_sum(d * d) * (1.f / 64.f);
        const float dot = wave_sum(r[h] * k[h] * rkk[h]);
        const float outv = d * (1.f / sqrtf(var + 64e-5f)) * lw[h] + lb[h] + dot * v[h];
        mixed[(size_t)row * 1024 + 640 + h * 64 + lane] = (bf16_t)f2bf(outv * silu(gt[h]));
      }
    }
  }
  __syncthreads();
  const bf16_t* WoT = (const bf16_t*)(ws + OFF_WO + l * SZ_WO);
  EpiOut eo{l == 0 ? p.in[0] : p.out, p.out};
  for (int ct = 0; ct < 8; ++ct) gemm_tile<2>(lds, mixed, 1024, WoT, 1024, 1024, row0, ct * 128, eo);
  __syncthreads();
  if (l == 0) norm_rows_bf16(p.out, p.in[2] + 1024, (bf16_t*)(ws + OFF_R1), row0, row0 + 64, w, 4, lane);
  else {
    const float* fg = p.in[25];
    for (int row = row0 + w; row < row0 + 64; row += 4) {
      f32x4* xr = (f32x4*)(p.out + (size_t)row * 1024) + lane;
      f32x4 v[4]; float s = 0.f;
#pragma unroll
      for (int j = 0; j < 4; ++j) { v[j] = xr[64 * j]; s += v[j][0] * v[j][0] + v[j][1] * v[j][1] + v[j][2] * v[j][2] + v[j][3] * v[j][3]; }
      const float rstd = 1.f / sqrtf(wave_sum(s) * (1.f / 1024.f) + 1e-6f);
#pragma unroll
      for (int j = 0; j < 4; ++j) { const f32x4 gg = *((const f32x4*)fg + lane + 64 * j); xr[64 * j] = v[j] * rstd * gg; }
    }
  }
}

DI void p3_run(unsigned char* lds, int* s_unit, const KP& p, int l, int cslot, bool do_scan, bool do_att) {
  unsigned char* ws = p.ws;
  const int tid = otid();
  unsigned* ctrS = (unsigned*)(ws + OFF_CTL) + 16 * (2 * cslot + 1);
  unsigned* ctrA = (unsigned*)(ws + OFF_CTL) + 16 * (2 * cslot + 2);
  unsigned* cucnt = (unsigned*)(ws + OFF_CU) + 4096 * cslot;
  const bf16_t* pA = (const bf16_t*)(ws + OFF_PA);
  const bf16_t* Qm = (const bf16_t*)(ws + OFF_R1); const bf16_t* Km = Qm + (size_t)T * 576;
  bf16_t* mixed = (bf16_t*)(ws + OFF_R2 + SZ_SC);
  const int* pos = (const int*)p.in[1];
  const float* lam = p.in[10] + l * 128;
  float d0 = 0.f, d1 = 0.f;
  for (int i = 0; i < 32; ++i) { d0 += lam[i] * lam[32 + i]; d1 += lam[64 + i] * lam[96 + i]; }
  const float lam_init = 0.8f - 0.6f * expf(-0.3f * (float)(l + 1));
  const float lam_full = expf(d0) - expf(d1) + lam_init;
  bool prefer_scan = false, sdone = !do_scan;
  if (tid == 0) {
    const unsigned xcc = (unsigned)__builtin_amdgcn_s_getreg((3 << 11) | 20) & 0xFu;
    const unsigned cu = (unsigned)__builtin_amdgcn_s_getreg((7 << 11) | (8 << 6) | 4) & 0xFFu;
    prefer_scan = (atomicAdd(cucnt + ((xcc << 8) | cu), 1u) == 0u);
  }
  for (;;) {
    __syncthreads();
    if (tid == 0) {
      int code = -1;
      if (prefer_scan && !sdone) { const unsigned u = atomicAdd(ctrS, 1u); if (u < (unsigned)NSCAN) code = (int)u; else sdone = true; }
      if (code < 0 && do_att) { const unsigned u = atomicAdd(ctrA, 1u); if (u < (unsigned)NATT) code = NSCAN + (int)u; }
      if (code < 0 && !sdone) { const unsigned u = atomicAdd(ctrS, 1u); if (u < (unsigned)NSCAN) code = (int)u; else sdone = true; }
      *s_unit = code;
    }
    __syncthreads();
    const int u = *s_unit;
    if (u < 0) break;
    if (u < NSCAN) scan_unit(lds, p, u);
    else if (u < NSCAN + NMLA) {
      const int v = u - NSCAN, qb = 15 - v / 96, bh = v % 96, b = bh / 6, h = bh - b * 6;
      attn_unit<false>(lds, Qm + (size_t)b * 2048 * 576 + h * 96, Km + (size_t)b * 2048 * 576 + h * 96, 576, (const bf16_t*)(ws + OFF_VTM) + (size_t)bh * 64 * 2048,
                       pA, mixed, pos, qb, h, b * 2048, 0.f, 0.f, nullptr);
    } else {
      const int v = u - NSCAN - NMLA, qb = 31 - v / 64, bh = v % 64, b = bh >> 2, h = bh & 3;
      attn_unit<true>(lds, pA + (size_t)b * 2048 * LDPA + h * 64, pA + (size_t)b * 2048 * LDPA + 256 + h * 64, LDPA, (const bf16_t*)(ws + OFF_VTD) + (size_t)bh * 64 * 2048,
                      pA, mixed, pos, qb, h, b * 2048, lam_full, lam_init, p.in[11] + l * 64);
    }
  }
}

DI void gbar(unsigned* bw, unsigned nblk) {
  asm volatile("s_waitcnt vmcnt(0)" ::: "memory");
  __syncthreads();
  if (threadIdx.x == 0) {
    __builtin_amdgcn_fence(__ATOMIC_RELEASE, "agent");
    asm volatile("s_waitcnt vmcnt(0)" ::: "memory");
    const unsigned g = __hip_atomic_load(bw + 64, __ATOMIC_RELAXED, __HIP_MEMORY_SCOPE_AGENT);
    const unsigned prev = __hip_atomic_fetch_add(bw, 1u, __ATOMIC_RELAXED, __HIP_MEMORY_SCOPE_AGENT);
    if (prev == nblk - 1u) {
      __hip_atomic_store(bw, 0u, __ATOMIC_RELAXED, __HIP_MEMORY_SCOPE_AGENT);
      __builtin_amdgcn_fence(__ATOMIC_RELEASE, "agent");
      __hip_atomic_fetch_add(bw + 64, 1u, __ATOMIC_RELAXED, __HIP_MEMORY_SCOPE_AGENT);
    } else {
      while (__hip_atomic_load(bw + 64, __ATOMIC_RELAXED, __HIP_MEMORY_SCOPE_AGENT) == g) __builtin_amdgcn_s_sleep(1);
    }
    __builtin_amdgcn_fence(__ATOMIC_ACQUIRE, "agent");
    asm volatile("s_waitcnt vmcnt(0)" ::: "memory");
  }
  __syncthreads();
}

__global__ void __launch_bounds__(NTH, 2) mk_fwd(KP p) {
  extern __shared__ __attribute__((aligned(16))) unsigned char lds[];
  int& s_unit = *(int*)(lds + 73728 + 1024);
  cg::grid_group grid = cg::this_grid();
  unsigned char* ws = p.ws;
  const int tid = otid(), lane = tid & 63, w = tid >> 6;
  const int G = gridDim.x, bid = blockIdx.x;
#define RUN(k) (p.ph_lo <= (k) && (k) < p.ph_hi)
#define SEAM(k) do { if (RUN(k) && RUN((k) + 1)) gbar((unsigned*)(ws + OFF_CTL) + 512, (unsigned)G); } while (0)
  if (p.ph_lo < 0) grid.sync();

  if (RUN(0)) {
    const int gt = bid * NTH + tid, ngt = G * NTH;
    for (int i = gt; i < 3 * 4096; i += ngt) ((unsigned*)(ws + OFF_CU))[i] = 0u;
    for (int l = 0; l < 2; ++l) {
      bf16_t* Wc = (bf16_t*)(ws + OFF_WC + l * SZ_WC);
      if (l == 0) convT(p.in[3], 1024, 3488, Wc, 1024, NP, nullptr, gt, ngt);
      else { convT(p.in[3] + (size_t)1024 * 3488, 1024, 3488, Wc, 1024, 3488, nullptr, gt, ngt); convT(p.in[4], 1024, 32, Wc + (size_t)3488 * 1024, 1024, 96, nullptr, gt, ngt); }
      convT(p.in[5] + (size_t)l * 1024 * 1024, 1024, 1024, (bf16_t*)(ws + OFF_WO + l * SZ_WO), 1024, 1024, nullptr, gt, ngt);
      convT(p.in[8] + (size_t)l * 256 * 576, 256, 576, (bf16_t*)(ws + OFF_WUQ + l * SZ_WUQ), 256, 640, p.in[6] + l * 256, gt, ngt);
      convT(p.in[9] + (size_t)l * 128 * 768, 128, 768, (bf16_t*)(ws + OFF_WUKV + l * SZ_WUKV), 128, 768, p.in[7] + l * 128, gt, ngt);
      convT(p.in[15] + (size_t)l * 64 * 384, 64, 384, (bf16_t*)(ws + OFF_W2 + l * SZ_L), 64, 384, nullptr, gt, ngt);
      convT(p.in[17] + (size_t)l * 64 * 384, 64, 384, (bf16_t*)(ws + OFF_A2 + l * SZ_L), 64, 384, nullptr, gt, ngt);
    }
    convT(p.in[19], 32, 384, (bf16_t*)(ws + OFF_V2), 64, 384, nullptr, gt, ngt);
    {
      float* tab = (float*)(ws + OFF_TAB); const int* pos = (const int*)p.in[1];
      for (int idx = gt; idx < 2048 * 16; idx += ngt) {
        const int s = idx >> 4, i = idx & 15;
        const float inv = exp2f(-(float)i * (13.287712379549449f / 16.f));
        const float ang = (float)pos[s] * inv;
        double rev = (double)ang * 0.15915494309189535; rev -= __builtin_rint(rev);
        tab[s * 32 + i] = __builtin_amdgcn_cosf((float)rev); tab[s * 32 + 16 + i] = __builtin_amdgcn_sinf((float)rev);
      }
    }
    norm_rows_bf16(p.in[0], p.in[2], (bf16_t*)(ws + OFF_R1), 0, T, bid * 4 + w, G * 4, lane);
  }
  SEAM(0);
#if PROBE == 8
  for (int i = 0; i < 10; ++i) grid.sync();
#endif
#if PROBE == 6
  if (RUN(0)) { norm_rows_bf16(p.in[0], p.in[2], (bf16_t*)(ws + OFF_R1), 0, T, bid * 4 + w, G * 4, lane); grid.sync(); }
#endif
  for (int l = 0; l < 2; ++l) {
    const int pb = 1 + 4 * l;
    if (RUN(pb)) {
      EpiRoute e{(bf16_t*)(ws + OFF_PA), (bf16_t*)(ws + OFF_R2), (bf16_t*)(ws + OFF_VTD), l ? 3520 : 3488};
      const bf16_t* hb = (const bf16_t*)(ws + OFF_R1); const bf16_t* Wc = (const bf16_t*)(ws + OFF_WC + l * SZ_WC);
      for (int rep = 0; rep < ((PROBE == 1 && l == 0) ? 2 : 1); ++rep)
      for (int u = bid; u < 256 * 28; u += G) { const int rt = u / 28, ct = u - rt * 28; gemm_tile<4>(lds, hb, 1024, Wc, 1024, 1024, rt * 128, ct * 128, e); }
    }
    SEAM(pb);
    if (RUN(pb + 1)) { for (int rt = bid; rt < 512; rt += G) p2_unit(lds, p, l, rt);
#if PROBE == 13
      if (l == 0) { gbar((unsigned*)(ws + OFF_CTL) + 512, (unsigned)G); for (int rt = bid; rt < 512; rt += G) p2_unit(lds, p, l, rt, 2, true); }
#elif PROBE == 15
      if (l == 0) { gbar((unsigned*)(ws + OFF_CTL) + 512, (unsigned)G); for (int rt = bid; rt < 512; rt += G) p2_unit(lds, p, l, rt, 8, true); }
#elif PROBE == 14
      if (l == 0) { gbar((unsigned*)(ws + OFF_CTL) + 512, (unsigned)G); for (int rt = bid; rt < 512; rt += G) p2_unit(lds, p, l, rt, 4, false); }
#endif
    }
    SEAM(pb + 1);
    if (RUN(pb + 2)) {
      p3_run(lds, &s_unit, p, l, l, true, true);
#if PROBE == 3
      if (l == 0) { grid.sync(); p3_run(lds, &s_unit, p, l, 2, true, false); }
#elif PROBE == 9
      if (l == 0) { grid.sync(); p3_run(lds, &s_unit, p, l, 2, true, true); }
#elif PROBE == 10
      if (l == 0) { grid.sync(); p3_run(lds, &s_unit, p, l, 2, false, true); }
#endif
    }
    SEAM(pb + 2);
    if (RUN(pb + 3)) { for (int rep = 0; rep < ((PROBE == 5 && l == 0) ? 2 : 1); ++rep) { if (rep) grid.sync(); for (int rt = bid; rt < 512; rt += G) p4_unit(lds, p, l, rt); } }
    SEAM(pb + 3);
  }
#undef RUN
#undef SEAM
}

extern "C" void kernel_launch(void* const* d_in, const int* in_sizes, int n_in, void* d_out, int out_size, void* d_ws, size_t ws_size, hipStream_t stream) {
  static int grid = 0;
  if (grid == 0) {
    if (n_in != 26 || ws_size < WS_END) { fprintf(stderr, "kernel_launch: need 26 inputs and %zu bytes of workspace (got %d, %zu)\n", (size_t)WS_END, n_in, ws_size); grid = -1; return; }
    int dev = 0, cus = 0, per_cu = 0;
    (void)hipGetDevice(&dev);
    (void)hipDeviceGetAttribute(&cus, hipDeviceAttributeMultiprocessorCount, dev);
    (void)hipFuncSetAttribute((const void*)mk_fwd, hipFuncAttributeMaxDynamicSharedMemorySize, LDS_BYTES);
    (void)hipOccupancyMaxActiveBlocksPerMultiprocessor(&per_cu, (const void*)mk_fwd, NTH, LDS_BYTES);
    if (per_cu > 2) per_cu = 2;
    if (per_cu < 1) { fprintf(stderr, "kernel_launch: occupancy query returned %d\n", per_cu); per_cu = 1; }
    grid = cus * per_cu;
  }
  if (grid < 0) return;
  (void)hipMemsetAsync(d_ws, 0, 4096, stream);
  KP p{};
  for (int i = 0; i < 26; ++i) p.in[i] = (const float*)d_in[i];
  p.out = (float*)d_out; p.ws = (unsigned char*)d_ws;
  if (MK_LAUNCHES == 1) {
    p.ph_lo = 0; p.ph_hi = NPHASE;
    void* args[] = {&p};
    hipError_t e = hipLaunchCooperativeKernel((const void*)mk_fwd, dim3(grid), dim3(NTH), args, LDS_BYTES, stream);
    if (e != hipSuccess) fprintf(stderr, "cooperative launch failed: %s (grid %d)\n", hipGetErrorString(e), grid);
  } else {
    for (int k = 0; k < NPHASE; ++k) { p.ph_lo = k; p.ph_hi = k + 1; hipLaunchKernelGGL(mk_fwd, dim3(grid), dim3(NTH), LDS_BYTES, stream, p); }
  }
}
```

```cpp
#include <hip/hip_runtime.h>
#include <hip/hip_cooperative_groups.h>
#include <cstdio>
#include <cstdint>
namespace cg = cooperative_groups;

#ifndef PROBE
#define PROBE 0
#endif
#ifndef MK_LAUNCHES
#define MK_LAUNCHES 1
#endif

typedef unsigned short bf16_t;
typedef short bf16x8 __attribute__((ext_vector_type(8)));
typedef float f32x4 __attribute__((ext_vector_type(4)));
#define DI __device__ __forceinline__

constexpr int NB = 16, SEQ = 2048, T = NB * SEQ, DM = 1024;
constexpr int NP = 3584;
constexpr int LDPA = 1536;
constexpr int LDPB = 1728;
constexpr int NPHASE = 9;
constexpr int LDS_BYTES = 73728 + 1024 + 1024;
constexpr int NTH = 256;
constexpr int NSCAN = 192, NMLA = 96 * 16, NDIFF = 64 * 32, NATT = NMLA + NDIFF;

constexpr size_t OFF_CTL = 0;
constexpr size_t OFF_TAB = 4096;
constexpr size_t SZ_WC = (size_t)NP * 1024 * 2;
constexpr size_t OFF_WC = OFF_TAB + 262144;
constexpr size_t SZ_WO = (size_t)1024 * 1024 * 2;
constexpr size_t OFF_WO = OFF_WC + 2 * SZ_WC;
constexpr size_t SZ_WUQ = (size_t)640 * 256 * 2;
constexpr size_t OFF_WUQ = OFF_WO + 2 * SZ_WO;
constexpr size_t SZ_WUKV = (size_t)768 * 128 * 2;
constexpr size_t OFF_WUKV = OFF_WUQ + 2 * SZ_WUQ;
constexpr size_t SZ_L = (size_t)384 * 64 * 2;
constexpr size_t OFF_W2 = OFF_WUKV + 2 * SZ_WUKV;
constexpr size_t OFF_A2 = OFF_W2 + 2 * SZ_L;
constexpr size_t OFF_V2 = OFF_A2 + 2 * SZ_L;
constexpr size_t OFF_R1 = OFF_V2 + SZ_L;
constexpr size_t SZ_QK = (size_t)T * 576 * 2;
constexpr size_t OFF_PA = OFF_R1 + 2 * SZ_QK;
constexpr size_t OFF_R2 = OFF_PA + (size_t)T * LDPA * 2;
constexpr size_t SZ_Y = (size_t)T * 384 * 4;
constexpr size_t OFF_MIX = OFF_R2 + SZ_Y;
constexpr size_t OFF_VTM = OFF_MIX + (size_t)T * 1024 * 2;
static_assert(OFF_MIX + (size_t)T * 1024 * 2 >= OFF_R2 + (size_t)T * LDPB * 2, "R2 holds projB");
constexpr size_t OFF_VTD = OFF_VTM + (size_t)T * 384 * 2;
constexpr size_t SZ_SC = (size_t)T * 384 * 2;
constexpr size_t OFF_SC = OFF_VTD + (size_t)T * 256 * 2;
constexpr size_t OFF_LA = OFF_SC + 6 * SZ_SC;
constexpr size_t OFF_CU = OFF_LA + (size_t)T * 192 * 2;
constexpr size_t OFF_T0 = OFF_CU + 3 * 4096 * 4;
constexpr size_t WS_END = OFF_T0 + 3 * 16 * 384 * 4;
static_assert(OFF_R1 % 256 == 0, "align");

struct KP { const float* in[26]; float* out; unsigned char* ws; int ph_lo, ph_hi; };

DI unsigned f2bf(float f) { unsigned u = __float_as_uint(f); return (u + 0x7fffu + ((u >> 16) & 1u)) >> 16; }
DI float bf2f(bf16_t h) { return __uint_as_float(((unsigned)h) << 16); }
typedef __bf16 bf2v_t __attribute__((ext_vector_type(2)));
typedef float f2v_t __attribute__((ext_vector_type(2)));
DI unsigned pk2(float a, float b) { f2v_t f = {a, b}; return __builtin_bit_cast(unsigned, __builtin_convertvector(f, bf2v_t)); }
DI void store4bf(bf16_t* p, f32x4 v) { uint2 u; u.x = pk2(v[0], v[1]); u.y = pk2(v[2], v[3]); *(uint2*)p = u; }
DI f32x4 up4(uint2 u) { f32x4 r; r[0] = __uint_as_float(u.x << 16); r[1] = __uint_as_float(u.x & 0xffff0000u); r[2] = __uint_as_float(u.y << 16); r[3] = __uint_as_float(u.y & 0xffff0000u); return r; }
DI f32x4 load4bf(const bf16_t* p) { return up4(*(const uint2*)p); }
DI float ex2(float x) { return __builtin_amdgcn_exp2f(x); }
DI float fexp(float x) { return __builtin_amdgcn_exp2f(x * 1.4426950408889634f); }
DI float sigm(float x) { return 1.f / (1.f + fexp(-x)); }
DI float silu(float x) { return x / (1.f + fexp(-x)); }
template <int CTRL> DI float dppmov(float x) { return __builtin_bit_cast(float, __builtin_amdgcn_update_dpp(0, __builtin_bit_cast(int, x), CTRL, 0xF, 0xF, true)); }
DI float rowsum16(float x) {
  x += dppmov<0xB1>(x);
  x += dppmov<0x4E>(x);
  x += dppmov<0x141>(x);
  x += dppmov<0x140>(x);
  return x;
}
DI int otid() { int t = threadIdx.x; asm volatile("" : "+v"(t)); return t; }
DI void swap16(unsigned& a, unsigned& b) { asm("s_nop 1\n\tv_permlane16_swap_b32 %0, %1" : "+v"(a), "+v"(b)); }
DI void swap32(unsigned& a, unsigned& b) { asm("s_nop 1\n\tv_permlane32_swap_b32 %0, %1" : "+v"(a), "+v"(b)); }
DI float xsum16(float x) { unsigned a = __float_as_uint(x), b = a; swap16(a, b); return __uint_as_float(a) + __uint_as_float(b); }
DI float xsum32(float x) { unsigned a = __float_as_uint(x), b = a; swap32(a, b); return __uint_as_float(a) + __uint_as_float(b); }
DI float xmax16(float x) { unsigned a = __float_as_uint(x), b = a; swap16(a, b); return fmaxf(__uint_as_float(a), __uint_as_float(b)); }
DI float xmax32(float x) { unsigned a = __float_as_uint(x), b = a; swap32(a, b); return fmaxf(__uint_as_float(a), __uint_as_float(b)); }
DI float wave_sum(float v) { return xsum32(xsum16(rowsum16(v))); }
#define MFMA16(a, b, c) __builtin_amdgcn_mfma_f32_16x16x32_bf16((a), (b), (c), 0, 0, 0)

template <int MI, class Epi>
DI void gemm_tile(unsigned char* lds, const bf16_t* __restrict__ A, int lda, const bf16_t* __restrict__ Bt, int ldb, int K, int row0, int col0, const Epi& epi) {
  constexpr int BM = 32 * MI;
  constexpr int BUFE = (BM + 128) * 64;
  bf16_t* sbase = (bf16_t*)lds;
  const int tid = otid(), lane = tid & 63, w = tid >> 6, wm = w >> 1, wn = w & 1, lr = lane & 15, g = lane >> 4;
  const int sr = tid >> 3, skc = tid & 7, swc = (skc ^ (sr & 7)) * 8;
  const int xr = lr & 7;
  const bf16_t* gA = A + (size_t)(row0 + sr) * lda + skc * 8;
  const bf16_t* gB = Bt + (size_t)(col0 + sr) * ldb + skc * 8;
  uint4 ra0, ra1, ra2 = {0u, 0u, 0u, 0u}, ra3 = {0u, 0u, 0u, 0u}, rb0, rb1, rb2, rb3;
#define G_LOAD(k0_) do { ra0 = *(const uint4*)(gA + (k0_)); ra1 = *(const uint4*)(gA + (size_t)32 * lda + (k0_)); \
    if (MI == 4) { ra2 = *(const uint4*)(gA + (size_t)64 * lda + (k0_)); ra3 = *(const uint4*)(gA + (size_t)96 * lda + (k0_)); } \
    rb0 = *(const uint4*)(gB + (k0_)); rb1 = *(const uint4*)(gB + (size_t)32 * ldb + (k0_)); rb2 = *(const uint4*)(gB + (size_t)64 * ldb + (k0_)); rb3 = *(const uint4*)(gB + (size_t)96 * ldb + (k0_)); } while (0)
#define G_STORE(buf_) do { bf16_t* sA_ = sbase + (buf_) * BUFE + sr * 64 + swc; bf16_t* sB_ = sA_ + BM * 64; \
    *(uint4*)(sA_) = ra0; *(uint4*)(sA_ + 32 * 64) = ra1; \
    if (MI == 4) { *(uint4*)(sA_ + 64 * 64) = ra2; *(uint4*)(sA_ + 96 * 64) = ra3; } \
    *(uint4*)(sB_) = rb0; *(uint4*)(sB_ + 32 * 64) = rb1; *(uint4*)(sB_ + 64 * 64) = rb2; *(uint4*)(sB_ + 96 * 64) = rb3; } while (0)
  f32x4 acc[MI][4];
#pragma unroll
  for (int mi = 0; mi < MI; ++mi)
#pragma unroll
    for (int ni = 0; ni < 4; ++ni) acc[mi][ni] = (f32x4){0.f, 0.f, 0.f, 0.f};
  const int nk = K >> 6;
  G_LOAD(0);
  G_STORE(0);
  if (nk > 1) G_LOAD(64);
  __syncthreads();
  for (int kt = 0; kt < nk; ++kt) {
    const int cur = kt & 1;
    if (kt + 1 < nk) { G_STORE(cur ^ 1); if (kt + 2 < nk) G_LOAD((kt + 2) * 64); }
    const bf16_t* sA = sbase + cur * BUFE; const bf16_t* sB = sA + BM * 64;
#pragma unroll
    for (int ks = 0; ks < 2; ++ks) {
      bf16x8 af[MI], bfr[4];
#pragma unroll
      for (int mi = 0; mi < MI; ++mi) af[mi] = *(const bf16x8*)(sA + (wm * 16 * MI + mi * 16 + lr) * 64 + ((ks * 4 + g) ^ xr) * 8);
#pragma unroll
      for (int ni = 0; ni < 4; ++ni) bfr[ni] = *(const bf16x8*)(sB + (wn * 64 + ni * 16 + lr) * 64 + ((ks * 4 + g) ^ xr) * 8);
      __builtin_amdgcn_s_setprio(1);
#pragma unroll
      for (int mi = 0; mi < MI; ++mi)
#pragma unroll
        for (int ni = 0; ni < 4; ++ni) acc[mi][ni] = MFMA16(bfr[ni], af[mi], acc[mi][ni]);
      __builtin_amdgcn_s_setprio(0);
    }
    __syncthreads();
  }
#undef G_STORE
#pragma unroll
  for (int mi = 0; mi < MI; ++mi)
#pragma unroll
    for (int ni = 0; ni < 4; ++ni) epi(row0 + wm * 16 * MI + mi * 16 + lr, col0 + wn * 64 + ni * 16 + 4 * g, acc[mi][ni]);
#undef G_LOAD
}

struct EpiRoute {
  bf16_t* pA; bf16_t* pB; bf16_t* VtD; int ncols;
  DI void operator()(int row, int col, f32x4 v) const {
    if (col >= ncols) return;
    if (col < 416) store4bf(pB + (size_t)row * LDPB + col, v);
    else if (col < 928) store4bf(pA + (size_t)row * LDPA + (col - 416), v);
    else if (col < 1184) {
      const int c = col - 928, h = c >> 6, dv = c & 63, b = row >> 11, s = row & 2047;
      bf16_t* q = VtD + ((size_t)((b * 4 + h) * 64 + dv)) * 2048 + s;
      q[0] = (bf16_t)f2bf(v[0]); q[2048] = (bf16_t)f2bf(v[1]); q[4096] = (bf16_t)f2bf(v[2]); q[6144] = (bf16_t)f2bf(v[3]);
    }
    else if (col < 2208) store4bf(pA + (size_t)row * LDPA + 512 + (col - 1184), v);
    else store4bf(pB + (size_t)row * LDPB + 416 + (col - 2208), v);
  }
};
struct EpiQ {
  bf16_t* __restrict__ Qm; const float* __restrict__ rs; int row0;
  DI void operator()(int row, int col, f32x4 v) const {
    if (col >= 576) return;
    const float r = rs[row - row0]; v = v * r;
    store4bf(Qm + (size_t)row * 576 + col, v);
  }
};
struct EpiKV {
  bf16_t* __restrict__ Km; bf16_t* __restrict__ VtM; const float* __restrict__ rs; int row0;
  DI void operator()(int row, int col, f32x4 v) const {
    const float r = rs[row - row0]; v = v * r;
    const int head = col >> 7, c = col & 127;
    if (c < 64) store4bf(Km + (size_t)row * 576 + head * 96 + c, v);
    else {
      const int b = row >> 11, s = row & 2047;
      bf16_t* q = VtM + ((size_t)((b * 6 + head) * 64 + (c - 64))) * 2048 + s;
      q[0] = (bf16_t)f2bf(v[0]); q[2048] = (bf16_t)f2bf(v[1]); q[4096] = (bf16_t)f2bf(v[2]); q[6144] = (bf16_t)f2bf(v[3]);
    }
  }
};
struct EpiW {
  bf16_t* __restrict__ wbuf; const float* __restrict__ w0;
  DI void operator()(int row, int col, f32x4 v) const {
    f32x4 o;
#pragma unroll
    for (int i = 0; i < 4; ++i) { const float val = v[i] + w0[col + i]; const float wv = -__logf(1.f + fexp(-val)) - 0.5f; o[i] = -fexp(wv); }
    store4bf(wbuf + (size_t)row * 384 + col, o);
  }
};
struct EpiA {
  bf16_t* __restrict__ abuf; bf16_t* __restrict__ kbuf; const bf16_t* __restrict__ kraw; const float* __restrict__ a0; const float* __restrict__ ka;
  DI void operator()(int row, int col, f32x4 v) const {
    f32x4 kr = load4bf(kraw + (size_t)row * 384 + col), a, kn;
#pragma unroll
    for (int i = 0; i < 4; ++i) { a[i] = sigm(v[i] + a0[col + i]); kn[i] = kr[i] * (1.f + (a[i] - 1.f) * ka[col + i]); }
    store4bf(abuf + (size_t)row * 384 + col, a);
    store4bf(kbuf + (size_t)row * 384 + col, kn);
  }
};
struct EpiV {
  bf16_t* vbuf; const bf16_t* pB; const float* v0; const float* mu;
  DI void operator()(int row, int col, f32x4 v) const {
    const int s = row & 2047;
    const bf16_t* pc = pB + (size_t)row * LDPB + 416 + 768 + col;
    f32x4 p = load4bf(pc), pr = load4bf(s > 0 ? pc - LDPB : pc);
    if (s == 0) pr = (f32x4){0.f, 0.f, 0.f, 0.f};
    f32x4 vf = load4bf(vbuf + (size_t)row * 384 + col), o;
#pragma unroll
    for (int i = 0; i < 4; ++i) { const float xv = p[i] + (pr[i] - p[i]) * mu[768 + col + i]; const float sg = sigm(v[i] + v0[col + i]); o[i] = xv + (vf[i] - xv) * sg; }
    store4bf(vbuf + (size_t)row * 384 + col, o);
  }
};
struct EpiOut {
  const float* xin; float* xout;
  DI void operator()(int row, int col, f32x4 v) const {
    const f32x4 x = *(const f32x4*)(xin + (size_t)row * 1024 + col);
    *(f32x4*)(xout + (size_t)row * 1024 + col) = x + v;
  }
};

DI void convT(const float* __restrict__ src, int K, int N, bf16_t* dst, int Kpad, int NR, const float* scale, int gt, int ngt) {
  const int kcN = Kpad >> 3, total = NR * kcN;
  for (int idx = gt; idx < total; idx += ngt) {
    const int n = idx % NR, kc = idx / NR; uint4 o = {0u, 0u, 0u, 0u};
    if (n < N) {
      float v[8];
#pragma unroll
      for (int j = 0; j < 8; ++j) { const int k = kc * 8 + j; v[j] = (k < K) ? src[(size_t)k * N + n] * (scale ? scale[k] : 1.f) : 0.f; }
      o.x = pk2(v[0], v[1]); o.y = pk2(v[2], v[3]); o.z = pk2(v[4], v[5]); o.w = pk2(v[6], v[7]);
    }
    *(uint4*)(dst + (size_t)n * Kpad + kc * 8) = o;
  }
}
DI void norm_rows_bf16(const float* x, const float* gain, bf16_t* hb, int rbeg, int rend, int gw, int ngw, int lane) {
  for (int row = rbeg + gw; row < rend; row += ngw) {
    const f32x4* xr = (const f32x4*)(x + (size_t)row * 1024) + lane;
    f32x4 v[4]; float s = 0.f;
#pragma unroll
    for (int j = 0; j < 4; ++j) { v[j] = xr[64 * j]; s += v[j][0] * v[j][0] + v[j][1] * v[j][1] + v[j][2] * v[j][2] + v[j][3] * v[j][3]; }
    const float rstd = 1.f / sqrtf(wave_sum(s) * (1.f / 1024.f) + 1e-6f);
#pragma unroll
    for (int j = 0; j < 4; ++j) { const f32x4 gg = *((const f32x4*)gain + lane + 64 * j); store4bf(hb + (size_t)row * 1024 + 4 * lane + 256 * j, v[j] * rstd * gg); }
  }
}

DI void p2_unit(unsigned char* lds, const KP& p, int l, int rt, int parts = 15, bool dummy = false) {
  unsigned char* ws = p.ws;
  const int tid = otid(), lane = tid & 63, w = tid >> 6, row0 = rt * 64;
  bf16_t* pB = (bf16_t*)(ws + OFF_R2);
  bf16_t* Qm = (bf16_t*)(ws + OFF_R1); bf16_t* Km = Qm + (size_t)T * 576;
  bf16_t* VtM = (bf16_t*)(ws + OFF_VTM);
  bf16_t* rbuf = (bf16_t*)(ws + OFF_SC); bf16_t* kbuf = rbuf + (size_t)T * 384; bf16_t* vbuf = kbuf + (size_t)T * 384;
  bf16_t* wbuf = vbuf + (size_t)T * 384; bf16_t* kkbuf = wbuf + (size_t)T * 384; bf16_t* abuf = kkbuf + (size_t)T * 384;
  bf16_t* LA = (bf16_t*)(ws + OFF_LA);
  const float* tab = (const float*)(ws + OFF_TAB);
  float* sRq = (float*)(lds + 73728); float* sRkv = sRq + 64;
  __syncthreads();
  if (parts & 1) {
    const int r = tid >> 2, part = tid & 3; const bf16_t* pr = pB + (size_t)(row0 + r) * LDPB;
    float sq = 0.f, sk = 0.f;
#pragma unroll
    for (int j = 0; j < 16; ++j) { f32x4 v = load4bf(pr + part * 64 + j * 4); sq += v[0] * v[0] + v[1] * v[1] + v[2] * v[2] + v[3] * v[3]; }
#pragma unroll
    for (int j = 0; j < 8; ++j) { f32x4 v = load4bf(pr + 256 + part * 32 + j * 4); sk += v[0] * v[0] + v[1] * v[1] + v[2] * v[2] + v[3] * v[3]; }
    sq += dppmov<0xB1>(sq); sq += dppmov<0x4E>(sq); sk += dppmov<0xB1>(sk); sk += dppmov<0x4E>(sk);
    if (part == 0) { sRq[r] = 1.f / sqrtf(sq * (1.f / 256.f) + 1e-6f); sRkv[r] = 1.f / sqrtf(sk * (1.f / 128.f) + 1e-6f); }
  }
  if (dummy) { rbuf = (bf16_t*)p.out; wbuf = rbuf + (size_t)T * 384; kkbuf = wbuf + (size_t)T * 384; vbuf = kkbuf + (size_t)T * 384; }
  if (parts & 2) {
    const float* mu = p.in[12] + l * 1280; const float* kkw = p.in[20] + l * 384;
    float mur[6], muk[6], muv_[6], kkw_[6];
#pragma unroll
    for (int h = 0; h < 6; ++h) { mur[h] = mu[h * 64 + lane]; muk[h] = mu[384 + h * 64 + lane]; muv_[h] = mu[768 + h * 64 + lane]; kkw_[h] = kkw[h * 64 + lane]; }
    for (int t = w; t < 64; t += 4) {
      const int row = row0 + t, s = row & 2047;
      const bf16_t* pc = pB + (size_t)row * LDPB + 416 + lane;
      const bf16_t* pp = (s > 0) ? pc - LDPB : pc;
      const float pm = (s > 0) ? 1.f : 0.f;
      float cr[6], ck[6], cv[6], qr[6], qk[6], qv[6];
#pragma unroll
      for (int h = 0; h < 6; ++h) { cr[h] = bf2f(pc[h * 64]); ck[h] = bf2f(pc[384 + h * 64]); cv[h] = bf2f(pc[768 + h * 64]); qr[h] = bf2f(pp[h * 64]) * pm; qk[h] = bf2f(pp[384 + h * 64]) * pm; qv[h] = bf2f(pp[768 + h * 64]) * pm; }
#pragma unroll
      for (int h = 0; h < 6; ++h) {
        const float xr = cr[h] + (qr[h] - cr[h]) * mur[h], xk = ck[h] + (qk[h] - ck[h]) * muk[h], xv = cv[h] + (qv[h] - cv[h]) * muv_[h];
        const float kv_ = xk * kkw_[h]; const float ss = wave_sum(kv_ * kv_);
        const float kk = kv_ / fmaxf(sqrtf(ss), 1e-12f);
        const size_t o = (size_t)row * 384 + h * 64 + lane;
        rbuf[o] = (bf16_t)f2bf(xr); wbuf[o] = (bf16_t)f2bf(xk); kkbuf[o] = (bf16_t)f2bf(kk);
        if (l == 0) vbuf[o] = (bf16_t)f2bf(xv);
      }
    }
  }
  if (parts & 4) {
    const float* mu = p.in[12] + l * 1280;
    const float* muv = p.in[13];
    f32x4 cur[12], prv[12];
#pragma unroll
    for (int i = 0; i < 12; ++i) {
      const int item = tid + 256 * i, r = item / 48, q = item - r * 48, row = row0 + r, s = row & 2047;
      const int qc = q < 40 ? q : 39;
      const bf16_t* pc = pB + (size_t)row * LDPB + 416 + 1152 + 4 * qc;
      cur[i] = load4bf(pc); prv[i] = load4bf(s > 0 ? pc - LDPB : pc);
    }
#pragma unroll
    for (int i = 0; i < 12; ++i) {
      const int item = tid + 256 * i, r = item / 48, q = item - r * 48, row = row0 + r, s = row & 2047;
      f32x4 o;
#pragma unroll
      for (int e = 0; e < 4; ++e) {
        const int j = 4 * q + e;
        const bool act = (j < 128) || (j < 160 && l > 0);
        const float m = (j < 128) ? mu[1152 + j] : muv[(j < 160 ? j : 159) - 128];
        const float pv = (s > 0) ? prv[i][e] : 0.f;
        float val = cur[i][e] + (pv - cur[i][e]) * m;
        if (j < 64) val = 1.f - 2.f / (fexp(2.f * val) + 1.f);
        o[e] = act ? val : 0.f;
      }
      store4bf(LA + (size_t)row * 192 + 4 * q, o);
    }
  }
  __syncthreads();
  if (parts & 1) {
    const bf16_t* WuqT = (const bf16_t*)(ws + OFF_WUQ + l * SZ_WUQ);
    const bf16_t* WukvT = (const bf16_t*)(ws + OFF_WUKV + l * SZ_WUKV);
    EpiQ eq{Qm, sRq, row0};
    for (int ct = 0; ct < 5; ++ct) gemm_tile<2>(lds, pB, LDPB, WuqT, 256, 256, row0, ct * 128, eq);
    EpiKV ek{Km, VtM, sRkv, row0};
    for (int ct = 0; ct < 6; ++ct) gemm_tile<2>(lds, pB + 256, LDPB, WukvT, 128, 128, row0, ct * 128, ek);
  }
  if (parts & 8) {
    const bf16_t* w2T = (const bf16_t*)(ws + OFF_W2 + l * SZ_L);
    const bf16_t* a2T = (const bf16_t*)(ws + OFF_A2 + l * SZ_L);
    const bf16_t* v2T = (const bf16_t*)(ws + OFF_V2);
    EpiA ea{dummy ? kkbuf : abuf, dummy ? vbuf : kbuf, wbuf, p.in[16] + l * 384, p.in[21] + l * 384};
    for (int ct = 0; ct < 3; ++ct) gemm_tile<2>(lds, LA + 64, 192, a2T, 64, 64, row0, ct * 128, ea);
    __syncthreads();
    EpiW ew{wbuf, p.in[14] + l * 384};
    for (int ct = 0; ct < 3; ++ct) gemm_tile<2>(lds, LA, 192, w2T, 64, 64, row0, ct * 128, ew);
    if (l > 0) {
      EpiV ev{vbuf, pB, p.in[18], p.in[12] + l * 1280};
      for (int ct = 0; ct < 3; ++ct) gemm_tile<2>(lds, LA + 128, 192, v2T, 64, 64, row0, ct * 128, ev);
    }
  }
  __syncthreads();
  if (parts & 1) {
    for (int idx = tid; idx < 64 * 16; idx += NTH) {
      const int r = idx >> 4, i = idx & 15, row = row0 + r, s = row & 2047;
      const float c = tab[s * 32 + i], sn = tab[s * 32 + 16 + i];
      bf16_t* q = Qm + (size_t)row * 576 + 64;
#pragma unroll
      for (int h = 0; h < 6; ++h) { const float t1 = bf2f(q[h * 96 + i]), t2 = bf2f(q[h * 96 + 16 + i]); q[h * 96 + i] = (bf16_t)f2bf(t1 * c - t2 * sn); q[h * 96 + 16 + i] = (bf16_t)f2bf(t1 * sn + t2 * c); }
      const float k1 = bf2f(pB[(size_t)row * LDPB + 384 + i]), k2 = bf2f(pB[(size_t)row * LDPB + 400 + i]);
      const bf16_t o1 = (bf16_t)f2bf(k1 * c - k2 * sn), o2 = (bf16_t)f2bf(k1 * sn + k2 * c);
      bf16_t* kq = Km + (size_t)row * 576 + 64;
#pragma unroll
      for (int h = 0; h < 6; ++h) { kq[h * 96 + i] = o1; kq[h * 96 + 16 + i] = o2; }
    }
  }
}

struct ScanOps { f32x4 w, k, a, b, r; f2v_t v, bk; };
DI void scan_unit(unsigned char* lds, const KP& p, int unit) {
  unsigned char* ws = p.ws;
  float* sm = (float*)lds;
  const int tid = otid(), lane = tid & 63, w16 = tid >> 6, rg = lane >> 4, cg_ = lane & 15;
  const int hid = unit >> 1, half = unit & 1, b = hid / 6, h = hid - b * 6;
  const bf16_t* rbuf = (const bf16_t*)(ws + OFF_SC); const bf16_t* kbuf = rbuf + (size_t)T * 384; const bf16_t* vbuf = kbuf + (size_t)T * 384;
  const bf16_t* wbuf = vbuf + (size_t)T * 384; const bf16_t* kkbuf = wbuf + (size_t)T * 384; const bf16_t* abuf = kkbuf + (size_t)T * 384;
  float* ybuf = (float*)(ws + OFF_R2);
  const int st = tid >> 4, sp = tid & 15;
  const size_t gbase = ((size_t)b * 2048) * 384 + h * 64 + sp * 4;
  uint2 qw, qk, qkk, qa, qr, qv;
#define SCAN_LOAD(t0) do { const size_t o_ = gbase + (size_t)((t0) + st) * 384; qw = *(const uint2*)(wbuf + o_); qk = *(const uint2*)(kbuf + o_); qkk = *(const uint2*)(kkbuf + o_); \
    qa = *(const uint2*)(abuf + o_); qr = *(const uint2*)(rbuf + o_); qv = *(const uint2*)(vbuf + o_); } while (0)
  f2v_t P0 = {0.f, 0.f}, P1 = {0.f, 0.f}, P2 = {0.f, 0.f}, P3 = {0.f, 0.f};
  SCAN_LOAD(0);
  const int rowoff = half * 32 + w16 * 8 + rg * 2;
  float* yout = ybuf + ((size_t)b * 2048) * 384 + h * 64 + rowoff;
  float* ypw = sm + 16 * 400 + w16 * (64 * 40);
  __builtin_amdgcn_s_setprio(3);
  for (int ch = 0; ch < 128; ++ch) {
    __syncthreads();
    {
      float* d = sm + st * 400 + sp * 4;
      const f32x4 fw = up4(qw), fk = up4(qk), fkk = up4(qkk), fa = up4(qa), fr = up4(qr), fv = up4(qv);
      f32x4 dec;
#pragma unroll
      for (int i = 0; i < 4; ++i) dec[i] = fexp(fw[i]);
      const f32x4 bp = fkk * fa;
      float be = bp[0] * fr[0] + bp[1] * fr[1] + bp[2] * fr[2] + bp[3] * fr[3];
      float ka = fk[0] * fr[0] + fk[1] * fr[1] + fk[2] * fr[2] + fk[3] * fr[3];
      be = rowsum16(be); ka = rowsum16(ka);
      *(f32x4*)(d) = dec; *(f32x4*)(d + 64) = fk; *(f32x4*)(d + 128) = -fkk; *(f32x4*)(d + 192) = bp; *(f32x4*)(d + 256) = dec * fr; *(f32x4*)(d + 320) = fv;
      if (sp == 0) { sm[st * 400 + 384] = be; sm[st * 400 + 385] = ka; }
    }
    __syncthreads();
    if (ch + 1 < 128) SCAN_LOAD((ch + 1) * 16);
#define SCAN_OPS(D, t_) do { const float* q_ = sm + (t_) * 400; D.w = *(const f32x4*)(q_ + 4 * cg_); D.k = *(const f32x4*)(q_ + 64 + 4 * cg_); D.a = *(const f32x4*)(q_ + 128 + 4 * cg_); \
      D.b = *(const f32x4*)(q_ + 192 + 4 * cg_); D.r = *(const f32x4*)(q_ + 256 + 4 * cg_); D.v = *(const f2v_t*)(q_ + 320 + rowoff); D.bk = *(const f2v_t*)(q_ + 384); } while (0)
    ScanOps cur, nxt;
    SCAN_OPS(cur, 0); nxt = cur;
#pragma unroll
    for (int t = 0; t < 16; ++t) {
      if (t < 15) SCAN_OPS(nxt, t + 1);
      asm volatile("" ::: "memory");
      const f32x4 w4 = cur.w, k4 = cur.k, a4 = cur.a, b4 = cur.b, r4 = cur.r; const f2v_t v2 = cur.v, bk = cur.bk;
      const f2v_t sa = (P0 * a4[0] + P1 * a4[1]) + (P2 * a4[2] + P3 * a4[3]);
      const f2v_t yd = (P0 * r4[0] + P1 * r4[1]) + (P2 * r4[2] + P3 * r4[3]);
      const f2v_t pre0 = P0 * w4[0] + v2 * k4[0], pre1 = P1 * w4[1] + v2 * k4[1], pre2 = P2 * w4[2] + v2 * k4[2], pre3 = P3 * w4[3] + v2 * k4[3];
      float sa0 = sa[0], sa1 = sa[1];
#define DPPADD2(x_, y_, CTL) asm("s_nop 1\n\tv_add_f32_dpp %0, %0, %0 " CTL " row_mask:0xf bank_mask:0xf bound_ctrl:1\n\tv_add_f32_dpp %1, %1, %1 " CTL " row_mask:0xf bank_mask:0xf bound_ctrl:1" : "+v"(x_), "+v"(y_))
      DPPADD2(sa0, sa1, "quad_perm:[1,0,3,2]"); DPPADD2(sa0, sa1, "quad_perm:[2,3,0,1]"); DPPADD2(sa0, sa1, "row_half_mirror"); DPPADD2(sa0, sa1, "row_mirror");
      const f2v_t sa2 = {sa0, sa1};
      P0 = sa2 * b4[0] + pre0; P1 = sa2 * b4[1] + pre1; P2 = sa2 * b4[2] + pre2; P3 = sa2 * b4[3] + pre3;
#undef DPPADD2
      const f2v_t fin = sa2 * bk[0] + v2 * bk[1];
      const f2v_t yp = (cg_ == 0) ? (yd + fin) : yd;
      *(f2v_t*)(ypw + (t * 4 + rg) * 40 + cg_ * 2) = yp;
      cur = nxt;
    }
#undef SCAN_OPS
    {
      const float* yr = ypw + lane * 40;
      f32x4 a0 = *(const f32x4*)(yr), a1 = *(const f32x4*)(yr + 4), a2 = *(const f32x4*)(yr + 8), a3 = *(const f32x4*)(yr + 12);
      f32x4 a4_ = *(const f32x4*)(yr + 16), a5 = *(const f32x4*)(yr + 20), a6 = *(const f32x4*)(yr + 24), a7 = *(const f32x4*)(yr + 28);
      const f32x4 q = ((a0 + a1) + (a2 + a3)) + ((a4_ + a5) + (a6 + a7));
      const int tt = lane >> 2, rr = lane & 3;
      *(f2v_t*)(ybuf + ((size_t)b * 2048 + ch * 16 + tt) * 384 + h * 64 + half * 32 + w16 * 8 + rr * 2) = (f2v_t){q[0] + q[2], q[1] + q[3]};
    }
  }
  __builtin_amdgcn_s_setprio(0);
#undef SCAN_LOAD
}

template <bool DIFF>
DI void attn_unit(unsigned char* lds, const bf16_t* __restrict__ Qb, const bf16_t* __restrict__ Kb, int ld, const bf16_t* __restrict__ Vt,
                  const bf16_t* __restrict__ gate, bf16_t* mixed, const int* __restrict__ pos, int qb, int h, int rowb,
                  float lam_full, float lam_init, const float* __restrict__ gsub) {
  constexpr int KS = DIFF ? 1 : 3, NM = DIFF ? 2 : 1, KW = DIFF ? 80 : 112,
                NQT = DIFF ? 1 : 2, QU = 64 * NQT;
  bf16_t* sK = (bf16_t*)lds; bf16_t* sV = sK + 64 * KW;
  const int tid = otid(), lane = tid & 63, w = tid >> 6, lr = lane & 15, g = lane >> 4;
  const int q0 = qb * QU, qw0 = q0 + 16 * NQT * w;
  bf16x8 qf[NM][NQT][KS];
#pragma unroll
  for (int m = 0; m < NM; ++m)
#pragma unroll
    for (int qt = 0; qt < NQT; ++qt)
#pragma unroll
      for (int ks = 0; ks < KS; ++ks) qf[m][qt][ks] = *(const bf16x8*)(Qb + (size_t)(qw0 + 16 * qt + lr) * ld + m * 32 + ks * 32 + g * 8);
  f32x4 O[NM][4][NQT]; float mrun[NM][NQT], lrun[NM][NQT];
#pragma unroll
  for (int m = 0; m < NM; ++m)
#pragma unroll
    for (int qt = 0; qt < NQT; ++qt) { mrun[m][qt] = -INFINITY; lrun[m][qt] = 0.f;
#pragma unroll
      for (int dt = 0; dt < 4; ++dt) O[m][dt][qt] = (f32x4){0.f, 0.f, 0.f, 0.f}; }
  float posq[2] = {0.f, 0.f};
  if (DIFF) { posq[0] = (float)pos[qw0 + lr]; if (NQT > 1) posq[1] = (float)pos[qw0 + 16 + lr]; }
  const float sc = DIFF ? (0.17677669529663687f * 1.4426950408889634f) : (0.10206207261596575f * 1.4426950408889634f);
  const float slope2 = DIFF ? ex2(-2.f * (float)(h + 1)) * 1.4426950408889634f : 0.f;
  const int nkt = (q0 + QU) / 64;
  const int vr = tid >> 3, vc = tid & 7;
  int kr0, kc0, kr1, kc1, kr2 = 0, kc2 = 0;
  if (DIFF) { kr0 = vr; kc0 = vc; kr1 = vr + 32; kc1 = vc; }
  else { kr0 = tid / 12; kc0 = tid - kr0 * 12; kr1 = (tid + 256) / 12; kc1 = (tid + 256) - kr1 * 12; kr2 = (tid + 512) / 12; kc2 = (tid + 512) - kr2 * 12; }
  uint4 rk0, rk1, rk2 = {0u, 0u, 0u, 0u}, rv0, rv1;
#define ATT_LOAD(j_) do { rk0 = *(const uint4*)(Kb + (size_t)(64 * (j_) + kr0) * ld + kc0 * 8); rk1 = *(const uint4*)(Kb + (size_t)(64 * (j_) + kr1) * ld + kc1 * 8); \
    if (!DIFF) rk2 = *(const uint4*)(Kb + (size_t)(64 * (j_) + kr2) * ld + kc2 * 8); \
    rv0 = *(const uint4*)(Vt + (size_t)vr * 2048 + 64 * (j_) + vc * 8); rv1 = *(const uint4*)(Vt + (size_t)(vr + 32) * 2048 + 64 * (j_) + vc * 8); } while (0)
  ATT_LOAD(0);
  for (int j = 0; j < nkt; ++j) {
    __syncthreads();
    *(uint4*)(sK + kr0 * KW + kc0 * 8) = rk0; *(uint4*)(sK + kr1 * KW + kc1 * 8) = rk1; if (!DIFF) *(uint4*)(sK + kr2 * KW + kc2 * 8) = rk2;
    *(uint4*)(sV + vr * 72 + vc * 8) = rv0; *(uint4*)(sV + (vr + 32) * 72 + vc * 8) = rv1;
    __syncthreads();
    if (j + 1 < nkt) ATT_LOAD(j + 1);
    if (64 * j <= qw0 + 16 * NQT - 1) {
      const bool domask = (64 * j + 63 > qw0);
      int4 pk[4];
      if (DIFF) {
#pragma unroll
        for (int kt = 0; kt < 4; ++kt) pk[kt] = *(const int4*)(pos + 64 * j + 16 * kt + 4 * g);
      }
#pragma unroll
      for (int m = 0; m < NM; ++m) {
        f32x4 s[4][NQT];
#pragma unroll
        for (int kt = 0; kt < 4; ++kt) {
#pragma unroll
          for (int qt = 0; qt < NQT; ++qt) s[kt][qt] = (f32x4){0.f, 0.f, 0.f, 0.f};
#pragma unroll
          for (int ks = 0; ks < KS; ++ks) {
            const bf16x8 kf = *(const bf16x8*)(sK + (16 * kt + lr) * KW + m * 32 + ks * 32 + g * 8);
#pragma unroll
            for (int qt = 0; qt < NQT; ++qt) s[kt][qt] = MFMA16(kf, qf[m][qt][ks], s[kt][qt]);
          }
        }
#pragma unroll
        for (int kt = 0; kt < 4; ++kt)
#pragma unroll
          for (int qt = 0; qt < NQT; ++qt)
#pragma unroll
            for (int i = 0; i < 4; ++i) {
              float v = s[kt][qt][i] * sc;
              if (DIFF) { const int pki = (i == 0) ? pk[kt].x : (i == 1) ? pk[kt].y : (i == 2) ? pk[kt].z : pk[kt].w; v -= slope2 * fabsf(posq[qt] - (float)pki); }
              s[kt][qt][i] = v;
            }
        if (domask) {
#pragma unroll
          for (int kt = 0; kt < 4; ++kt)
#pragma unroll
            for (int qt = 0; qt < NQT; ++qt)
#pragma unroll
              for (int i = 0; i < 4; ++i) if (64 * j + 16 * kt + 4 * g + i > qw0 + 16 * qt + lr) s[kt][qt][i] = -INFINITY;
        }
#pragma unroll
        for (int qt = 0; qt < NQT; ++qt) {
          float mx = -INFINITY;
#pragma unroll
          for (int kt = 0; kt < 4; ++kt)
#pragma unroll
            for (int i = 0; i < 4; ++i) mx = fmaxf(mx, s[kt][qt][i]);
          mx = xmax32(xmax16(mx));
          const float mn = fmaxf(mrun[m][qt], mx), alpha = ex2(mrun[m][qt] - mn); mrun[m][qt] = mn;
          float ls = 0.f;
#pragma unroll
          for (int kt = 0; kt < 4; ++kt)
#pragma unroll
            for (int i = 0; i < 4; ++i) { const float pv = ex2(s[kt][qt][i] - mn); ls += pv; s[kt][qt][i] = pv; }
          lrun[m][qt] = lrun[m][qt] * alpha + ls;
#pragma unroll
          for (int dt = 0; dt < 4; ++dt) O[m][dt][qt] = O[m][dt][qt] * alpha;
        }
#pragma unroll
        for (int s2 = 0; s2 < 2; ++s2) {
          bf16x8 pf[NQT];
#pragma unroll
          for (int qt = 0; qt < NQT; ++qt) {
            uint4 u; u.x = pk2(s[2 * s2][qt][0], s[2 * s2][qt][1]); u.y = pk2(s[2 * s2][qt][2], s[2 * s2][qt][3]);
            u.z = pk2(s[2 * s2 + 1][qt][0], s[2 * s2 + 1][qt][1]); u.w = pk2(s[2 * s2 + 1][qt][2], s[2 * s2 + 1][qt][3]);
            pf[qt] = __builtin_bit_cast(bf16x8, u);
          }
#pragma unroll
          for (int dt = 0; dt < 4; ++dt) {
            const uint2 lo = *(const uint2*)(sV + (16 * dt + lr) * 72 + 32 * s2 + 4 * g), hi = *(const uint2*)(sV + (16 * dt + lr) * 72 + 32 * s2 + 16 + 4 * g);
            uint4 u; u.x = lo.x; u.y = lo.y; u.z = hi.x; u.w = hi.y;
            const bf16x8 vf = __builtin_bit_cast(bf16x8, u);
#pragma unroll
            for (int qt = 0; qt < NQT; ++qt) O[m][dt][qt] = MFMA16(vf, pf[qt], O[m][dt][qt]);
          }
        }
      }
    }
  }
#undef ATT_LOAD
#pragma unroll
  for (int qt = 0; qt < NQT; ++qt) {
    const size_t row = (size_t)rowb + qw0 + 16 * qt + lr;
    float inv[NM];
#pragma unroll
    for (int m = 0; m < NM; ++m) { const float lt = xsum32(xsum16(lrun[m][qt])); inv[m] = 1.f / lt; }
    if (!DIFF) {
#pragma unroll
      for (int dt = 0; dt < 4; ++dt) {
        const int col = h * 64 + 16 * dt + 4 * g;
        const f32x4 gt = load4bf(gate + row * LDPA + 512 + col); f32x4 o = O[0][dt][qt] * inv[0];
#pragma unroll
        for (int i = 0; i < 4; ++i) o[i] *= silu(gt[i]);
        store4bf(mixed + row * 1024 + col, o);
      }
    } else {
      f32x4 o[4]; float ss = 0.f;
#pragma unroll
      for (int dt = 0; dt < 4; ++dt) { o[dt] = O[0][dt][qt] * inv[0] - O[NM - 1][dt][qt] * (lam_full * inv[NM - 1]); ss += o[dt][0] * o[dt][0] + o[dt][1] * o[dt][1] + o[dt][2] * o[dt][2] + o[dt][3] * o[dt][3]; }
      ss = xsum32(xsum16(ss));
      const float rs = (1.f / sqrtf(ss * (1.f / 64.f) + 1e-5f)) * (1.f - lam_init);
#pragma unroll
      for (int dt = 0; dt < 4; ++dt) {
        const int dvc = 16 * dt + 4 * g, col = h * 64 + dvc;
        const f32x4 gs = *(const f32x4*)(gsub + dvc); const f32x4 gt = load4bf(gate + row * LDPA + 512 + 384 + col);
        f32x4 r;
#pragma unroll
        for (int i = 0; i < 4; ++i) r[i] = o[dt][i] * rs * gs[i] * silu(gt[i]);
        store4bf(mixed + row * 1024 + 384 + col, r);
      }
    }
  }
}

DI void p4_unit(unsigned char* lds, const KP& p, int l, int rt) {
  unsigned char* ws = p.ws;
  const int tid = otid(), lane = tid & 63, w = tid >> 6, row0 = rt * 64;
  const bf16_t* rbuf = (const bf16_t*)(ws + OFF_SC); const bf16_t* kbuf = rbuf + (size_t)T * 384; const bf16_t* vbuf = kbuf + (size_t)T * 384;
  const float* ybuf = (const float*)(ws + OFF_R2); bf16_t* mixed = (bf16_t*)(ws + OFF_MIX);
  const bf16_t* pA = (const bf16_t*)(ws + OFF_PA);
  const float* lnw = p.in[23] + l * 384; const float* lnb = p.in[24] + l * 384; const float* rk = p.in[22] + l * 384;
  {
    float lw[6], lb[6], rkk[6];
#pragma unroll
    for (int h = 0; h < 6; ++h) { lw[h] = lnw[h * 64 + lane]; lb[h] = lnb[h * 64 + lane]; rkk[h] = rk[h * 64 + lane]; }
    for (int t = w; t < 64; t += 4) {
      const int row = row0 + t; const size_t o = (size_t)row * 384 + lane;
      float y[6], r[6], k[6], v[6], gt[6];
#pragma unroll
      for (int h = 0; h < 6; ++h) { y[h] = ybuf[o + h * 64]; r[h] = bf2f(rbuf[o + h * 64]); k[h] = bf2f(kbuf[o + h * 64]); v[h] = bf2f(vbuf[o + h * 64]); gt[h] = bf2f(pA[(size_t)row * LDPA + 512 + 640 + h * 64 + lane]); }
#pragma unroll
      for (int h = 0; h < 6; ++h) {
        const float mean = wave_sum(y[h]) * (1.f / 64.f); const float d = y[h] - mean; const float var = wave_sum(d * d) * (1.f / 64.f);
        const float dot = wave_sum(r[h] * k[h] * rkk[h]);
        float outv = d * (1.f / sqrtf(var + 64e-5f)) * lw[h] + lb[h] + dot * v[h];
        if ((row & 2047) == 0) outv = ((const float*)(ws + OFF_T0))[((size_t)l * 16 + (row >> 11)) * 384 + h * 64 + lane];
        mixed[(size_t)row * 1024 + 640 + h * 64 + lane] = (bf16_t)f2bf(outv * silu(gt[h]));
      }
    }
  }
  __syncthreads();
  const bf16_t* WoT = (const bf16_t*)(ws + OFF_WO + l * SZ_WO);
  EpiOut eo{l == 0 ? p.in[0] : p.out, p.out};
  for (int ct = 0; ct < 8; ++ct) gemm_tile<2>(lds, mixed, 1024, WoT, 1024, 1024, row0, ct * 128, eo);
  __syncthreads();
  if (l == 0) norm_rows_bf16(p.out, p.in[2] + 1024, (bf16_t*)(ws + OFF_R1), row0, row0 + 64, w, 4, lane);
  else {
    const float* fg = p.in[25];
    for (int row = row0 + w; row < row0 + 64; row += 4) {
      f32x4* xr = (f32x4*)(p.out + (size_t)row * 1024) + lane;
      f32x4 v[4]; float s = 0.f;
#pragma unroll
      for (int j = 0; j < 4; ++j) { v[j] = xr[64 * j]; s += v[j][0] * v[j][0] + v[j][1] * v[j][1] + v[j][2] * v[j][2] + v[j][3] * v[j][3]; }
      const float rstd = 1.f / sqrtf(wave_sum(s) * (1.f / 1024.f) + 1e-6f);
#pragma unroll
      for (int j = 0; j < 4; ++j) { const f32x4 gg = *((const f32x4*)fg + lane + 64 * j); xr[64 * j] = v[j] * rstd * gg; }
    }
  }
}

DI void t0_unit(unsigned char* lds, const KP& p, int l, int b) {
  unsigned char* ws = p.ws;
  float* hv_ = (float*)lds;
  float* pv = hv_ + 1024;
  float* red = pv + 1280;
  float* kp = red + 8;
  float* vv = kp + 384;
  const int tid = otid(), lane = tid & 63, w = tid >> 6;
  const size_t row = (size_t)b * 2048;
  const float* xr = (l == 0 ? p.in[0] : (const float*)p.out) + row * 1024;
  const float* g = p.in[2] + l * 1024;
  __syncthreads();
  float ss = 0.f;
  for (int k = tid; k < 1024; k += NTH) { const float x = xr[k]; ss += x * x; }
  ss = wave_sum(ss);
  if (lane == 0) red[w] = ss;
  __syncthreads();
  const float rstd = 1.f / sqrtf((red[0] + red[1] + red[2] + red[3]) * (1.f / 1024.f) + 1e-6f);
  for (int k = tid; k < 1024; k += NTH) hv_[k] = xr[k] * rstd * g[k];
  __syncthreads();
  const float* W = p.in[3] + (size_t)l * 1024 * 3488 + 2208;
  const float* Wv = p.in[4];
  const float* mu = p.in[12] + l * 1280; const float* muv = p.in[13];
  const int ncol = l ? 1248 : 1216;
  for (int c0 = tid; c0 < ncol; c0 += NTH) {
    const float* wp; int ldw; float m;
    if (c0 < 1152) { wp = W + c0; ldw = 3488; m = mu[c0]; }
    else if (c0 < 1216) { wp = W + 1216 + (c0 - 1152); ldw = 3488; m = mu[1216 + (c0 - 1152)]; }
    else { wp = Wv + (c0 - 1216); ldw = 32; m = muv[c0 - 1216]; }
    float a0_ = 0.f, a1_ = 0.f, a2_ = 0.f, a3_ = 0.f;
    for (int k = 0; k < 1024; k += 16) {
      float wv[16];
#pragma unroll
      for (int u = 0; u < 16; ++u) wv[u] = wp[(size_t)(k + u) * ldw];
#pragma unroll
      for (int u = 0; u < 16; u += 4) { a0_ += hv_[k + u] * wv[u]; a1_ += hv_[k + u + 1] * wv[u + 1]; a2_ += hv_[k + u + 2] * wv[u + 2]; a3_ += hv_[k + u + 3] * wv[u + 3]; }
    }
    pv[c0] = ((a0_ + a1_) + (a2_ + a3_)) * (1.f - m);
  }
  __syncthreads();
  const float* a2w = p.in[17] + (size_t)l * 64 * 384; const float* a0w = p.in[16] + l * 384; const float* kaw = p.in[21] + l * 384;
  const float* v2w = p.in[19]; const float* v0w = p.in[18];
  for (int j = tid; j < 384; j += NTH) {
    float acc = a0w[j];
    for (int i = 0; i < 64; ++i) acc += pv[1152 + i] * a2w[i * 384 + j];
    const float a = sigm(acc);
    kp[j] = pv[384 + j] * (1.f + (a - 1.f) * kaw[j]);
    float v = pv[768 + j];
    if (l > 0) {
      float av = v0w[j];
      for (int i = 0; i < 32; ++i) av += pv[1216 + i] * v2w[i * 384 + j];
      vv[j] = av;
    } else vv[j] = 0.f;
    pv[768 + j] = v;
  }
  __syncthreads();
  float* t0 = (float*)(ws + OFF_T0) + ((size_t)l * 16 + b) * 384;
  if (l > 0) {
    const float* vfirst = (const float*)(ws + OFF_T0) + 2 * 16 * 384 + (size_t)b * 384;
    for (int j = tid; j < 384; j += NTH) { const float xv = pv[768 + j]; pv[768 + j] = xv + (vfirst[j] - xv) * sigm(vv[j]); }
  } else {
    float* vfirst = (float*)(ws + OFF_T0) + 2 * 16 * 384 + (size_t)b * 384;
    for (int j = tid; j < 384; j += NTH) vfirst[j] = pv[768 + j];
  }
  __syncthreads();
  const float* lnw = p.in[23] + l * 384; const float* lnb = p.in[24] + l * 384; const float* rk = p.in[22] + l * 384;
  for (int h = w; h < 6; h += 4) {
    const int j = h * 64 + lane;
    const float r = pv[j], k = kp[j], v = pv[768 + j];
    const float c = wave_sum(k * r), dot = wave_sum(r * k * rk[j]);
    const float y = v * c;
    const float mean = wave_sum(y) * (1.f / 64.f); const float d = y - mean; const float var = wave_sum(d * d) * (1.f / 64.f);
    t0[j] = d * (1.f / sqrtf(var + 64e-5f)) * lnw[j] + lnb[j] + dot * v;
  }
}

DI void p3_run(unsigned char* lds, int* s_unit, const KP& p, int l, int cslot, bool do_scan, bool do_att) {
  unsigned char* ws = p.ws;
  const int tid = otid();
  unsigned* ctrS = (unsigned*)(ws + OFF_CTL) + 16 * (2 * cslot + 1);
  unsigned* ctrA = (unsigned*)(ws + OFF_CTL) + 16 * (2 * cslot + 2);
  unsigned* cucnt = (unsigned*)(ws + OFF_CU) + 4096 * cslot;
  const bf16_t* pA = (const bf16_t*)(ws + OFF_PA);
  const bf16_t* Qm = (const bf16_t*)(ws + OFF_R1); const bf16_t* Km = Qm + (size_t)T * 576;
  bf16_t* mixed = (bf16_t*)(ws + OFF_MIX);
  const int* pos = (const int*)p.in[1];
  const float* lam = p.in[10] + l * 128;
  float d0 = 0.f, d1 = 0.f;
  for (int i = 0; i < 32; ++i) { d0 += lam[i] * lam[32 + i]; d1 += lam[64 + i] * lam[96 + i]; }
  const float lam_init = 0.8f - 0.6f * expf(-0.3f * (float)(l + 1));
  const float lam_full = expf(d0) - expf(d1) + lam_init;
  bool prefer_scan = false, sdone = !do_scan, t0done = false;
  if (tid == 0) {
    const unsigned xcc = (unsigned)__builtin_amdgcn_s_getreg((3 << 11) | 20) & 0xFu;
    const unsigned cu = (unsigned)__builtin_amdgcn_s_getreg((7 << 11) | (8 << 6) | 4) & 0xFFu;
    prefer_scan = (atomicAdd(cucnt + ((xcc << 8) | cu), 1u) == 0u);
  }
  for (;;) {
    __syncthreads();
    if (tid == 0) {
      int code = -1;
      if (do_scan && !t0done) { const unsigned u = atomicAdd(ctrS + 8, 1u); if (u < 16u) code = NSCAN + NATT + (int)u; else t0done = true; }
      if (code < 0 && prefer_scan && !sdone) { const unsigned u = atomicAdd(ctrS, 1u); if (u < (unsigned)NSCAN) code = (int)u; else sdone = true; }
      if (code < 0 && do_att) { const unsigned u = atomicAdd(ctrA, 1u); if (u < (unsigned)NATT) code = NSCAN + (int)u; }
      if (code < 0 && !sdone) { const unsigned u = atomicAdd(ctrS, 1u); if (u < (unsigned)NSCAN) code = (int)u; else sdone = true; }
      *s_unit = code;
    }
    __syncthreads();
    const int u = *s_unit;
    if (u < 0) break;
    if (u >= NSCAN + NATT) t0_unit(lds, p, l, u - NSCAN - NATT);
    else if (u < NSCAN) scan_unit(lds, p, u);
    else if (u < NSCAN + NMLA) {
      const int v = u - NSCAN, qb = 15 - v / 96, bh = v % 96, b = bh / 6, h = bh - b * 6;
      attn_unit<false>(lds, Qm + (size_t)b * 2048 * 576 + h * 96, Km + (size_t)b * 2048 * 576 + h * 96, 576, (const bf16_t*)(ws + OFF_VTM) + (size_t)bh * 64 * 2048,
                       pA, mixed, pos, qb, h, b * 2048, 0.f, 0.f, nullptr);
    } else {
      const int v = u - NSCAN - NMLA, qb = 31 - v / 64, bh = v % 64, b = bh >> 2, h = bh & 3;
      attn_unit<true>(lds, pA + (size_t)b * 2048 * LDPA + h * 64, pA + (size_t)b * 2048 * LDPA + 256 + h * 64, LDPA, (const bf16_t*)(ws + OFF_VTD) + (size_t)bh * 64 * 2048,
                      pA, mixed, pos, qb, h, b * 2048, lam_full, lam_init, p.in[11] + l * 64);
    }
  }
}

DI void gbar(unsigned* bw, unsigned nblk) {
  asm volatile("s_waitcnt vmcnt(0)" ::: "memory");
  __syncthreads();
  if (threadIdx.x == 0) {
    __builtin_amdgcn_fence(__ATOMIC_RELEASE, "agent");
    asm volatile("s_waitcnt vmcnt(0)" ::: "memory");
    const unsigned g = __hip_atomic_load(bw + 64, __ATOMIC_RELAXED, __HIP_MEMORY_SCOPE_AGENT);
    const unsigned prev = __hip_atomic_fetch_add(bw, 1u, __ATOMIC_RELAXED, __HIP_MEMORY_SCOPE_AGENT);
    if (prev == nblk - 1u) {
      __hip_atomic_store(bw, 0u, __ATOMIC_RELAXED, __HIP_MEMORY_SCOPE_AGENT);
      __builtin_amdgcn_fence(__ATOMIC_RELEASE, "agent");
      __hip_atomic_fetch_add(bw + 64, 1u, __ATOMIC_RELAXED, __HIP_MEMORY_SCOPE_AGENT);
    } else {
      while (__hip_atomic_load(bw + 64, __ATOMIC_RELAXED, __HIP_MEMORY_SCOPE_AGENT) == g) __builtin_amdgcn_s_sleep(1);
    }
    __builtin_amdgcn_fence(__ATOMIC_ACQUIRE, "agent");
    asm volatile("s_waitcnt vmcnt(0)" ::: "memory");
  }
  __syncthreads();
}

__global__ void __launch_bounds__(NTH, 2) mk_fwd(KP p) {
  extern __shared__ __attribute__((aligned(16))) unsigned char lds[];
  int& s_unit = *(int*)(lds + 73728 + 1024);
  cg::grid_group grid = cg::this_grid();
  unsigned char* ws = p.ws;
  const int tid = otid(), lane = tid & 63, w = tid >> 6;
  const int G = gridDim.x, bid = blockIdx.x;
#define RUN(k) (p.ph_lo <= (k) && (k) < p.ph_hi)
#define SEAM(k) do { if (RUN(k) && RUN((k) + 1)) gbar((unsigned*)(ws + OFF_CTL) + 512, (unsigned)G); } while (0)
  if (p.ph_lo < 0) grid.sync();

  if (RUN(0)) {
    const int gt = bid * NTH + tid, ngt = G * NTH;
    for (int i = gt; i < 3 * 4096; i += ngt) ((unsigned*)(ws + OFF_CU))[i] = 0u;
    for (int l = 0; l < 2; ++l) {
      bf16_t* Wc = (bf16_t*)(ws + OFF_WC + l * SZ_WC);
      if (l == 0) convT(p.in[3], 1024, 3488, Wc, 1024, NP, nullptr, gt, ngt);
      else { convT(p.in[3] + (size_t)1024 * 3488, 1024, 3488, Wc, 1024, 3488, nullptr, gt, ngt); convT(p.in[4], 1024, 32, Wc + (size_t)3488 * 1024, 1024, 96, nullptr, gt, ngt); }
      convT(p.in[5] + (size_t)l * 1024 * 1024, 1024, 1024, (bf16_t*)(ws + OFF_WO + l * SZ_WO), 1024, 1024, nullptr, gt, ngt);
      convT(p.in[8] + (size_t)l * 256 * 576, 256, 576, (bf16_t*)(ws + OFF_WUQ + l * SZ_WUQ), 256, 640, p.in[6] + l * 256, gt, ngt);
      convT(p.in[9] + (size_t)l * 128 * 768, 128, 768, (bf16_t*)(ws + OFF_WUKV + l * SZ_WUKV), 128, 768, p.in[7] + l * 128, gt, ngt);
      convT(p.in[15] + (size_t)l * 64 * 384, 64, 384, (bf16_t*)(ws + OFF_W2 + l * SZ_L), 64, 384, nullptr, gt, ngt);
      convT(p.in[17] + (size_t)l * 64 * 384, 64, 384, (bf16_t*)(ws + OFF_A2 + l * SZ_L), 64, 384, nullptr, gt, ngt);
    }
    convT(p.in[19], 32, 384, (bf16_t*)(ws + OFF_V2), 64, 384, nullptr, gt, ngt);
    {
      float* tab = (float*)(ws + OFF_TAB); const int* pos = (const int*)p.in[1];
      for (int idx = gt; idx < 2048 * 16; idx += ngt) {
        const int s = idx >> 4, i = idx & 15;
        const float inv = exp2f(-(float)i * (13.287712379549449f / 16.f));
        const float ang = (float)pos[s] * inv;
        double rev = (double)ang * 0.15915494309189535; rev -= __builtin_rint(rev);
        tab[s * 32 + i] = __builtin_amdgcn_cosf((float)rev); tab[s * 32 + 16 + i] = __builtin_amdgcn_sinf((float)rev);
      }
    }
    norm_rows_bf16(p.in[0], p.in[2], (bf16_t*)(ws + OFF_R1), 0, T, bid * 4 + w, G * 4, lane);
  }
  SEAM(0);
#if PROBE == 8
  for (int i = 0; i < 10; ++i) grid.sync();
#endif
#if PROBE == 6
  if (RUN(0)) { norm_rows_bf16(p.in[0], p.in[2], (bf16_t*)(ws + OFF_R1), 0, T, bid * 4 + w, G * 4, lane); grid.sync(); }
#endif
  for (int l = 0; l < 2; ++l) {
    const int pb = 1 + 4 * l;
    if (RUN(pb)) {
      EpiRoute e{(bf16_t*)(ws + OFF_PA), (bf16_t*)(ws + OFF_R2), (bf16_t*)(ws + OFF_VTD), l ? 3520 : 3488};
      const bf16_t* hb = (const bf16_t*)(ws + OFF_R1); const bf16_t* Wc = (const bf16_t*)(ws + OFF_WC + l * SZ_WC);
      for (int rep = 0; rep < ((PROBE == 1 && l == 0) ? 2 : 1); ++rep)
      if (G == 512) {
        const int x = bid & 7, i = bid >> 3;
        for (int k = 0; k < 14; ++k) { const int rp = k / 7, cp = k - rp * 7; const int rt = x * 32 + rp * 16 + (i >> 2), ct = cp * 4 + (i & 3); gemm_tile<4>(lds, hb, 1024, Wc, 1024, 1024, rt * 128, ct * 128, e); }
      } else
      for (int u = bid; u < 256 * 28; u += G) { const int rt = u / 28, ct = u - rt * 28; gemm_tile<4>(lds, hb, 1024, Wc, 1024, 1024, rt * 128, ct * 128, e); }
    }
    SEAM(pb);
    if (RUN(pb + 1)) { for (int rt = bid; rt < 512; rt += G) p2_unit(lds, p, l, rt);
#if PROBE == 13
      if (l == 0) { gbar((unsigned*)(ws + OFF_CTL) + 512, (unsigned)G); for (int rt = bid; rt < 512; rt += G) p2_unit(lds, p, l, rt, 2, true); }
#elif PROBE == 15
      if (l == 0) { gbar((unsigned*)(ws + OFF_CTL) + 512, (unsigned)G); for (int rt = bid; rt < 512; rt += G) p2_unit(lds, p, l, rt, 8, true); }
#elif PROBE == 14
      if (l == 0) { gbar((unsigned*)(ws + OFF_CTL) + 512, (unsigned)G); for (int rt = bid; rt < 512; rt += G) p2_unit(lds, p, l, rt, 4, false); }
#endif
    }
    SEAM(pb + 1);
    if (RUN(pb + 2)) {
      p3_run(lds, &s_unit, p, l, l, true, true);
#if PROBE == 3
      if (l == 0) { grid.sync(); p3_run(lds, &s_unit, p, l, 2, true, false); }
#elif PROBE == 9
      if (l == 0) { grid.sync(); p3_run(lds, &s_unit, p, l, 2, true, true); }
#elif PROBE == 10
      if (l == 0) { grid.sync(); p3_run(lds, &s_unit, p, l, 2, false, true); }
#endif
    }
    SEAM(pb + 2);
    if (RUN(pb + 3)) { for (int rep = 0; rep < ((PROBE == 5 && l == 0) ? 2 : 1); ++rep) { if (rep) grid.sync(); for (int rt = bid; rt < 512; rt += G) p4_unit(lds, p, l, rt); } }
    SEAM(pb + 3);
  }
#undef RUN
#undef SEAM
}

extern "C" void kernel_launch(void* const* d_in, const int* in_sizes, int n_in, void* d_out, int out_size, void* d_ws, size_t ws_size, hipStream_t stream) {
  static int grid = 0;
  if (grid == 0) {
    if (n_in != 26 || ws_size < WS_END) { fprintf(stderr, "kernel_launch: need 26 inputs and %zu bytes of workspace (got %d, %zu)\n", (size_t)WS_END, n_in, ws_size); grid = -1; return; }
    int dev = 0, cus = 0, per_cu = 0;
    (void)hipGetDevice(&dev);
    (void)hipDeviceGetAttribute(&cus, hipDeviceAttributeMultiprocessorCount, dev);
    (void)hipFuncSetAttribute((const void*)mk_fwd, hipFuncAttributeMaxDynamicSharedMemorySize, LDS_BYTES);
    (void)hipOccupancyMaxActiveBlocksPerMultiprocessor(&per_cu, (const void*)mk_fwd, NTH, LDS_BYTES);
    if (per_cu > 2) per_cu = 2;
    if (per_cu < 1) { fprintf(stderr, "kernel_launch: occupancy query returned %d\n", per_cu); per_cu = 1; }
    grid = cus * per_cu;
  }
  if (grid < 0) return;
  (void)hipMemsetAsync(d_ws, 0, 4096, stream);
  KP p{};
  for (int i = 0; i < 26; ++i) p.in[i] = (const float*)d_in[i];
  p.out = (float*)d_out; p.ws = (unsigned char*)d_ws;
  if (MK_LAUNCHES == 1) {
    p.ph_lo = 0; p.ph_hi = NPHASE;
    void* args[] = {&p};
    hipError_t e = hipLaunchCooperativeKernel((const void*)mk_fwd, dim3(grid), dim3(NTH), args, LDS_BYTES, stream);
    if (e != hipSuccess) fprintf(stderr, "cooperative launch failed: %s (grid %d)\n", hipGetErrorString(e), grid);
  } else {
    for (int k = 0; k < NPHASE; ++k) { p.ph_lo = k; p.ph_hi = k + 1; hipLaunchKernelGGL(mk_fwd, dim3(grid), dim3(NTH), LDS_BYTES, stream, p); }
  }
}
```

```cpp
#include <hip/hip_runtime.h>
#include <hip/hip_cooperative_groups.h>
#include <cstdio>
#include <cstdint>
namespace cg = cooperative_groups;

#ifndef PROBE
#define PROBE 0
#endif
#ifndef MK_LAUNCHES
#define MK_LAUNCHES 1
#endif

typedef unsigned short bf16_t;
typedef short bf16x8 __attribute__((ext_vector_type(8)));
typedef float f32x4 __attribute__((ext_vector_type(4)));
#define DI __device__ __forceinline__

constexpr int NB = 16, SEQ = 2048, T = NB * SEQ, DM = 1024;
constexpr int NP = 3584;
constexpr int LDPA = 1536;
constexpr int LDPB = 1728;
constexpr int NPHASE = 9;
constexpr int LDS_BYTES = 73728 + 1024 + 1024;
constexpr int NTH = 256;
constexpr int NSCAN = 192, NMLA = 96 * 16, NDIFF = 64 * 32, NATT = NMLA + NDIFF;

constexpr size_t OFF_CTL = 0;
constexpr size_t OFF_TAB = 4096;
constexpr size_t SZ_WC = (size_t)NP * 1024 * 2;
constexpr size_t OFF_WC = OFF_TAB + 262144;
constexpr size_t SZ_WO = (size_t)1024 * 1024 * 2;
constexpr size_t OFF_WO = OFF_WC + 2 * SZ_WC;
constexpr size_t SZ_WUQ = (size_t)640 * 256 * 2;
constexpr size_t OFF_WUQ = OFF_WO + 2 * SZ_WO;
constexpr size_t SZ_WUKV = (size_t)768 * 128 * 2;
constexpr size_t OFF_WUKV = OFF_WUQ + 2 * SZ_WUQ;
constexpr size_t SZ_L = (size_t)384 * 64 * 2;
constexpr size_t OFF_W2 = OFF_WUKV + 2 * SZ_WUKV;
constexpr size_t OFF_A2 = OFF_W2 + 2 * SZ_L;
constexpr size_t OFF_V2 = OFF_A2 + 2 * SZ_L;
constexpr size_t OFF_R1 = OFF_V2 + SZ_L;
constexpr size_t SZ_QK = (size_t)T * 576 * 2;
constexpr size_t OFF_PA = OFF_R1 + 2 * SZ_QK;
constexpr size_t OFF_R2 = OFF_PA + (size_t)T * LDPA * 2;
constexpr size_t SZ_Y = (size_t)T * 384 * 4;
constexpr size_t OFF_MIX = OFF_R2 + SZ_Y;
constexpr size_t OFF_VTM = OFF_MIX + (size_t)T * 1024 * 2;
static_assert(OFF_MIX + (size_t)T * 1024 * 2 >= OFF_R2 + (size_t)T * LDPB * 2, "R2 holds projB");
constexpr size_t OFF_VTD = OFF_VTM + (size_t)T * 384 * 2;
constexpr size_t SZ_SC = (size_t)T * 384 * 2;
constexpr size_t OFF_SC = OFF_VTD + (size_t)T * 256 * 2;
constexpr size_t OFF_LA = OFF_SC + 6 * SZ_SC;
constexpr size_t OFF_CU = OFF_LA + (size_t)T * 192 * 2;
constexpr size_t OFF_T0 = OFF_CU + 3 * 4096 * 4;
constexpr size_t WS_END = OFF_T0 + 3 * 16 * 384 * 4;
static_assert(OFF_R1 % 256 == 0, "align");

struct KP { const float* in[26]; float* out; unsigned char* ws; int ph_lo, ph_hi; };

DI unsigned f2bf(float f) { unsigned u = __float_as_uint(f); return (u + 0x7fffu + ((u >> 16) & 1u)) >> 16; }
DI float bf2f(bf16_t h) { return __uint_as_float(((unsigned)h) << 16); }
typedef __bf16 bf2v_t __attribute__((ext_vector_type(2)));
typedef float f2v_t __attribute__((ext_vector_type(2)));
DI unsigned pk2(float a, float b) { f2v_t f = {a, b}; return __builtin_bit_cast(unsigned, __builtin_convertvector(f, bf2v_t)); }
DI void store4bf(bf16_t* p, f32x4 v) { uint2 u; u.x = pk2(v[0], v[1]); u.y = pk2(v[2], v[3]); *(uint2*)p = u; }
DI f32x4 up4(uint2 u) { f32x4 r; r[0] = __uint_as_float(u.x << 16); r[1] = __uint_as_float(u.x & 0xffff0000u); r[2] = __uint_as_float(u.y << 16); r[3] = __uint_as_float(u.y & 0xffff0000u); return r; }
DI f32x4 load4bf(const bf16_t* p) { return up4(*(const uint2*)p); }
DI float ex2(float x) { return __builtin_amdgcn_exp2f(x); }
DI float fexp(float x) { return __builtin_amdgcn_exp2f(x * 1.4426950408889634f); }
DI float sigm(float x) { return 1.f / (1.f + fexp(-x)); }
DI float silu(float x) { return x / (1.f + fexp(-x)); }
template <int CTRL> DI float dppmov(float x) { return __builtin_bit_cast(float, __builtin_amdgcn_update_dpp(0, __builtin_bit_cast(int, x), CTRL, 0xF, 0xF, true)); }
DI float rowsum16(float x) {
  x += dppmov<0xB1>(x);
  x += dppmov<0x4E>(x);
  x += dppmov<0x141>(x);
  x += dppmov<0x140>(x);
  return x;
}
DI int otid() { int t = threadIdx.x; asm volatile("" : "+v"(t)); return t; }
DI void swap16(unsigned& a, unsigned& b) { asm("s_nop 1\n\tv_permlane16_swap_b32 %0, %1" : "+v"(a), "+v"(b)); }
DI void swap32(unsigned& a, unsigned& b) { asm("s_nop 1\n\tv_permlane32_swap_b32 %0, %1" : "+v"(a), "+v"(b)); }
DI float xsum16(float x) { unsigned a = __float_as_uint(x), b = a; swap16(a, b); return __uint_as_float(a) + __uint_as_float(b); }
DI float xsum32(float x) { unsigned a = __float_as_uint(x), b = a; swap32(a, b); return __uint_as_float(a) + __uint_as_float(b); }
DI float xmax16(float x) { unsigned a = __float_as_uint(x), b = a; swap16(a, b); return fmaxf(__uint_as_float(a), __uint_as_float(b)); }
DI float xmax32(float x) { unsigned a = __float_as_uint(x), b = a; swap32(a, b); return fmaxf(__uint_as_float(a), __uint_as_float(b)); }
DI float wave_sum(float v) { return xsum32(xsum16(rowsum16(v))); }
#define MFMA16(a, b, c) __builtin_amdgcn_mfma_f32_16x16x32_bf16((a), (b), (c), 0, 0, 0)

template <int MI, class Epi>
DI void gemm_tile(unsigned char* lds, const bf16_t* __restrict__ A, int lda, const bf16_t* __restrict__ Bt, int ldb, int K, int row0, int col0, const Epi& epi) {
  constexpr int BM = 32 * MI;
  constexpr int BUFE = (BM + 128) * 64;
  bf16_t* sbase = (bf16_t*)lds;
  const int tid = otid(), lane = tid & 63, w = tid >> 6, wm = w >> 1, wn = w & 1, lr = lane & 15, g = lane >> 4;
  const int sr = tid >> 3, skc = tid & 7, swc = (skc ^ (sr & 7)) * 8;
  const int xr = lr & 7;
  const bf16_t* gA = A + (size_t)(row0 + sr) * lda + skc * 8;
  const bf16_t* gB = Bt + (size_t)(col0 + sr) * ldb + skc * 8;
  uint4 ra0, ra1, ra2 = {0u, 0u, 0u, 0u}, ra3 = {0u, 0u, 0u, 0u}, rb0, rb1, rb2, rb3;
#define G_LOAD(k0_) do { ra0 = *(const uint4*)(gA + (k0_)); ra1 = *(const uint4*)(gA + (size_t)32 * lda + (k0_)); \
    if (MI == 4) { ra2 = *(const uint4*)(gA + (size_t)64 * lda + (k0_)); ra3 = *(const uint4*)(gA + (size_t)96 * lda + (k0_)); } \
    rb0 = *(const uint4*)(gB + (k0_)); rb1 = *(const uint4*)(gB + (size_t)32 * ldb + (k0_)); rb2 = *(const uint4*)(gB + (size_t)64 * ldb + (k0_)); rb3 = *(const uint4*)(gB + (size_t)96 * ldb + (k0_)); } while (0)
#define G_STORE(buf_) do { bf16_t* sA_ = sbase + (buf_) * BUFE + sr * 64 + swc; bf16_t* sB_ = sA_ + BM * 64; \
    *(uint4*)(sA_) = ra0; *(uint4*)(sA_ + 32 * 64) = ra1; \
    if (MI == 4) { *(uint4*)(sA_ + 64 * 64) = ra2; *(uint4*)(sA_ + 96 * 64) = ra3; } \
    *(uint4*)(sB_) = rb0; *(uint4*)(sB_ + 32 * 64) = rb1; *(uint4*)(sB_ + 64 * 64) = rb2; *(uint4*)(sB_ + 96 * 64) = rb3; } while (0)
  f32x4 acc[MI][4];
#pragma unroll
  for (int mi = 0; mi < MI; ++mi)
#pragma unroll
    for (int ni = 0; ni < 4; ++ni) acc[mi][ni] = (f32x4){0.f, 0.f, 0.f, 0.f};
  const int nk = K >> 6;
  G_LOAD(0);
  G_STORE(0);
  if (nk > 1) G_LOAD(64);
  __syncthreads();
  for (int kt = 0; kt < nk; ++kt) {
    const int cur = kt & 1;
    if (kt + 1 < nk) { G_STORE(cur ^ 1); if (kt + 2 < nk) G_LOAD((kt + 2) * 64); }
    const bf16_t* sA = sbase + cur * BUFE; const bf16_t* sB = sA + BM * 64;
#pragma unroll
    for (int ks = 0; ks < 2; ++ks) {
      bf16x8 af[MI], bfr[4];
#pragma unroll
      for (int mi = 0; mi < MI; ++mi) af[mi] = *(const bf16x8*)(sA + (wm * 16 * MI + mi * 16 + lr) * 64 + ((ks * 4 + g) ^ xr) * 8);
#pragma unroll
      for (int ni = 0; ni < 4; ++ni) bfr[ni] = *(const bf16x8*)(sB + (wn * 64 + ni * 16 + lr) * 64 + ((ks * 4 + g) ^ xr) * 8);
      __builtin_amdgcn_s_setprio(1);
#pragma unroll
      for (int mi = 0; mi < MI; ++mi)
#pragma unroll
        for (int ni = 0; ni < 4; ++ni) acc[mi][ni] = MFMA16(bfr[ni], af[mi], acc[mi][ni]);
      __builtin_amdgcn_s_setprio(0);
    }
    __syncthreads();
  }
#undef G_STORE
#pragma unroll
  for (int mi = 0; mi < MI; ++mi)
#pragma unroll
    for (int ni = 0; ni < 4; ++ni) epi(row0 + wm * 16 * MI + mi * 16 + lr, col0 + wn * 64 + ni * 16 + 4 * g, acc[mi][ni]);
#undef G_LOAD
}

struct EpiRoute {
  bf16_t* pA; bf16_t* pB; bf16_t* VtD; int ncols;
  DI void operator()(int row, int col, f32x4 v) const {
    if (col >= ncols) return;
    if (col < 416) store4bf(pB + (size_t)row * LDPB + col, v);
    else if (col < 928) store4bf(pA + (size_t)row * LDPA + (col - 416), v);
    else if (col < 1184) {
      const int c = col - 928, h = c >> 6, dv = c & 63, b = row >> 11, s = row & 2047;
      bf16_t* q = VtD + ((size_t)((b * 4 + h) * 64 + dv)) * 2048 + s;
      q[0] = (bf16_t)f2bf(v[0]); q[2048] = (bf16_t)f2bf(v[1]); q[4096] = (bf16_t)f2bf(v[2]); q[6144] = (bf16_t)f2bf(v[3]);
    }
    else if (col < 2208) store4bf(pA + (size_t)row * LDPA + 512 + (col - 1184), v);
    else store4bf(pB + (size_t)row * LDPB + 416 + (col - 2208), v);
  }
};
struct EpiQ {
  bf16_t* __restrict__ Qm; const float* __restrict__ rs; int row0;
  DI void operator()(int row, int col, f32x4 v) const {
    if (col >= 576) return;
    const float r = rs[row - row0]; v = v * r;
    store4bf(Qm + (size_t)row * 576 + col, v);
  }
};
struct EpiKV {
  bf16_t* __restrict__ Km; bf16_t* __restrict__ VtM; const float* __restrict__ rs; int row0;
  DI void operator()(int row, int col, f32x4 v) const {
    const float r = rs[row - row0]; v = v * r;
    const int head = col >> 7, c = col & 127;
    if (c < 64) store4bf(Km + (size_t)row * 576 + head * 96 + c, v);
    else {
      const int b = row >> 11, s = row & 2047;
      bf16_t* q = VtM + ((size_t)((b * 6 + head) * 64 + (c - 64))) * 2048 + s;
      q[0] = (bf16_t)f2bf(v[0]); q[2048] = (bf16_t)f2bf(v[1]); q[4096] = (bf16_t)f2bf(v[2]); q[6144] = (bf16_t)f2bf(v[3]);
    }
  }
};
struct EpiW {
  bf16_t* __restrict__ wbuf; const float* __restrict__ w0;
  DI void operator()(int row, int col, f32x4 v) const {
    f32x4 o;
#pragma unroll
    for (int i = 0; i < 4; ++i) { const float val = v[i] + w0[col + i]; const float wv = -__logf(1.f + fexp(-val)) - 0.5f; o[i] = -fexp(wv); }
    store4bf(wbuf + (size_t)row * 384 + col, o);
  }
};
struct EpiA {
  bf16_t* __restrict__ abuf; bf16_t* __restrict__ kbuf; const bf16_t* __restrict__ kraw; const float* __restrict__ a0; const float* __restrict__ ka;
  DI void operator()(int row, int col, f32x4 v) const {
    f32x4 kr = load4bf(kraw + (size_t)row * 384 + col), a, kn;
#pragma unroll
    for (int i = 0; i < 4; ++i) { a[i] = sigm(v[i] + a0[col + i]); kn[i] = kr[i] * (1.f + (a[i] - 1.f) * ka[col + i]); }
    store4bf(abuf + (size_t)row * 384 + col, a);
    store4bf(kbuf + (size_t)row * 384 + col, kn);
  }
};
struct EpiV {
  bf16_t* vbuf; const bf16_t* pB; const float* v0; const float* mu;
  DI void operator()(int row, int col, f32x4 v) const {
    const int s = row & 2047;
    const bf16_t* pc = pB + (size_t)row * LDPB + 416 + 768 + col;
    f32x4 p = load4bf(pc), pr = load4bf(s > 0 ? pc - LDPB : pc);
    if (s == 0) pr = (f32x4){0.f, 0.f, 0.f, 0.f};
    f32x4 vf = load4bf(vbuf + (size_t)row * 384 + col), o;
#pragma unroll
    for (int i = 0; i < 4; ++i) { const float xv = p[i] + (pr[i] - p[i]) * mu[768 + col + i]; const float sg = sigm(v[i] + v0[col + i]); o[i] = xv + (vf[i] - xv) * sg; }
    store4bf(vbuf + (size_t)row * 384 + col, o);
  }
};
struct EpiOut {
  const float* xin; float* xout;
  DI void operator()(int row, int col, f32x4 v) const {
    const f32x4 x = *(const f32x4*)(xin + (size_t)row * 1024 + col);
    *(f32x4*)(xout + (size_t)row * 1024 + col) = x + v;
  }
};

DI void convT(const float* __restrict__ src, int K, int N, bf16_t* dst, int Kpad, int NR, const float* scale, int gt, int ngt) {
  const int kcN = Kpad >> 3, total = NR * kcN;
  for (int idx = gt; idx < total; idx += ngt) {
    const int n = idx % NR, kc = idx / NR; uint4 o = {0u, 0u, 0u, 0u};
    if (n < N) {
      float v[8];
#pragma unroll
      for (int j = 0; j < 8; ++j) { const int k = kc * 8 + j; v[j] = (k < K) ? src[(size_t)k * N + n] * (scale ? scale[k] : 1.f) : 0.f; }
      o.x = pk2(v[0], v[1]); o.y = pk2(v[2], v[3]); o.z = pk2(v[4], v[5]); o.w = pk2(v[6], v[7]);
    }
    *(uint4*)(dst + (size_t)n * Kpad + kc * 8) = o;
  }
}
DI void norm_rows_bf16(const float* x, const float* gain, bf16_t* hb, int rbeg, int rend, int gw, int ngw, int lane) {
  for (int row = rbeg + gw; row < rend; row += ngw) {
    const f32x4* xr = (const f32x4*)(x + (size_t)row * 1024) + lane;
    f32x4 v[4]; float s = 0.f;
#pragma unroll
    for (int j = 0; j < 4; ++j) { v[j] = xr[64 * j]; s += v[j][0] * v[j][0] + v[j][1] * v[j][1] + v[j][2] * v[j][2] + v[j][3] * v[j][3]; }
    const float rstd = 1.f / sqrtf(wave_sum(s) * (1.f / 1024.f) + 1e-6f);
#pragma unroll
    for (int j = 0; j < 4; ++j) { const f32x4 gg = *((const f32x4*)gain + lane + 64 * j); store4bf(hb + (size_t)row * 1024 + 4 * lane + 256 * j, v[j] * rstd * gg); }
  }
}

DI void p2_unit(unsigned char* lds, const KP& p, int l, int rt, int parts = 15, bool dummy = false) {
  unsigned char* ws = p.ws;
  const int tid = otid(), lane = tid & 63, w = tid >> 6, row0 = rt * 64;
  bf16_t* pB = (bf16_t*)(ws + OFF_R2);
  bf16_t* Qm = (bf16_t*)(ws + OFF_R1); bf16_t* Km = Qm + (size_t)T * 576;
  bf16_t* VtM = (bf16_t*)(ws + OFF_VTM);
  bf16_t* rbuf = (bf16_t*)(ws + OFF_SC); bf16_t* kbuf = rbuf + (size_t)T * 384; bf16_t* vbuf = kbuf + (size_t)T * 384;
  bf16_t* wbuf = vbuf + (size_t)T * 384; bf16_t* kkbuf = wbuf + (size_t)T * 384; bf16_t* abuf = kkbuf + (size_t)T * 384;
  bf16_t* LA = (bf16_t*)(ws + OFF_LA);
  const float* tab = (const float*)(ws + OFF_TAB);
  float* sRq = (float*)(lds + 73728); float* sRkv = sRq + 64;
  __syncthreads();
  if (parts & 1) {
    const int r = tid >> 2, part = tid & 3; const bf16_t* pr = pB + (size_t)(row0 + r) * LDPB;
    float sq = 0.f, sk = 0.f;
#pragma unroll
    for (int j = 0; j < 16; ++j) { f32x4 v = load4bf(pr + part * 64 + j * 4); sq += v[0] * v[0] + v[1] * v[1] + v[2] * v[2] + v[3] * v[3]; }
#pragma unroll
    for (int j = 0; j < 8; ++j) { f32x4 v = load4bf(pr + 256 + part * 32 + j * 4); sk += v[0] * v[0] + v[1] * v[1] + v[2] * v[2] + v[3] * v[3]; }
    sq += dppmov<0xB1>(sq); sq += dppmov<0x4E>(sq); sk += dppmov<0xB1>(sk); sk += dppmov<0x4E>(sk);
    if (part == 0) { sRq[r] = 1.f / sqrtf(sq * (1.f / 256.f) + 1e-6f); sRkv[r] = 1.f / sqrtf(sk * (1.f / 128.f) + 1e-6f); }
  }
  if (dummy) { rbuf = (bf16_t*)p.out; wbuf = rbuf + (size_t)T * 384; kkbuf = wbuf + (size_t)T * 384; vbuf = kkbuf + (size_t)T * 384; }
  if (parts & 2) {
    const float* mu = p.in[12] + l * 1280; const float* kkw = p.in[20] + l * 384;
    float mur[6], muk[6], muv_[6], kkw_[6];
#pragma unroll
    for (int h = 0; h < 6; ++h) { mur[h] = mu[h * 64 + lane]; muk[h] = mu[384 + h * 64 + lane]; muv_[h] = mu[768 + h * 64 + lane]; kkw_[h] = kkw[h * 64 + lane]; }
    for (int t = w; t < 64; t += 4) {
      const int row = row0 + t, s = row & 2047;
      const bf16_t* pc = pB + (size_t)row * LDPB + 416 + lane;
      const bf16_t* pp = (s > 0) ? pc - LDPB : pc;
      const float pm = (s > 0) ? 1.f : 0.f;
      float cr[6], ck[6], cv[6], qr[6], qk[6], qv[6];
#pragma unroll
      for (int h = 0; h < 6; ++h) { cr[h] = bf2f(pc[h * 64]); ck[h] = bf2f(pc[384 + h * 64]); cv[h] = bf2f(pc[768 + h * 64]); qr[h] = bf2f(pp[h * 64]) * pm; qk[h] = bf2f(pp[384 + h * 64]) * pm; qv[h] = bf2f(pp[768 + h * 64]) * pm; }
#pragma unroll
      for (int h = 0; h < 6; ++h) {
        const float xr = cr[h] + (qr[h] - cr[h]) * mur[h], xk = ck[h] + (qk[h] - ck[h]) * muk[h], xv = cv[h] + (qv[h] - cv[h]) * muv_[h];
        const float kv_ = xk * kkw_[h]; const float ss = wave_sum(kv_ * kv_);
        const float kk = kv_ / fmaxf(sqrtf(ss), 1e-12f);
        const size_t o = (size_t)row * 384 + h * 64 + lane;
        rbuf[o] = (bf16_t)f2bf(xr); wbuf[o] = (bf16_t)f2bf(xk); kkbuf[o] = (bf16_t)f2bf(kk);
        if (l == 0) vbuf[o] = (bf16_t)f2bf(xv);
      }
    }
  }
  if (parts & 4) {
    const float* mu = p.in[12] + l * 1280;
    const float* muv = p.in[13];
    f32x4 cur[12], prv[12];
#pragma unroll
    for (int i = 0; i < 12; ++i) {
      const int item = tid + 256 * i, r = item / 48, q = item - r * 48, row = row0 + r, s = row & 2047;
      const int qc = q < 40 ? q : 39;
      const bf16_t* pc = pB + (size_t)row * LDPB + 416 + 1152 + 4 * qc;
      cur[i] = load4bf(pc); prv[i] = load4bf(s > 0 ? pc - LDPB : pc);
    }
#pragma unroll
    for (int i = 0; i < 12; ++i) {
      const int item = tid + 256 * i, r = item / 48, q = item - r * 48, row = row0 + r, s = row & 2047;
      f32x4 o;
#pragma unroll
      for (int e = 0; e < 4; ++e) {
        const int j = 4 * q + e;
        const bool act = (j < 128) || (j < 160 && l > 0);
        const float m = (j < 128) ? mu[1152 + j] : muv[(j < 160 ? j : 159) - 128];
        const float pv = (s > 0) ? prv[i][e] : 0.f;
        float val = cur[i][e] + (pv - cur[i][e]) * m;
        if (j < 64) val = 1.f - 2.f / (fexp(2.f * val) + 1.f);
        o[e] = act ? val : 0.f;
      }
      store4bf(LA + (size_t)row * 192 + 4 * q, o);
    }
  }
  __syncthreads();
  if (parts & 1) {
    const bf16_t* WuqT = (const bf16_t*)(ws + OFF_WUQ + l * SZ_WUQ);
    const bf16_t* WukvT = (const bf16_t*)(ws + OFF_WUKV + l * SZ_WUKV);
    EpiQ eq{Qm, sRq, row0};
    for (int ct = 0; ct < 5; ++ct) gemm_tile<2>(lds, pB, LDPB, WuqT, 256, 256, row0, ct * 128, eq);
    EpiKV ek{Km, VtM, sRkv, row0};
    for (int ct = 0; ct < 6; ++ct) gemm_tile<2>(lds, pB + 256, LDPB, WukvT, 128, 128, row0, ct * 128, ek);
  }
  if (parts & 8) {
    const bf16_t* w2T = (const bf16_t*)(ws + OFF_W2 + l * SZ_L);
    const bf16_t* a2T = (const bf16_t*)(ws + OFF_A2 + l * SZ_L);
    const bf16_t* v2T = (const bf16_t*)(ws + OFF_V2);
    EpiA ea{dummy ? kkbuf : abuf, dummy ? vbuf : kbuf, wbuf, p.in[16] + l * 384, p.in[21] + l * 384};
    for (int ct = 0; ct < 3; ++ct) gemm_tile<2>(lds, LA + 64, 192, a2T, 64, 64, row0, ct * 128, ea);
    __syncthreads();
    EpiW ew{wbuf, p.in[14] + l * 384};
    for (int ct = 0; ct < 3; ++ct) gemm_tile<2>(lds, LA, 192, w2T, 64, 64, row0, ct * 128, ew);
    if (l > 0) {
      EpiV ev{vbuf, pB, p.in[18], p.in[12] + l * 1280};
      for (int ct = 0; ct < 3; ++ct) gemm_tile<2>(lds, LA + 128, 192, v2T, 64, 64, row0, ct * 128, ev);
    }
  }
  __syncthreads();
  if (parts & 1) {
    for (int idx = tid; idx < 64 * 16; idx += NTH) {
      const int r = idx >> 4, i = idx & 15, row = row0 + r, s = row & 2047;
      const float c = tab[s * 32 + i], sn = tab[s * 32 + 16 + i];
      bf16_t* q = Qm + (size_t)row * 576 + 64;
#pragma unroll
      for (int h = 0; h < 6; ++h) { const float t1 = bf2f(q[h * 96 + i]), t2 = bf2f(q[h * 96 + 16 + i]); q[h * 96 + i] = (bf16_t)f2bf(t1 * c - t2 * sn); q[h * 96 + 16 + i] = (bf16_t)f2bf(t1 * sn + t2 * c); }
      const float k1 = bf2f(pB[(size_t)row * LDPB + 384 + i]), k2 = bf2f(pB[(size_t)row * LDPB + 400 + i]);
      const bf16_t o1 = (bf16_t)f2bf(k1 * c - k2 * sn), o2 = (bf16_t)f2bf(k1 * sn + k2 * c);
      bf16_t* kq = Km + (size_t)row * 576 + 64;
#pragma unroll
      for (int h = 0; h < 6; ++h) { kq[h * 96 + i] = o1; kq[h * 96 + 16 + i] = o2; }
    }
  }
}

struct ScanOps { f32x4 w, k, a, b, r; f2v_t v, bk; };
DI void scan_unit(unsigned char* lds, const KP& p, int unit) {
  unsigned char* ws = p.ws;
  float* sm = (float*)lds;
  const int tid = otid(), lane = tid & 63, w16 = tid >> 6, rg = lane >> 4, cg_ = lane & 15;
  const int hid = unit >> 1, half = unit & 1, b = hid / 6, h = hid - b * 6;
  const bf16_t* rbuf = (const bf16_t*)(ws + OFF_SC); const bf16_t* kbuf = rbuf + (size_t)T * 384; const bf16_t* vbuf = kbuf + (size_t)T * 384;
  const bf16_t* wbuf = vbuf + (size_t)T * 384; const bf16_t* kkbuf = wbuf + (size_t)T * 384; const bf16_t* abuf = kkbuf + (size_t)T * 384;
  float* ybuf = (float*)(ws + OFF_R2);
  const int st = tid >> 4, sp = tid & 15;
  const size_t gbase = ((size_t)b * 2048) * 384 + h * 64 + sp * 4;
  uint2 qw, qk, qkk, qa, qr, qv;
#define SCAN_LOAD(t0) do { const size_t o_ = gbase + (size_t)((t0) + st) * 384; qw = *(const uint2*)(wbuf + o_); qk = *(const uint2*)(kbuf + o_); qkk = *(const uint2*)(kkbuf + o_); \
    qa = *(const uint2*)(abuf + o_); qr = *(const uint2*)(rbuf + o_); qv = *(const uint2*)(vbuf + o_); } while (0)
  f2v_t P0 = {0.f, 0.f}, P1 = {0.f, 0.f}, P2 = {0.f, 0.f}, P3 = {0.f, 0.f};
  SCAN_LOAD(0);
  const int rowoff = half * 32 + w16 * 8 + rg * 2;
  float* yout = ybuf + ((size_t)b * 2048) * 384 + h * 64 + rowoff;
  float* ypw = sm + 16 * 400 + w16 * (64 * 40);
  __builtin_amdgcn_s_setprio(3);
  for (int ch = 0; ch < 128; ++ch) {
    __syncthreads();
    {
      float* d = sm + st * 400 + sp * 4;
      const f32x4 fw = up4(qw), fk = up4(qk), fkk = up4(qkk), fa = up4(qa), fr = up4(qr), fv = up4(qv);
      f32x4 dec;
#pragma unroll
      for (int i = 0; i < 4; ++i) dec[i] = fexp(fw[i]);
      const f32x4 bp = fkk * fa;
      float be = bp[0] * fr[0] + bp[1] * fr[1] + bp[2] * fr[2] + bp[3] * fr[3];
      float ka = fk[0] * fr[0] + fk[1] * fr[1] + fk[2] * fr[2] + fk[3] * fr[3];
      be = rowsum16(be); ka = rowsum16(ka);
      *(f32x4*)(d) = dec; *(f32x4*)(d + 64) = fk; *(f32x4*)(d + 128) = -fkk; *(f32x4*)(d + 192) = bp; *(f32x4*)(d + 256) = dec * fr; *(f32x4*)(d + 320) = fv;
      if (sp == 0) { sm[st * 400 + 384] = be; sm[st * 400 + 385] = ka; }
    }
    __syncthreads();
    if (ch + 1 < 128) SCAN_LOAD((ch + 1) * 16);
#define SCAN_OPS(D, t_) do { const float* q_ = sm + (t_) * 400; D.w = *(const f32x4*)(q_ + 4 * cg_); D.k = *(const f32x4*)(q_ + 64 + 4 * cg_); D.a = *(const f32x4*)(q_ + 128 + 4 * cg_); \
      D.b = *(const f32x4*)(q_ + 192 + 4 * cg_); D.r = *(const f32x4*)(q_ + 256 + 4 * cg_); D.v = *(const f2v_t*)(q_ + 320 + rowoff); D.bk = *(const f2v_t*)(q_ + 384); } while (0)
    ScanOps cur, nxt;
    SCAN_OPS(cur, 0); nxt = cur;
#pragma unroll
    for (int t = 0; t < 16; ++t) {
      if (t < 15) SCAN_OPS(nxt, t + 1);
      asm volatile("" ::: "memory");
      const f32x4 w4 = cur.w, k4 = cur.k, a4 = cur.a, b4 = cur.b, r4 = cur.r; const f2v_t v2 = cur.v, bk = cur.bk;
      const f2v_t sa = (P0 * a4[0] + P1 * a4[1]) + (P2 * a4[2] + P3 * a4[3]);
      const f2v_t yd = (P0 * r4[0] + P1 * r4[1]) + (P2 * r4[2] + P3 * r4[3]);
      const f2v_t pre0 = P0 * w4[0] + v2 * k4[0], pre1 = P1 * w4[1] + v2 * k4[1], pre2 = P2 * w4[2] + v2 * k4[2], pre3 = P3 * w4[3] + v2 * k4[3];
      float sa0 = sa[0], sa1 = sa[1];
#define DPPADD2(x_, y_, CTL) asm("s_nop 1\n\tv_add_f32_dpp %0, %0, %0 " CTL " row_mask:0xf bank_mask:0xf bound_ctrl:1\n\tv_add_f32_dpp %1, %1, %1 " CTL " row_mask:0xf bank_mask:0xf bound_ctrl:1" : "+v"(x_), "+v"(y_))
      DPPADD2(sa0, sa1, "quad_perm:[1,0,3,2]"); DPPADD2(sa0, sa1, "quad_perm:[2,3,0,1]"); DPPADD2(sa0, sa1, "row_half_mirror"); DPPADD2(sa0, sa1, "row_mirror");
      const f2v_t sa2 = {sa0, sa1};
      P0 = sa2 * b4[0] + pre0; P1 = sa2 * b4[1] + pre1; P2 = sa2 * b4[2] + pre2; P3 = sa2 * b4[3] + pre3;
#undef DPPADD2
      const f2v_t fin = sa2 * bk[0] + v2 * bk[1];
      const f2v_t yp = (cg_ == 0) ? (yd + fin) : yd;
      *(f2v_t*)(ypw + (t * 4 + rg) * 40 + cg_ * 2) = yp;
      cur = nxt;
    }
#undef SCAN_OPS
    {
      const float* yr = ypw + lane * 40;
      f32x4 a0 = *(const f32x4*)(yr), a1 = *(const f32x4*)(yr + 4), a2 = *(const f32x4*)(yr + 8), a3 = *(const f32x4*)(yr + 12);
      f32x4 a4_ = *(const f32x4*)(yr + 16), a5 = *(const f32x4*)(yr + 20), a6 = *(const f32x4*)(yr + 24), a7 = *(const f32x4*)(yr + 28);
      const f32x4 q = ((a0 + a1) + (a2 + a3)) + ((a4_ + a5) + (a6 + a7));
      const int tt = lane >> 2, rr = lane & 3;
      *(f2v_t*)(ybuf + ((size_t)b * 2048 + ch * 16 + tt) * 384 + h * 64 + half * 32 + w16 * 8 + rr * 2) = (f2v_t){q[0] + q[2], q[1] + q[3]};
    }
  }
  __builtin_amdgcn_s_setprio(0);
#undef SCAN_LOAD
}

template <bool DIFF>
DI void attn_unit(unsigned char* lds, const bf16_t* __restrict__ Qb, const bf16_t* __restrict__ Kb, int ld, const bf16_t* __restrict__ Vt,
                  const bf16_t* __restrict__ gate, bf16_t* mixed, const int* __restrict__ pos, int qb, int h, int rowb,
                  float lam_full, float lam_init, const float* __restrict__ gsub) {
  constexpr int KS = DIFF ? 1 : 3, NM = DIFF ? 2 : 1, KW = DIFF ? 80 : 112,
                NQT = DIFF ? 1 : 2, QU = 64 * NQT;
  bf16_t* sK = (bf16_t*)lds; bf16_t* sV = sK + 64 * KW;
  const int tid = otid(), lane = tid & 63, w = tid >> 6, lr = lane & 15, g = lane >> 4;
  const int q0 = qb * QU, qw0 = q0 + 16 * NQT * w;
  bf16x8 qf[NM][NQT][KS];
#pragma unroll
  for (int m = 0; m < NM; ++m)
#pragma unroll
    for (int qt = 0; qt < NQT; ++qt)
#pragma unroll
      for (int ks = 0; ks < KS; ++ks) qf[m][qt][ks] = *(const bf16x8*)(Qb + (size_t)(qw0 + 16 * qt + lr) * ld + m * 32 + ks * 32 + g * 8);
  f32x4 O[NM][4][NQT]; float mrun[NM][NQT], lrun[NM][NQT];
#pragma unroll
  for (int m = 0; m < NM; ++m)
#pragma unroll
    for (int qt = 0; qt < NQT; ++qt) { mrun[m][qt] = -INFINITY; lrun[m][qt] = 0.f;
#pragma unroll
      for (int dt = 0; dt < 4; ++dt) O[m][dt][qt] = (f32x4){0.f, 0.f, 0.f, 0.f}; }
  float posq[2] = {0.f, 0.f};
  if (DIFF) { posq[0] = (float)pos[qw0 + lr]; if (NQT > 1) posq[1] = (float)pos[qw0 + 16 + lr]; }
  const float sc = DIFF ? (0.17677669529663687f * 1.4426950408889634f) : (0.10206207261596575f * 1.4426950408889634f);
  const float slope2 = DIFF ? ex2(-2.f * (float)(h + 1)) * 1.4426950408889634f : 0.f;
  const int nkt = (q0 + QU) / 64;
  const int vr = tid >> 3, vc = tid & 7;
  int kr0, kc0, kr1, kc1, kr2 = 0, kc2 = 0;
  if (DIFF) { kr0 = vr; kc0 = vc; kr1 = vr + 32; kc1 = vc; }
  else { kr0 = tid / 12; kc0 = tid - kr0 * 12; kr1 = (tid + 256) / 12; kc1 = (tid + 256) - kr1 * 12; kr2 = (tid + 512) / 12; kc2 = (tid + 512) - kr2 * 12; }
  uint4 rk0, rk1, rk2 = {0u, 0u, 0u, 0u}, rv0, rv1;
#define ATT_LOAD(j_) do { rk0 = *(const uint4*)(Kb + (size_t)(64 * (j_) + kr0) * ld + kc0 * 8); rk1 = *(const uint4*)(Kb + (size_t)(64 * (j_) + kr1) * ld + kc1 * 8); \
    if (!DIFF) rk2 = *(const uint4*)(Kb + (size_t)(64 * (j_) + kr2) * ld + kc2 * 8); \
    rv0 = *(const uint4*)(Vt + (size_t)vr * 2048 + 64 * (j_) + vc * 8); rv1 = *(const uint4*)(Vt + (size_t)(vr + 32) * 2048 + 64 * (j_) + vc * 8); } while (0)
  ATT_LOAD(0);
  for (int j = 0; j < nkt; ++j) {
    __syncthreads();
    *(uint4*)(sK + kr0 * KW + kc0 * 8) = rk0; *(uint4*)(sK + kr1 * KW + kc1 * 8) = rk1; if (!DIFF) *(uint4*)(sK + kr2 * KW + kc2 * 8) = rk2;
    *(uint4*)(sV + vr * 72 + vc * 8) = rv0; *(uint4*)(sV + (vr + 32) * 72 + vc * 8) = rv1;
    __syncthreads();
    if (j + 1 < nkt) ATT_LOAD(j + 1);
    if (64 * j <= qw0 + 16 * NQT - 1) {
      const bool domask = (64 * j + 63 > qw0);
      int4 pk[4];
      if (DIFF) {
#pragma unroll
        for (int kt = 0; kt < 4; ++kt) pk[kt] = *(const int4*)(pos + 64 * j + 16 * kt + 4 * g);
      }
#pragma unroll
      for (int m = 0; m < NM; ++m) {
        f32x4 s[4][NQT];
#pragma unroll
        for (int kt = 0; kt < 4; ++kt) {
#pragma unroll
          for (int qt = 0; qt < NQT; ++qt) s[kt][qt] = (f32x4){0.f, 0.f, 0.f, 0.f};
#pragma unroll
          for (int ks = 0; ks < KS; ++ks) {
            const bf16x8 kf = *(const bf16x8*)(sK + (16 * kt + lr) * KW + m * 32 + ks * 32 + g * 8);
#pragma unroll
            for (int qt = 0; qt < NQT; ++qt) s[kt][qt] = MFMA16(kf, qf[m][qt][ks], s[kt][qt]);
          }
        }
#pragma unroll
        for (int kt = 0; kt < 4; ++kt)
#pragma unroll
          for (int qt = 0; qt < NQT; ++qt)
#pragma unroll
            for (int i = 0; i < 4; ++i) {
              float v = s[kt][qt][i] * sc;
              if (DIFF) { const int pki = (i == 0) ? pk[kt].x : (i == 1) ? pk[kt].y : (i == 2) ? pk[kt].z : pk[kt].w; v -= slope2 * fabsf(posq[qt] - (float)pki); }
              s[kt][qt][i] = v;
            }
        if (domask) {
#pragma unroll
          for (int kt = 0; kt < 4; ++kt)
#pragma unroll
            for (int qt = 0; qt < NQT; ++qt)
#pragma unroll
              for (int i = 0; i < 4; ++i) if (64 * j + 16 * kt + 4 * g + i > qw0 + 16 * qt + lr) s[kt][qt][i] = -INFINITY;
        }
#pragma unroll
        for (int qt = 0; qt < NQT; ++qt) {
          float mx = -INFINITY;
#pragma unroll
          for (int kt = 0; kt < 4; ++kt)
#pragma unroll
            for (int i = 0; i < 4; ++i) mx = fmaxf(mx, s[kt][qt][i]);
          mx = xmax32(xmax16(mx));
          const float mn = fmaxf(mrun[m][qt], mx), alpha = ex2(mrun[m][qt] - mn); mrun[m][qt] = mn;
          float ls = 0.f;
#pragma unroll
          for (int kt = 0; kt < 4; ++kt)
#pragma unroll
            for (int i = 0; i < 4; ++i) { const float pv = ex2(s[kt][qt][i] - mn); ls += pv; s[kt][qt][i] = pv; }
          lrun[m][qt] = lrun[m][qt] * alpha + ls;
#pragma unroll
          for (int dt = 0; dt < 4; ++dt) O[m][dt][qt] = O[m][dt][qt] * alpha;
        }
#pragma unroll
        for (int s2 = 0; s2 < 2; ++s2) {
          bf16x8 pf[NQT];
#pragma unroll
          for (int qt = 0; qt < NQT; ++qt) {
            uint4 u; u.x = pk2(s[2 * s2][qt][0], s[2 * s2][qt][1]); u.y = pk2(s[2 * s2][qt][2], s[2 * s2][qt][3]);
            u.z = pk2(s[2 * s2 + 1][qt][0], s[2 * s2 + 1][qt][1]); u.w = pk2(s[2 * s2 + 1][qt][2], s[2 * s2 + 1][qt][3]);
            pf[qt] = __builtin_bit_cast(bf16x8, u);
          }
#pragma unroll
          for (int dt = 0; dt < 4; ++dt) {
            const uint2 lo = *(const uint2*)(sV + (16 * dt + lr) * 72 + 32 * s2 + 4 * g), hi = *(const uint2*)(sV + (16 * dt + lr) * 72 + 32 * s2 + 16 + 4 * g);
            uint4 u; u.x = lo.x; u.y = lo.y; u.z = hi.x; u.w = hi.y;
            const bf16x8 vf = __builtin_bit_cast(bf16x8, u);
#pragma unroll
            for (int qt = 0; qt < NQT; ++qt) O[m][dt][qt] = MFMA16(vf, pf[qt], O[m][dt][qt]);
          }
        }
      }
    }
  }
#undef ATT_LOAD
#pragma unroll
  for (int qt = 0; qt < NQT; ++qt) {
    const size_t row = (size_t)rowb + qw0 + 16 * qt + lr;
    float inv[NM];
#pragma unroll
    for (int m = 0; m < NM; ++m) { const float lt = xsum32(xsum16(lrun[m][qt])); inv[m] = 1.f / lt; }
    if (!DIFF) {
#pragma unroll
      for (int dt = 0; dt < 4; ++dt) {
        const int col = h * 64 + 16 * dt + 4 * g;
        const f32x4 gt = load4bf(gate + row * LDPA + 512 + col); f32x4 o = O[0][dt][qt] * inv[0];
#pragma unroll
        for (int i = 0; i < 4; ++i) o[i] *= silu(gt[i]);
        store4bf(mixed + row * 1024 + col, o);
      }
    } else {
      f32x4 o[4]; float ss = 0.f;
#pragma unroll
      for (int dt = 0; dt < 4; ++dt) { o[dt] = O[0][dt][qt] * inv[0] - O[NM - 1][dt][qt] * (lam_full * inv[NM - 1]); ss += o[dt][0] * o[dt][0] + o[dt][1] * o[dt][1] + o[dt][2] * o[dt][2] + o[dt][3] * o[dt][3]; }
      ss = xsum32(xsum16(ss));
      const float rs = (1.f / sqrtf(ss * (1.f / 64.f) + 1e-5f)) * (1.f - lam_init);
#pragma unroll
      for (int dt = 0; dt < 4; ++dt) {
        const int dvc = 16 * dt + 4 * g, col = h * 64 + dvc;
        const f32x4 gs = *(const f32x4*)(gsub + dvc); const f32x4 gt = load4bf(gate + row * LDPA + 512 + 384 + col);
        f32x4 r;
#pragma unroll
        for (int i = 0; i < 4; ++i) r[i] = o[dt][i] * rs * gs[i] * silu(gt[i]);
        store4bf(mixed + row * 1024 + 384 + col, r);
      }
    }
  }
}

DI void p4_unit(unsigned char* lds, const KP& p, int l, int rt) {
  unsigned char* ws = p.ws;
  const int tid = otid(), lane = tid & 63, w = tid >> 6, row0 = rt * 64;
  const bf16_t* rbuf = (const bf16_t*)(ws + OFF_SC); const bf16_t* kbuf = rbuf + (size_t)T * 384; const bf16_t* vbuf = kbuf + (size_t)T * 384;
  const float* ybuf = (const float*)(ws + OFF_R2); bf16_t* mixed = (bf16_t*)(ws + OFF_MIX);
  const bf16_t* pA = (const bf16_t*)(ws + OFF_PA);
  const float* lnw = p.in[23] + l * 384; const float* lnb = p.in[24] + l * 384; const float* rk = p.in[22] + l * 384;
  {
    float lw[6], lb[6], rkk[6];
#pragma unroll
    for (int h = 0; h < 6; ++h) { lw[h] = lnw[h * 64 + lane]; lb[h] = lnb[h * 64 + lane]; rkk[h] = rk[h * 64 + lane]; }
    for (int t = w; t < 64; t += 4) {
      const int row = row0 + t; const size_t o = (size_t)row * 384 + lane;
      float y[6], r[6], k[6], v[6], gt[6];
#pragma unroll
      for (int h = 0; h < 6; ++h) { y[h] = ybuf[o + h * 64]; r[h] = bf2f(rbuf[o + h * 64]); k[h] = bf2f(kbuf[o + h * 64]); v[h] = bf2f(vbuf[o + h * 64]); gt[h] = bf2f(pA[(size_t)row * LDPA + 512 + 640 + h * 64 + lane]); }
#pragma unroll
      for (int h = 0; h < 6; ++h) {
        const float mean = wave_sum(y[h]) * (1.f / 64.f); const float d = y[h] - mean; const float var = wave_sum(d * d) * (1.f / 64.f);
        const float dot = wave_sum(r[h] * k[h] * rkk[h]);
        float outv = d * (1.f / sqrtf(var + 64e-5f)) * lw[h] + lb[h] + dot * v[h];
        if ((row & 2047) == 0) outv = ((const float*)(ws + OFF_T0))[((size_t)l * 16 + (row >> 11)) * 384 + h * 64 + lane];
        mixed[(size_t)row * 1024 + 640 + h * 64 + lane] = (bf16_t)f2bf(outv * silu(gt[h]));
      }
    }
  }
  __syncthreads();
  const bf16_t* WoT = (const bf16_t*)(ws + OFF_WO + l * SZ_WO);
  EpiOut eo{l == 0 ? p.in[0] : p.out, p.out};
  for (int ct = 0; ct < 8; ++ct) gemm_tile<2>(lds, mixed, 1024, WoT, 1024, 1024, row0, ct * 128, eo);
  __syncthreads();
  if (l == 0) norm_rows_bf16(p.out, p.in[2] + 1024, (bf16_t*)(ws + OFF_R1), row0, row0 + 64, w, 4, lane);
  else {
    const float* fg = p.in[25];
    for (int row = row0 + w; row < row0 + 64; row += 4) {
      f32x4* xr = (f32x4*)(p.out + (size_t)row * 1024) + lane;
      f32x4 v[4]; float s = 0.f;
#pragma unroll
      for (int j = 0; j < 4; ++j) { v[j] = xr[64 * j]; s += v[j][0] * v[j][0] + v[j][1] * v[j][1] + v[j][2] * v[j][2] + v[j][3] * v[j][3]; }
      const float rstd = 1.f / sqrtf(wave_sum(s) * (1.f / 1024.f) + 1e-6f);
#pragma unroll
      for (int j = 0; j < 4; ++j) { const f32x4 gg = *((const f32x4*)fg + lane + 64 * j); xr[64 * j] = v[j] * rstd * gg; }
    }
  }
}

DI void t0_unit(unsigned char* lds, const KP& p, int l, int b) {
  unsigned char* ws = p.ws;
  float* hv_ = (float*)lds;
  float* pv = hv_ + 1024;
  float* red = pv + 1280;
  float* kp = red + 8;
  float* vv = kp + 384;
  const int tid = otid(), lane = tid & 63, w = tid >> 6;
  const size_t row = (size_t)b * 2048;
  const float* xr = (l == 0 ? p.in[0] : (const float*)p.out) + row * 1024;
  const float* g = p.in[2] + l * 1024;
  __syncthreads();
  float ss = 0.f;
  for (int k = tid; k < 1024; k += NTH) { const float x = xr[k]; ss += x * x; }
  ss = wave_sum(ss);
  if (lane == 0) red[w] = ss;
  __syncthreads();
  const float rstd = 1.f / sqrtf((red[0] + red[1] + red[2] + red[3]) * (1.f / 1024.f) + 1e-6f);
  for (int k = tid; k < 1024; k += NTH) hv_[k] = xr[k] * rstd * g[k];
  __syncthreads();
  const float* W = p.in[3] + (size_t)l * 1024 * 3488 + 2208;
  const float* Wv = p.in[4];
  const float* mu = p.in[12] + l * 1280; const float* muv = p.in[13];
  const int ncol = l ? 1248 : 1216;
  for (int c0 = tid; c0 < ncol; c0 += NTH) {
    const float* wp; int ldw; float m;
    if (c0 < 1152) { wp = W + c0; ldw = 3488; m = mu[c0]; }
    else if (c0 < 1216) { wp = W + 1216 + (c0 - 1152); ldw = 3488; m = mu[1216 + (c0 - 1152)]; }
    else { wp = Wv + (c0 - 1216); ldw = 32; m = muv[c0 - 1216]; }
    float a0_ = 0.f, a1_ = 0.f, a2_ = 0.f, a3_ = 0.f;
    for (int k = 0; k < 1024; k += 16) {
      float wv[16];
#pragma unroll
      for (int u = 0; u < 16; ++u) wv[u] = wp[(size_t)(k + u) * ldw];
#pragma unroll
      for (int u = 0; u < 16; u += 4) { a0_ += hv_[k + u] * wv[u]; a1_ += hv_[k + u + 1] * wv[u + 1]; a2_ += hv_[k + u + 2] * wv[u + 2]; a3_ += hv_[k + u + 3] * wv[u + 3]; }
    }
    pv[c0] = ((a0_ + a1_) + (a2_ + a3_)) * (1.f - m);
  }
  __syncthreads();
  const float* a2w = p.in[17] + (size_t)l * 64 * 384; const float* a0w = p.in[16] + l * 384; const float* kaw = p.in[21] + l * 384;
  const float* v2w = p.in[19]; const float* v0w = p.in[18];
  for (int j = tid; j < 384; j += NTH) {
    float acc = a0w[j];
    for (int i = 0; i < 64; ++i) acc += pv[1152 + i] * a2w[i * 384 + j];
    const float a = sigm(acc);
    kp[j] = pv[384 + j] * (1.f + (a - 1.f) * kaw[j]);
    float v = pv[768 + j];
    if (l > 0) {
      float av = v0w[j];
      for (int i = 0; i < 32; ++i) av += pv[1216 + i] * v2w[i * 384 + j];
      vv[j] = av;
    } else vv[j] = 0.f;
    pv[768 + j] = v;
  }
  __syncthreads();
  float* t0 = (float*)(ws + OFF_T0) + ((size_t)l * 16 + b) * 384;
  if (l > 0) {
    const float* vfirst = (const float*)(ws + OFF_T0) + 2 * 16 * 384 + (size_t)b * 384;
    for (int j = tid; j < 384; j += NTH) { const float xv = pv[768 + j]; pv[768 + j] = xv + (vfirst[j] - xv) * sigm(vv[j]); }
  } else {
    float* vfirst = (float*)(ws + OFF_T0) + 2 * 16 * 384 + (size_t)b * 384;
    for (int j = tid; j < 384; j += NTH) vfirst[j] = pv[768 + j];
  }
  __syncthreads();
  const float* lnw = p.in[23] + l * 384; const float* lnb = p.in[24] + l * 384; const float* rk = p.in[22] + l * 384;
  for (int h = w; h < 6; h += 4) {
    const int j = h * 64 + lane;
    const float r = pv[j], k = kp[j], v = pv[768 + j];
    const float c = wave_sum(k * r), dot = wave_sum(r * k * rk[j]);
    const float y = v * c;
    const float mean = wave_sum(y) * (1.f / 64.f); const float d = y - mean; const float var = wave_sum(d * d) * (1.f / 64.f);
    t0[j] = d * (1.f / sqrtf(var + 64e-5f)) * lnw[j] + lnb[j] + dot * v;
  }
}

DI void p3_run(unsigned char* lds, int* s_unit, const KP& p, int l, int cslot, bool do_scan, bool do_att) {
  unsigned char* ws = p.ws;
  const int tid = otid();
  unsigned* ctrS = (unsigned*)(ws + OFF_CTL) + 16 * (2 * cslot + 1);
  unsigned* ctrA = (unsigned*)(ws + OFF_CTL) + 16 * (2 * cslot + 2);
  unsigned* cucnt = (unsigned*)(ws + OFF_CU) + 4096 * cslot;
  const bf16_t* pA = (const bf16_t*)(ws + OFF_PA);
  const bf16_t* Qm = (const bf16_t*)(ws + OFF_R1); const bf16_t* Km = Qm + (size_t)T * 576;
  bf16_t* mixed = (bf16_t*)(ws + OFF_MIX);
  const int* pos = (const int*)p.in[1];
  const float* lam = p.in[10] + l * 128;
  float d0 = 0.f, d1 = 0.f;
  for (int i = 0; i < 32; ++i) { d0 += lam[i] * lam[32 + i]; d1 += lam[64 + i] * lam[96 + i]; }
  const float lam_init = 0.8f - 0.6f * expf(-0.3f * (float)(l + 1));
  const float lam_full = expf(d0) - expf(d1) + lam_init;
  bool prefer_scan = false, sdone = !do_scan, t0done = false;
  if (tid == 0) {
    const unsigned xcc = (unsigned)__builtin_amdgcn_s_getreg((3 << 11) | 20) & 0xFu;
    const unsigned cu = (unsigned)__builtin_amdgcn_s_getreg((7 << 11) | (8 << 6) | 4) & 0xFFu;
    prefer_scan = (atomicAdd(cucnt + ((xcc << 8) | cu), 1u) == 0u);
  }
  for (;;) {
    __syncthreads();
    if (tid == 0) {
      int code = -1;
      if (do_scan && !t0done) { const unsigned u = atomicAdd(ctrS + 8, 1u); if (u < 16u) code = NSCAN + NATT + (int)u; else t0done = true; }
      if (code < 0 && prefer_scan && !sdone) { const unsigned u = atomicAdd(ctrS, 1u); if (u < (unsigned)NSCAN) code = (int)u; else sdone = true; }
      if (code < 0 && do_att) { const unsigned u = atomicAdd(ctrA, 1u); if (u < (unsigned)NATT) code = NSCAN + (int)u; }
      if (code < 0 && !sdone) { const unsigned u = atomicAdd(ctrS, 1u); if (u < (unsigned)NSCAN) code = (int)u; else sdone = true; }
      *s_unit = code;
    }
    __syncthreads();
    const int u = *s_unit;
    if (u < 0) break;
    if (u >= NSCAN + NATT) t0_unit(lds, p, l, u - NSCAN - NATT);
    else if (u < NSCAN) scan_unit(lds, p, u);
    else if (u < NSCAN + NMLA) {
      const int v = u - NSCAN, qb = 15 - v / 96, bh = v % 96, b = bh / 6, h = bh - b * 6;
      attn_unit<false>(lds, Qm + (size_t)b * 2048 * 576 + h * 96, Km + (size_t)b * 2048 * 576 + h * 96, 576, (const bf16_t*)(ws + OFF_VTM) + (size_t)bh * 64 * 2048,
                       pA, mixed, pos, qb, h, b * 2048, 0.f, 0.f, nullptr);
    } else {
      const int v = u - NSCAN - NMLA, qb = 31 - v / 64, bh = v % 64, b = bh >> 2, h = bh & 3;
      attn_unit<true>(lds, pA + (size_t)b * 2048 * LDPA + h * 64, pA + (size_t)b * 2048 * LDPA + 256 + h * 64, LDPA, (const bf16_t*)(ws + OFF_VTD) + (size_t)bh * 64 * 2048,
                      pA, mixed, pos, qb, h, b * 2048, lam_full, lam_init, p.in[11] + l * 64);
    }
  }
}

struct GBar { unsigned* w; unsigned x, nloc, nx; };
DI unsigned gb_ld(unsigned* p) { return __hip_atomic_load(p, __ATOMIC_RELAXED, __HIP_MEMORY_SCOPE_AGENT); }
DI unsigned gb_add(unsigned* p) { return __hip_atomic_fetch_add(p, 1u, __ATOMIC_RELAXED, __HIP_MEMORY_SCOPE_AGENT); }
DI void gbar(GBar& B, unsigned nblk) {
  asm volatile("s_waitcnt vmcnt(0)" ::: "memory");
  __syncthreads();
  if (threadIdx.x == 0) {
    unsigned* w = B.w;
    if (B.nloc == 0u) {
      unsigned sum, cnt, mine, sp = 0u;
      for (;;) {
        sum = 0u; cnt = 0u; mine = 0u;
#pragma unroll
        for (unsigned j = 0; j < 16; ++j) { const unsigned c = gb_ld(w + 896 + 4 * j); sum += c; cnt += (c > 0u) ? 1u : 0u; mine = (j == B.x) ? c : mine; }
        if (sum == nblk || ++sp > (1u << 22)) break;
        __builtin_amdgcn_s_sleep(1);
      }
      B.nloc = mine > 0u ? mine : 1u; B.nx = cnt > 0u ? cnt : 1u;
    }
    const unsigned old = gb_add(w + 640 + 8 * B.x), gen = old / B.nloc;
    if (old + 1u == (gen + 1u) * B.nloc) {
      __builtin_amdgcn_fence(__ATOMIC_RELEASE, "agent");
      asm volatile("s_waitcnt vmcnt(0)" ::: "memory");
      const unsigned og = gb_add(w + 960), tg = og / B.nx;
      if (og + 1u == (tg + 1u) * B.nx) (void)gb_add(w + 968);
      else { unsigned sp = 0u; while (gb_ld(w + 968) == tg && ++sp < (1u << 22)) __builtin_amdgcn_s_sleep(1); }
      __builtin_amdgcn_fence(__ATOMIC_ACQUIRE, "agent");
      (void)gb_add(w + 768 + 8 * B.x);
    } else {
      unsigned sp = 0u; while (gb_ld(w + 768 + 8 * B.x) == gen && ++sp < (1u << 22)) __builtin_amdgcn_s_sleep(1);
      __builtin_amdgcn_fence(__ATOMIC_ACQUIRE, "agent");
    }
    asm volatile("s_waitcnt vmcnt(0)" ::: "memory");
  }
  __syncthreads();
}

__global__ void __launch_bounds__(NTH, 2) mk_fwd(KP p) {
  extern __shared__ __attribute__((aligned(16))) unsigned char lds[];
  int& s_unit = *(int*)(lds + 73728 + 1024);
  cg::grid_group grid = cg::this_grid();
  unsigned char* ws = p.ws;
  const int tid = otid(), lane = tid & 63, w = tid >> 6;
  const int G = gridDim.x, bid = blockIdx.x;
#define RUN(k) (p.ph_lo <= (k) && (k) < p.ph_hi)
  GBar gb; gb.w = (unsigned*)(ws + OFF_CTL); gb.x = (unsigned)__builtin_amdgcn_s_getreg((3 << 11) | 20) & 0xFu; gb.nloc = 0u; gb.nx = 0u;
  if (tid == 0 && p.ph_hi - p.ph_lo > 1) (void)gb_add(gb.w + 896 + 4 * gb.x);
#define SEAM(k) do { if (RUN(k) && RUN((k) + 1)) gbar(gb, (unsigned)G); } while (0)
  if (p.ph_lo < 0) grid.sync();

  if (RUN(0)) {
    const int gt = bid * NTH + tid, ngt = G * NTH;
    for (int i = gt; i < 3 * 4096; i += ngt) ((unsigned*)(ws + OFF_CU))[i] = 0u;
    for (int l = 0; l < 2; ++l) {
      bf16_t* Wc = (bf16_t*)(ws + OFF_WC + l * SZ_WC);
      if (l == 0) convT(p.in[3], 1024, 3488, Wc, 1024, NP, nullptr, gt, ngt);
      else { convT(p.in[3] + (size_t)1024 * 3488, 1024, 3488, Wc, 1024, 3488, nullptr, gt, ngt); convT(p.in[4], 1024, 32, Wc + (size_t)3488 * 1024, 1024, 96, nullptr, gt, ngt); }
      convT(p.in[5] + (size_t)l * 1024 * 1024, 1024, 1024, (bf16_t*)(ws + OFF_WO + l * SZ_WO), 1024, 1024, nullptr, gt, ngt);
      convT(p.in[8] + (size_t)l * 256 * 576, 256, 576, (bf16_t*)(ws + OFF_WUQ + l * SZ_WUQ), 256, 640, p.in[6] + l * 256, gt, ngt);
      convT(p.in[9] + (size_t)l * 128 * 768, 128, 768, (bf16_t*)(ws + OFF_WUKV + l * SZ_WUKV), 128, 768, p.in[7] + l * 128, gt, ngt);
      convT(p.in[15] + (size_t)l * 64 * 384, 64, 384, (bf16_t*)(ws + OFF_W2 + l * SZ_L), 64, 384, nullptr, gt, ngt);
      convT(p.in[17] + (size_t)l * 64 * 384, 64, 384, (bf16_t*)(ws + OFF_A2 + l * SZ_L), 64, 384, nullptr, gt, ngt);
    }
    convT(p.in[19], 32, 384, (bf16_t*)(ws + OFF_V2), 64, 384, nullptr, gt, ngt);
    {
      float* tab = (float*)(ws + OFF_TAB); const int* pos = (const int*)p.in[1];
      for (int idx = gt; idx < 2048 * 16; idx += ngt) {
        const int s = idx >> 4, i = idx & 15;
        const float inv = exp2f(-(float)i * (13.287712379549449f / 16.f));
        const float ang = (float)pos[s] * inv;
        double rev = (double)ang * 0.15915494309189535; rev -= __builtin_rint(rev);
        tab[s * 32 + i] = __builtin_amdgcn_cosf((float)rev); tab[s * 32 + 16 + i] = __builtin_amdgcn_sinf((float)rev);
      }
    }
    norm_rows_bf16(p.in[0], p.in[2], (bf16_t*)(ws + OFF_R1), 0, T, bid * 4 + w, G * 4, lane);
  }
  SEAM(0);
#if PROBE == 8
  for (int i = 0; i < 10; ++i) grid.sync();
#endif
#if PROBE == 6
  if (RUN(0)) { norm_rows_bf16(p.in[0], p.in[2], (bf16_t*)(ws + OFF_R1), 0, T, bid * 4 + w, G * 4, lane); grid.sync(); }
#endif
  for (int l = 0; l < 2; ++l) {
    const int pb = 1 + 4 * l;
    if (RUN(pb)) {
      EpiRoute e{(bf16_t*)(ws + OFF_PA), (bf16_t*)(ws + OFF_R2), (bf16_t*)(ws + OFF_VTD), l ? 3520 : 3488};
      const bf16_t* hb = (const bf16_t*)(ws + OFF_R1); const bf16_t* Wc = (const bf16_t*)(ws + OFF_WC + l * SZ_WC);
      for (int rep = 0; rep < ((PROBE == 1 && l == 0) ? 2 : 1); ++rep)
      for (int u = bid; u < 256 * 28; u += G) { const int rt = u / 28, ct = u - rt * 28; gemm_tile<4>(lds, hb, 1024, Wc, 1024, 1024, rt * 128, ct * 128, e); }
    }
    SEAM(pb);
    if (RUN(pb + 1)) { for (int rt = bid; rt < 512; rt += G) p2_unit(lds, p, l, rt);
#if PROBE == 13
      if (l == 0) { gbar((unsigned*)(ws + OFF_CTL) + 512, (unsigned)G); for (int rt = bid; rt < 512; rt += G) p2_unit(lds, p, l, rt, 2, true); }
#elif PROBE == 15
      if (l == 0) { gbar((unsigned*)(ws + OFF_CTL) + 512, (unsigned)G); for (int rt = bid; rt < 512; rt += G) p2_unit(lds, p, l, rt, 8, true); }
#elif PROBE == 14
      if (l == 0) { gbar((unsigned*)(ws + OFF_CTL) + 512, (unsigned)G); for (int rt = bid; rt < 512; rt += G) p2_unit(lds, p, l, rt, 4, false); }
#endif
    }
    SEAM(pb + 1);
    if (RUN(pb + 2)) {
      p3_run(lds, &s_unit, p, l, l, true, true);
#if PROBE == 3
      if (l == 0) { grid.sync(); p3_run(lds, &s_unit, p, l, 2, true, false); }
#elif PROBE == 9
      if (l == 0) { grid.sync(); p3_run(lds, &s_unit, p, l, 2, true, true); }
#elif PROBE == 10
      if (l == 0) { grid.sync(); p3_run(lds, &s_unit, p, l, 2, false, true); }
#endif
    }
    SEAM(pb + 2);
    if (RUN(pb + 3)) { for (int rep = 0; rep < ((PROBE == 5 && l == 0) ? 2 : 1); ++rep) { if (rep) grid.sync(); for (int rt = bid; rt < 512; rt += G) p4_unit(lds, p, l, rt); } }
    SEAM(pb + 3);
  }
#undef RUN
#undef SEAM
}

extern "C" void kernel_launch(void* const* d_in, const int* in_sizes, int n_in, void* d_out, int out_size, void* d_ws, size_t ws_size, hipStream_t stream) {
  static int grid = 0;
  if (grid == 0) {
    if (n_in != 26 || ws_size < WS_END) { fprintf(stderr, "kernel_launch: need 26 inputs and %zu bytes of workspace (got %d, %zu)\n", (size_t)WS_END, n_in, ws_size); grid = -1; return; }
    int dev = 0, cus = 0, per_cu = 0;
    (void)hipGetDevice(&dev);
    (void)hipDeviceGetAttribute(&cus, hipDeviceAttributeMultiprocessorCount, dev);
    (void)hipFuncSetAttribute((const void*)mk_fwd, hipFuncAttributeMaxDynamicSharedMemorySize, LDS_BYTES);
    (void)hipOccupancyMaxActiveBlocksPerMultiprocessor(&per_cu, (const void*)mk_fwd, NTH, LDS_BYTES);
    if (per_cu > 2) per_cu = 2;
    if (per_cu < 1) { fprintf(stderr, "kernel_launch: occupancy query returned %d\n", per_cu); per_cu = 1; }
    grid = cus * per_cu;
  }
  if (grid < 0) return;
  (void)hipMemsetAsync(d_ws, 0, 4096, stream);
  KP p{};
  for (int i = 0; i < 26; ++i) p.in[i] = (const float*)d_in[i];
  p.out = (float*)d_out; p.ws = (unsigned char*)d_ws;
  if (MK_LAUNCHES == 1) {
    p.ph_lo = 0; p.ph_hi = NPHASE;
    void* args[] = {&p};
    hipError_t e = hipLaunchCooperativeKernel((const void*)mk_fwd, dim3(grid), dim3(NTH), args, LDS_BYTES, stream);
    if (e != hipSuccess) fprintf(stderr, "cooperative launch failed: %s (grid %d)\n", hipGetErrorString(e), grid);
  } else {
    for (int k = 0; k < NPHASE; ++k) { p.ph_lo = k; p.ph_hi = k + 1; hipLaunchKernelGGL(mk_fwd, dim3(grid), dim3(NTH), LDS_BYTES, stream, p); }
  }
}
```

```cpp
#include <hip/hip_runtime.h>
#include <hip/hip_cooperative_groups.h>
#include <cstdio>
#include <cstdint>
namespace cg = cooperative_groups;

#ifndef PROBE
#define PROBE 0
#endif
#ifndef MK_LAUNCHES
#define MK_LAUNCHES 1
#endif

typedef unsigned short bf16_t;
typedef short bf16x8 __attribute__((ext_vector_type(8)));
typedef float f32x4 __attribute__((ext_vector_type(4)));
#define DI __device__ __forceinline__

constexpr int NB = 16, SEQ = 2048, T = NB * SEQ, DM = 1024;
constexpr int NP = 3584;
constexpr int LDPA = 1536;
constexpr int LDPB = 1728;
constexpr int NPHASE = 9;
constexpr int LDS_BYTES = 73728 + 1024 + 1024;
constexpr int NTH = 256;
constexpr int NSCAN = 192, NMLA = 96 * 16, NDIFF = 64 * 32, NATT = NMLA + NDIFF;

constexpr size_t OFF_CTL = 0;
constexpr size_t OFF_TAB = 4096;
constexpr size_t SZ_WC = (size_t)NP * 1024 * 2;
constexpr size_t OFF_WC = OFF_TAB + 262144;
constexpr size_t SZ_WO = (size_t)1024 * 1024 * 2;
constexpr size_t OFF_WO = OFF_WC + 2 * SZ_WC;
constexpr size_t SZ_WUQ = (size_t)640 * 256 * 2;
constexpr size_t OFF_WUQ = OFF_WO + 2 * SZ_WO;
constexpr size_t SZ_WUKV = (size_t)768 * 128 * 2;
constexpr size_t OFF_WUKV = OFF_WUQ + 2 * SZ_WUQ;
constexpr size_t SZ_L = (size_t)384 * 64 * 2;
constexpr size_t OFF_W2 = OFF_WUKV + 2 * SZ_WUKV;
constexpr size_t OFF_A2 = OFF_W2 + 2 * SZ_L;
constexpr size_t OFF_V2 = OFF_A2 + 2 * SZ_L;
constexpr size_t OFF_R1 = OFF_V2 + SZ_L;
constexpr size_t SZ_QK = (size_t)T * 576 * 2;
constexpr size_t OFF_PA = OFF_R1 + 2 * SZ_QK;
constexpr size_t OFF_R2 = OFF_PA + (size_t)T * LDPA * 2;
constexpr size_t SZ_Y = (size_t)T * 384 * 4;
constexpr size_t OFF_MIX = OFF_R2 + SZ_Y;
constexpr size_t OFF_VTM = OFF_MIX + (size_t)T * 1024 * 2;
static_assert(OFF_MIX + (size_t)T * 1024 * 2 >= OFF_R2 + (size_t)T * LDPB * 2, "R2 holds projB");
constexpr size_t OFF_VTD = OFF_VTM + (size_t)T * 384 * 2;
constexpr size_t SZ_SC = (size_t)T * 384 * 2;
constexpr size_t OFF_SC = OFF_VTD + (size_t)T * 256 * 2;
constexpr size_t OFF_LA = OFF_SC + 6 * SZ_SC;
constexpr size_t OFF_CU = OFF_LA + (size_t)T * 192 * 2;
constexpr size_t OFF_T0 = OFF_CU + 3 * 4096 * 4;
constexpr size_t WS_END = OFF_T0 + 3 * 16 * 384 * 4;
static_assert(OFF_R1 % 256 == 0, "align");

struct KP { const float* in[26]; float* out; unsigned char* ws; int ph_lo, ph_hi; };

DI unsigned f2bf(float f) { unsigned u = __float_as_uint(f); return (u + 0x7fffu + ((u >> 16) & 1u)) >> 16; }
DI float bf2f(bf16_t h) { return __uint_as_float(((unsigned)h) << 16); }
typedef __bf16 bf2v_t __attribute__((ext_vector_type(2)));
typedef float f2v_t __attribute__((ext_vector_type(2)));
DI unsigned pk2(float a, float b) { f2v_t f = {a, b}; return __builtin_bit_cast(unsigned, __builtin_convertvector(f, bf2v_t)); }
DI void store4bf(bf16_t* p, f32x4 v) { uint2 u; u.x = pk2(v[0], v[1]); u.y = pk2(v[2], v[3]); *(uint2*)p = u; }
DI f32x4 up4(uint2 u) { f32x4 r; r[0] = __uint_as_float(u.x << 16); r[1] = __uint_as_float(u.x & 0xffff0000u); r[2] = __uint_as_float(u.y << 16); r[3] = __uint_as_float(u.y & 0xffff0000u); return r; }
DI f32x4 load4bf(const bf16_t* p) { return up4(*(const uint2*)p); }
DI float ex2(float x) { return __builtin_amdgcn_exp2f(x); }
DI float fexp(float x) { return __builtin_amdgcn_exp2f(x * 1.4426950408889634f); }
DI float sigm(float x) { return 1.f / (1.f + fexp(-x)); }
DI float silu(float x) { return x / (1.f + fexp(-x)); }
template <int CTRL> DI float dppmov(float x) { return __builtin_bit_cast(float, __builtin_amdgcn_update_dpp(0, __builtin_bit_cast(int, x), CTRL, 0xF, 0xF, true)); }
DI float rowsum16(float x) {
  x += dppmov<0xB1>(x);
  x += dppmov<0x4E>(x);
  x += dppmov<0x141>(x);
  x += dppmov<0x140>(x);
  return x;
}
DI int otid() { int t = threadIdx.x; asm volatile("" : "+v"(t)); return t; }
DI void swap16(unsigned& a, unsigned& b) { asm("s_nop 1\n\tv_permlane16_swap_b32 %0, %1" : "+v"(a), "+v"(b)); }
DI void swap32(unsigned& a, unsigned& b) { asm("s_nop 1\n\tv_permlane32_swap_b32 %0, %1" : "+v"(a), "+v"(b)); }
DI float xsum16(float x) { unsigned a = __float_as_uint(x), b = a; swap16(a, b); return __uint_as_float(a) + __uint_as_float(b); }
DI float xsum32(float x) { unsigned a = __float_as_uint(x), b = a; swap32(a, b); return __uint_as_float(a) + __uint_as_float(b); }
DI float xmax16(float x) { unsigned a = __float_as_uint(x), b = a; swap16(a, b); return fmaxf(__uint_as_float(a), __uint_as_float(b)); }
DI float xmax32(float x) { unsigned a = __float_as_uint(x), b = a; swap32(a, b); return fmaxf(__uint_as_float(a), __uint_as_float(b)); }
DI float wave_sum(float v) { return xsum32(xsum16(rowsum16(v))); }
#define MFMA16(a, b, c) __builtin_amdgcn_mfma_f32_16x16x32_bf16((a), (b), (c), 0, 0, 0)

template <int MI, class Epi>
DI void gemm_tile(unsigned char* lds, const bf16_t* __restrict__ A, int lda, const bf16_t* __restrict__ Bt, int ldb, int K, int row0, int col0, const Epi& epi) {
  constexpr int BM = 32 * MI;
  constexpr int BUFE = (BM + 128) * 64;
  bf16_t* sbase = (bf16_t*)lds;
  const int tid = otid(), lane = tid & 63, w = tid >> 6, wm = w >> 1, wn = w & 1, lr = lane & 15, g = lane >> 4;
  const int sr = tid >> 3, skc = tid & 7, swc = (skc ^ (sr & 7)) * 8;
  const int xr = lr & 7;
  const bf16_t* gA = A + (size_t)(row0 + sr) * lda + skc * 8;
  const bf16_t* gB = Bt + (size_t)(col0 + sr) * ldb + skc * 8;
  uint4 ra0, ra1, ra2 = {0u, 0u, 0u, 0u}, ra3 = {0u, 0u, 0u, 0u}, rb0, rb1, rb2, rb3;
#define G_LOAD(k0_) do { ra0 = *(const uint4*)(gA + (k0_)); ra1 = *(const uint4*)(gA + (size_t)32 * lda + (k0_)); \
    if (MI == 4) { ra2 = *(const uint4*)(gA + (size_t)64 * lda + (k0_)); ra3 = *(const uint4*)(gA + (size_t)96 * lda + (k0_)); } \
    rb0 = *(const uint4*)(gB + (k0_)); rb1 = *(const uint4*)(gB + (size_t)32 * ldb + (k0_)); rb2 = *(const uint4*)(gB + (size_t)64 * ldb + (k0_)); rb3 = *(const uint4*)(gB + (size_t)96 * ldb + (k0_)); } while (0)
#define G_STORE(buf_) do { bf16_t* sA_ = sbase + (buf_) * BUFE + sr * 64 + swc; bf16_t* sB_ = sA_ + BM * 64; \
    *(uint4*)(sA_) = ra0; *(uint4*)(sA_ + 32 * 64) = ra1; \
    if (MI == 4) { *(uint4*)(sA_ + 64 * 64) = ra2; *(uint4*)(sA_ + 96 * 64) = ra3; } \
    *(uint4*)(sB_) = rb0; *(uint4*)(sB_ + 32 * 64) = rb1; *(uint4*)(sB_ + 64 * 64) = rb2; *(uint4*)(sB_ + 96 * 64) = rb3; } while (0)
  f32x4 acc[MI][4];
#pragma unroll
  for (int mi = 0; mi < MI; ++mi)
#pragma unroll
    for (int ni = 0; ni < 4; ++ni) acc[mi][ni] = (f32x4){0.f, 0.f, 0.f, 0.f};
  const int nk = K >> 6;
  G_LOAD(0);
  G_STORE(0);
  if (nk > 1) G_LOAD(64);
  __syncthreads();
  for (int kt = 0; kt < nk; ++kt) {
    const int cur = kt & 1;
    if (kt + 1 < nk) { G_STORE(cur ^ 1); if (kt + 2 < nk) G_LOAD((kt + 2) * 64); }
    const bf16_t* sA = sbase + cur * BUFE; const bf16_t* sB = sA + BM * 64;
#pragma unroll
    for (int ks = 0; ks < 2; ++ks) {
      bf16x8 af[MI], bfr[4];
#pragma unroll
      for (int mi = 0; mi < MI; ++mi) af[mi] = *(const bf16x8*)(sA + (wm * 16 * MI + mi * 16 + lr) * 64 + ((ks * 4 + g) ^ xr) * 8);
#pragma unroll
      for (int ni = 0; ni < 4; ++ni) bfr[ni] = *(const bf16x8*)(sB + (wn * 64 + ni * 16 + lr) * 64 + ((ks * 4 + g) ^ xr) * 8);
      __builtin_amdgcn_s_setprio(1);
#pragma unroll
      for (int mi = 0; mi < MI; ++mi)
#pragma unroll
        for (int ni = 0; ni < 4; ++ni) acc[mi][ni] = MFMA16(bfr[ni], af[mi], acc[mi][ni]);
      __builtin_amdgcn_s_setprio(0);
    }
    __syncthreads();
  }
#undef G_STORE
#pragma unroll
  for (int mi = 0; mi < MI; ++mi)
#pragma unroll
    for (int ni = 0; ni < 4; ++ni) epi(row0 + wm * 16 * MI + mi * 16 + lr, col0 + wn * 64 + ni * 16 + 4 * g, acc[mi][ni]);
#undef G_LOAD
}

struct EpiRoute {
  bf16_t* pA; bf16_t* pB; bf16_t* VtD; int ncols;
  DI void operator()(int row, int col, f32x4 v) const {
    if (col >= ncols) return;
    if (col < 416) store4bf(pB + (size_t)row * LDPB + col, v);
    else if (col < 928) store4bf(pA + (size_t)row * LDPA + (col - 416), v);
    else if (col < 1184) {
      const int c = col - 928, h = c >> 6, dv = c & 63, b = row >> 11, s = row & 2047;
      bf16_t* q = VtD + ((size_t)((b * 4 + h) * 64 + dv)) * 2048 + s;
      q[0] = (bf16_t)f2bf(v[0]); q[2048] = (bf16_t)f2bf(v[1]); q[4096] = (bf16_t)f2bf(v[2]); q[6144] = (bf16_t)f2bf(v[3]);
    }
    else if (col < 2208) store4bf(pA + (size_t)row * LDPA + 512 + (col - 1184), v);
    else store4bf(pB + (size_t)row * LDPB + 416 + (col - 2208), v);
  }
};
struct EpiQ {
  bf16_t* __restrict__ Qm; const float* __restrict__ rs; int row0;
  DI void operator()(int row, int col, f32x4 v) const {
    if (col >= 576) return;
    const float r = rs[row - row0]; v = v * r;
    store4bf(Qm + (size_t)row * 576 + col, v);
  }
};
struct EpiKV {
  bf16_t* __restrict__ Km; bf16_t* __restrict__ VtM; const float* __restrict__ rs; int row0;
  DI void operator()(int row, int col, f32x4 v) const {
    const float r = rs[row - row0]; v = v * r;
    const int head = col >> 7, c = col & 127;
    if (c < 64) store4bf(Km + (size_t)row * 576 + head * 96 + c, v);
    else {
      const int b = row >> 11, s = row & 2047;
      bf16_t* q = VtM + ((size_t)((b * 6 + head) * 64 + (c - 64))) * 2048 + s;
      q[0] = (bf16_t)f2bf(v[0]); q[2048] = (bf16_t)f2bf(v[1]); q[4096] = (bf16_t)f2bf(v[2]); q[6144] = (bf16_t)f2bf(v[3]);
    }
  }
};
struct EpiW {
  bf16_t* __restrict__ wbuf; const float* __restrict__ w0;
  DI void operator()(int row, int col, f32x4 v) const {
    f32x4 o;
#pragma unroll
    for (int i = 0; i < 4; ++i) { const float val = v[i] + w0[col + i]; const float wv = -__logf(1.f + fexp(-val)) - 0.5f; o[i] = -fexp(wv); }
    store4bf(wbuf + (size_t)row * 384 + col, o);
  }
};
struct EpiA {
  bf16_t* __restrict__ abuf; bf16_t* __restrict__ kbuf; const bf16_t* __restrict__ kraw; const float* __restrict__ a0; const float* __restrict__ ka;
  DI void operator()(int row, int col, f32x4 v) const {
    f32x4 kr = load4bf(kraw + (size_t)row * 384 + col), a, kn;
#pragma unroll
    for (int i = 0; i < 4; ++i) { a[i] = sigm(v[i] + a0[col + i]); kn[i] = kr[i] * (1.f + (a[i] - 1.f) * ka[col + i]); }
    store4bf(abuf + (size_t)row * 384 + col, a);
    store4bf(kbuf + (size_t)row * 384 + col, kn);
  }
};
struct EpiV {
  bf16_t* vbuf; const bf16_t* pB; const float* v0; const float* mu;
  DI void operator()(int row, int col, f32x4 v) const {
    const int s = row & 2047;
    const bf16_t* pc = pB + (size_t)row * LDPB + 416 + 768 + col;
    f32x4 p = load4bf(pc), pr = load4bf(s > 0 ? pc - LDPB : pc);
    if (s == 0) pr = (f32x4){0.f, 0.f, 0.f, 0.f};
    f32x4 vf = load4bf(vbuf + (size_t)row * 384 + col), o;
#pragma unroll
    for (int i = 0; i < 4; ++i) { const float xv = p[i] + (pr[i] - p[i]) * mu[768 + col + i]; const float sg = sigm(v[i] + v0[col + i]); o[i] = xv + (vf[i] - xv) * sg; }
    store4bf(vbuf + (size_t)row * 384 + col, o);
  }
};
struct EpiOut {
  const float* xin; float* xout;
  DI void operator()(int row, int col, f32x4 v) const {
    const f32x4 x = *(const f32x4*)(xin + (size_t)row * 1024 + col);
    *(f32x4*)(xout + (size_t)row * 1024 + col) = x + v;
  }
};

DI void convT(const float* __restrict__ src, int K, int N, bf16_t* dst, int Kpad, int NR, const float* scale, int gt, int ngt) {
  const int kcN = Kpad >> 3, total = NR * kcN;
  for (int idx = gt; idx < total; idx += ngt) {
    const int n = idx % NR, kc = idx / NR; uint4 o = {0u, 0u, 0u, 0u};
    if (n < N) {
      float v[8];
#pragma unroll
      for (int j = 0; j < 8; ++j) { const int k = kc * 8 + j; v[j] = (k < K) ? src[(size_t)k * N + n] * (scale ? scale[k] : 1.f) : 0.f; }
      o.x = pk2(v[0], v[1]); o.y = pk2(v[2], v[3]); o.z = pk2(v[4], v[5]); o.w = pk2(v[6], v[7]);
    }
    *(uint4*)(dst + (size_t)n * Kpad + kc * 8) = o;
  }
}
DI void norm_rows_bf16(const float* x, const float* gain, bf16_t* hb, int rbeg, int rend, int gw, int ngw, int lane) {
  for (int row = rbeg + gw; row < rend; row += ngw) {
    const f32x4* xr = (const f32x4*)(x + (size_t)row * 1024) + lane;
    f32x4 v[4]; float s = 0.f;
#pragma unroll
    for (int j = 0; j < 4; ++j) { v[j] = xr[64 * j]; s += v[j][0] * v[j][0] + v[j][1] * v[j][1] + v[j][2] * v[j][2] + v[j][3] * v[j][3]; }
    const float rstd = 1.f / sqrtf(wave_sum(s) * (1.f / 1024.f) + 1e-6f);
#pragma unroll
    for (int j = 0; j < 4; ++j) { const f32x4 gg = *((const f32x4*)gain + lane + 64 * j); store4bf(hb + (size_t)row * 1024 + 4 * lane + 256 * j, v[j] * rstd * gg); }
  }
}

DI void norm_rows2_bf16(const float* x, const float* gain, bf16_t* hb, int nrows, int gw, int ngw, int lane) {
  for (int row = gw; row < nrows; row += 2 * ngw) {
    const int row2 = row + ngw; const bool two = row2 < nrows;
    const f32x4* xr = (const f32x4*)(x + (size_t)row * 1024) + lane;
    const f32x4* xq = (const f32x4*)(x + (size_t)(two ? row2 : row) * 1024) + lane;
    f32x4 v[4], u[4]; float s = 0.f, t = 0.f;
#pragma unroll
    for (int j = 0; j < 4; ++j) { v[j] = xr[64 * j]; u[j] = xq[64 * j]; }
#pragma unroll
    for (int j = 0; j < 4; ++j) { s += v[j][0] * v[j][0] + v[j][1] * v[j][1] + v[j][2] * v[j][2] + v[j][3] * v[j][3]; t += u[j][0] * u[j][0] + u[j][1] * u[j][1] + u[j][2] * u[j][2] + u[j][3] * u[j][3]; }
    const float rstd = 1.f / sqrtf(wave_sum(s) * (1.f / 1024.f) + 1e-6f), rstd2 = 1.f / sqrtf(wave_sum(t) * (1.f / 1024.f) + 1e-6f);
#pragma unroll
    for (int j = 0; j < 4; ++j) {
      const f32x4 gg = *((const f32x4*)gain + lane + 64 * j);
      store4bf(hb + (size_t)row * 1024 + 4 * lane + 256 * j, v[j] * rstd * gg);
      if (two) store4bf(hb + (size_t)row2 * 1024 + 4 * lane + 256 * j, u[j] * rstd2 * gg);
    }
  }
}

DI void p2_unit(unsigned char* lds, const KP& p, int l, int rt, int parts = 15, bool dummy = false) {
  unsigned char* ws = p.ws;
  const int tid = otid(), lane = tid & 63, w = tid >> 6, row0 = rt * 64;
  bf16_t* pB = (bf16_t*)(ws + OFF_R2);
  bf16_t* Qm = (bf16_t*)(ws + OFF_R1); bf16_t* Km = Qm + (size_t)T * 576;
  bf16_t* VtM = (bf16_t*)(ws + OFF_VTM);
  bf16_t* rbuf = (bf16_t*)(ws + OFF_SC); bf16_t* kbuf = rbuf + (size_t)T * 384; bf16_t* vbuf = kbuf + (size_t)T * 384;
  bf16_t* wbuf = vbuf + (size_t)T * 384; bf16_t* kkbuf = wbuf + (size_t)T * 384; bf16_t* abuf = kkbuf + (size_t)T * 384;
  bf16_t* LA = (bf16_t*)(ws + OFF_LA);
  const float* tab = (const float*)(ws + OFF_TAB);
  float* sRq = (float*)(lds + 73728); float* sRkv = sRq + 64;
  __syncthreads();
  if (parts & 1) {
    const int r = tid >> 2, part = tid & 3; const bf16_t* pr = pB + (size_t)(row0 + r) * LDPB;
    float sq = 0.f, sk = 0.f;
#pragma unroll
    for (int j = 0; j < 16; ++j) { f32x4 v = load4bf(pr + part * 64 + j * 4); sq += v[0] * v[0] + v[1] * v[1] + v[2] * v[2] + v[3] * v[3]; }
#pragma unroll
    for (int j = 0; j < 8; ++j) { f32x4 v = load4bf(pr + 256 + part * 32 + j * 4); sk += v[0] * v[0] + v[1] * v[1] + v[2] * v[2] + v[3] * v[3]; }
    sq += dppmov<0xB1>(sq); sq += dppmov<0x4E>(sq); sk += dppmov<0xB1>(sk); sk += dppmov<0x4E>(sk);
    if (part == 0) { sRq[r] = 1.f / sqrtf(sq * (1.f / 256.f) + 1e-6f); sRkv[r] = 1.f / sqrtf(sk * (1.f / 128.f) + 1e-6f); }
  }
  if (dummy) { rbuf = (bf16_t*)p.out; wbuf = rbuf + (size_t)T * 384; kkbuf = wbuf + (size_t)T * 384; vbuf = kkbuf + (size_t)T * 384; }
  if (parts & 2) {
    const float* mu = p.in[12] + l * 1280; const float* kkw = p.in[20] + l * 384;
    float mur[6], muk[6], muv_[6], kkw_[6];
#pragma unroll
    for (int h = 0; h < 6; ++h) { mur[h] = mu[h * 64 + lane]; muk[h] = mu[384 + h * 64 + lane]; muv_[h] = mu[768 + h * 64 + lane]; kkw_[h] = kkw[h * 64 + lane]; }
    for (int t = w; t < 64; t += 4) {
      const int row = row0 + t, s = row & 2047;
      const bf16_t* pc = pB + (size_t)row * LDPB + 416 + lane;
      const bf16_t* pp = (s > 0) ? pc - LDPB : pc;
      const float pm = (s > 0) ? 1.f : 0.f;
      float cr[6], ck[6], cv[6], qr[6], qk[6], qv[6];
#pragma unroll
      for (int h = 0; h < 6; ++h) { cr[h] = bf2f(pc[h * 64]); ck[h] = bf2f(pc[384 + h * 64]); cv[h] = bf2f(pc[768 + h * 64]); qr[h] = bf2f(pp[h * 64]) * pm; qk[h] = bf2f(pp[384 + h * 64]) * pm; qv[h] = bf2f(pp[768 + h * 64]) * pm; }
#pragma unroll
      for (int h = 0; h < 6; ++h) {
        const float xr = cr[h] + (qr[h] - cr[h]) * mur[h], xk = ck[h] + (qk[h] - ck[h]) * muk[h], xv = cv[h] + (qv[h] - cv[h]) * muv_[h];
        const float kv_ = xk * kkw_[h]; const float ss = wave_sum(kv_ * kv_);
        const float kk = kv_ / fmaxf(sqrtf(ss), 1e-12f);
        const size_t o = (size_t)row * 384 + h * 64 + lane;
        rbuf[o] = (bf16_t)f2bf(xr); wbuf[o] = (bf16_t)f2bf(xk); kkbuf[o] = (bf16_t)f2bf(kk);
        if (l == 0) vbuf[o] = (bf16_t)f2bf(xv);
      }
    }
  }
  if (parts & 4) {
    const float* mu = p.in[12] + l * 1280;
    const float* muv = p.in[13];
    f32x4 cur[12], prv[12];
#pragma unroll
    for (int i = 0; i < 12; ++i) {
      const int item = tid + 256 * i, r = item / 48, q = item - r * 48, row = row0 + r, s = row & 2047;
      const int qc = q < 40 ? q : 39;
      const bf16_t* pc = pB + (size_t)row * LDPB + 416 + 1152 + 4 * qc;
      cur[i] = load4bf(pc); prv[i] = load4bf(s > 0 ? pc - LDPB : pc);
    }
#pragma unroll
    for (int i = 0; i < 12; ++i) {
      const int item = tid + 256 * i, r = item / 48, q = item - r * 48, row = row0 + r, s = row & 2047;
      f32x4 o;
#pragma unroll
      for (int e = 0; e < 4; ++e) {
        const int j = 4 * q + e;
        const bool act = (j < 128) || (j < 160 && l > 0);
        const float m = (j < 128) ? mu[1152 + j] : muv[(j < 160 ? j : 159) - 128];
        const float pv = (s > 0) ? prv[i][e] : 0.f;
        float val = cur[i][e] + (pv - cur[i][e]) * m;
        if (j < 64) val = 1.f - 2.f / (fexp(2.f * val) + 1.f);
        o[e] = act ? val : 0.f;
      }
      store4bf(LA + (size_t)row * 192 + 4 * q, o);
    }
  }
  __syncthreads();
  if (parts & 1) {
    const bf16_t* WuqT = (const bf16_t*)(ws + OFF_WUQ + l * SZ_WUQ);
    const bf16_t* WukvT = (const bf16_t*)(ws + OFF_WUKV + l * SZ_WUKV);
    EpiQ eq{Qm, sRq, row0};
    for (int ct = 0; ct < 5; ++ct) gemm_tile<2>(lds, pB, LDPB, WuqT, 256, 256, row0, ct * 128, eq);
    EpiKV ek{Km, VtM, sRkv, row0};
    for (int ct = 0; ct < 6; ++ct) gemm_tile<2>(lds, pB + 256, LDPB, WukvT, 128, 128, row0, ct * 128, ek);
  }
  if (parts & 8) {
    const bf16_t* w2T = (const bf16_t*)(ws + OFF_W2 + l * SZ_L);
    const bf16_t* a2T = (const bf16_t*)(ws + OFF_A2 + l * SZ_L);
    const bf16_t* v2T = (const bf16_t*)(ws + OFF_V2);
    EpiA ea{dummy ? kkbuf : abuf, dummy ? vbuf : kbuf, wbuf, p.in[16] + l * 384, p.in[21] + l * 384};
    for (int ct = 0; ct < 3; ++ct) gemm_tile<2>(lds, LA + 64, 192, a2T, 64, 64, row0, ct * 128, ea);
    __syncthreads();
    EpiW ew{wbuf, p.in[14] + l * 384};
    for (int ct = 0; ct < 3; ++ct) gemm_tile<2>(lds, LA, 192, w2T, 64, 64, row0, ct * 128, ew);
    if (l > 0) {
      EpiV ev{vbuf, pB, p.in[18], p.in[12] + l * 1280};
      for (int ct = 0; ct < 3; ++ct) gemm_tile<2>(lds, LA + 128, 192, v2T, 64, 64, row0, ct * 128, ev);
    }
  }
  __syncthreads();
  if (parts & 1) {
    for (int idx = tid; idx < 64 * 16; idx += NTH) {
      const int r = idx >> 4, i = idx & 15, row = row0 + r, s = row & 2047;
      const float c = tab[s * 32 + i], sn = tab[s * 32 + 16 + i];
      bf16_t* q = Qm + (size_t)row * 576 + 64;
#pragma unroll
      for (int h = 0; h < 6; ++h) { const float t1 = bf2f(q[h * 96 + i]), t2 = bf2f(q[h * 96 + 16 + i]); q[h * 96 + i] = (bf16_t)f2bf(t1 * c - t2 * sn); q[h * 96 + 16 + i] = (bf16_t)f2bf(t1 * sn + t2 * c); }
      const float k1 = bf2f(pB[(size_t)row * LDPB + 384 + i]), k2 = bf2f(pB[(size_t)row * LDPB + 400 + i]);
      const bf16_t o1 = (bf16_t)f2bf(k1 * c - k2 * sn), o2 = (bf16_t)f2bf(k1 * sn + k2 * c);
      bf16_t* kq = Km + (size_t)row * 576 + 64;
#pragma unroll
      for (int h = 0; h < 6; ++h) { kq[h * 96 + i] = o1; kq[h * 96 + 16 + i] = o2; }
    }
  }
}

struct ScanOps { f32x4 w, k, a, b, r; f2v_t v, bk; };
DI void scan_unit(unsigned char* lds, const KP& p, int unit) {
  unsigned char* ws = p.ws;
  float* sm = (float*)lds;
  const int tid = otid(), lane = tid & 63, w16 = tid >> 6, rg = lane >> 4, cg_ = lane & 15;
  const int hid = unit >> 1, half = unit & 1, b = hid / 6, h = hid - b * 6;
  const bf16_t* rbuf = (const bf16_t*)(ws + OFF_SC); const bf16_t* kbuf = rbuf + (size_t)T * 384; const bf16_t* vbuf = kbuf + (size_t)T * 384;
  const bf16_t* wbuf = vbuf + (size_t)T * 384; const bf16_t* kkbuf = wbuf + (size_t)T * 384; const bf16_t* abuf = kkbuf + (size_t)T * 384;
  float* ybuf = (float*)(ws + OFF_R2);
  const int st = tid >> 4, sp = tid & 15;
  const size_t gbase = ((size_t)b * 2048) * 384 + h * 64 + sp * 4;
  uint2 qw, qk, qkk, qa, qr, qv;
#define SCAN_LOAD(t0) do { const size_t o_ = gbase + (size_t)((t0) + st) * 384; qw = *(const uint2*)(wbuf + o_); qk = *(const uint2*)(kbuf + o_); qkk = *(const uint2*)(kkbuf + o_); \
    qa = *(const uint2*)(abuf + o_); qr = *(const uint2*)(rbuf + o_); qv = *(const uint2*)(vbuf + o_); } while (0)
  f2v_t P0 = {0.f, 0.f}, P1 = {0.f, 0.f}, P2 = {0.f, 0.f}, P3 = {0.f, 0.f};
  SCAN_LOAD(0);
  const int rowoff = half * 32 + w16 * 8 + rg * 2;
  float* yout = ybuf + ((size_t)b * 2048) * 384 + h * 64 + rowoff;
  float* ypw = sm + 16 * 400 + w16 * (64 * 40);
  __builtin_amdgcn_s_setprio(3);
  for (int ch = 0; ch < 128; ++ch) {
    __syncthreads();
    {
      float* d = sm + st * 400 + sp * 4;
      const f32x4 fw = up4(qw), fk = up4(qk), fkk = up4(qkk), fa = up4(qa), fr = up4(qr), fv = up4(qv);
      f32x4 dec;
#pragma unroll
      for (int i = 0; i < 4; ++i) dec[i] = fexp(fw[i]);
      const f32x4 bp = fkk * fa;
      float be = bp[0] * fr[0] + bp[1] * fr[1] + bp[2] * fr[2] + bp[3] * fr[3];
      float ka = fk[0] * fr[0] + fk[1] * fr[1] + fk[2] * fr[2] + fk[3] * fr[3];
      be = rowsum16(be); ka = rowsum16(ka);
      *(f32x4*)(d) = dec; *(f32x4*)(d + 64) = fk; *(f32x4*)(d + 128) = -fkk; *(f32x4*)(d + 192) = bp; *(f32x4*)(d + 256) = dec * fr; *(f32x4*)(d + 320) = fv;
      if (sp == 0) { sm[st * 400 + 384] = be; sm[st * 400 + 385] = ka; }
    }
    __syncthreads();
    if (ch + 1 < 128) SCAN_LOAD((ch + 1) * 16);
#define SCAN_OPS(D, t_) do { const float* q_ = sm + (t_) * 400; D.w = *(const f32x4*)(q_ + 4 * cg_); D.k = *(const f32x4*)(q_ + 64 + 4 * cg_); D.a = *(const f32x4*)(q_ + 128 + 4 * cg_); \
      D.b = *(const f32x4*)(q_ + 192 + 4 * cg_); D.r = *(const f32x4*)(q_ + 256 + 4 * cg_); D.v = *(const f2v_t*)(q_ + 320 + rowoff); D.bk = *(const f2v_t*)(q_ + 384); } while (0)
    ScanOps cur, nxt;
    SCAN_OPS(cur, 0); nxt = cur;
#pragma unroll
    for (int t = 0; t < 16; ++t) {
      if (t < 15) SCAN_OPS(nxt, t + 1);
      asm volatile("" ::: "memory");
      const f32x4 w4 = cur.w, k4 = cur.k, a4 = cur.a, b4 = cur.b, r4 = cur.r; const f2v_t v2 = cur.v, bk = cur.bk;
      const f2v_t sa = (P0 * a4[0] + P1 * a4[1]) + (P2 * a4[2] + P3 * a4[3]);
      const f2v_t yd = (P0 * r4[0] + P1 * r4[1]) + (P2 * r4[2] + P3 * r4[3]);
      const f2v_t pre0 = P0 * w4[0] + v2 * k4[0], pre1 = P1 * w4[1] + v2 * k4[1], pre2 = P2 * w4[2] + v2 * k4[2], pre3 = P3 * w4[3] + v2 * k4[3];
      float sa0 = sa[0], sa1 = sa[1];
#define DPPADD2(x_, y_, CTL) asm("s_nop 1\n\tv_add_f32_dpp %0, %0, %0 " CTL " row_mask:0xf bank_mask:0xf bound_ctrl:1\n\tv_add_f32_dpp %1, %1, %1 " CTL " row_mask:0xf bank_mask:0xf bound_ctrl:1" : "+v"(x_), "+v"(y_))
      DPPADD2(sa0, sa1, "quad_perm:[1,0,3,2]"); DPPADD2(sa0, sa1, "quad_perm:[2,3,0,1]"); DPPADD2(sa0, sa1, "row_half_mirror"); DPPADD2(sa0, sa1, "row_mirror");
      const f2v_t sa2 = {sa0, sa1};
      P0 = sa2 * b4[0] + pre0; P1 = sa2 * b4[1] + pre1; P2 = sa2 * b4[2] + pre2; P3 = sa2 * b4[3] + pre3;
#undef DPPADD2
      const f2v_t fin = sa2 * bk[0] + v2 * bk[1];
      const f2v_t yp = (cg_ == 0) ? (yd + fin) : yd;
      *(f2v_t*)(ypw + (t * 4 + rg) * 40 + cg_ * 2) = yp;
      cur = nxt;
    }
#undef SCAN_OPS
    {
      const float* yr = ypw + lane * 40;
      f32x4 a0 = *(const f32x4*)(yr), a1 = *(const f32x4*)(yr + 4), a2 = *(const f32x4*)(yr + 8), a3 = *(const f32x4*)(yr + 12);
      f32x4 a4_ = *(const f32x4*)(yr + 16), a5 = *(const f32x4*)(yr + 20), a6 = *(const f32x4*)(yr + 24), a7 = *(const f32x4*)(yr + 28);
      const f32x4 q = ((a0 + a1) + (a2 + a3)) + ((a4_ + a5) + (a6 + a7));
      const int tt = lane >> 2, rr = lane & 3;
      *(f2v_t*)(ybuf + ((size_t)b * 2048 + ch * 16 + tt) * 384 + h * 64 + half * 32 + w16 * 8 + rr * 2) = (f2v_t){q[0] + q[2], q[1] + q[3]};
    }
  }
  __builtin_amdgcn_s_setprio(0);
#undef SCAN_LOAD
}

template <bool DIFF>
DI void attn_unit(unsigned char* lds, const bf16_t* __restrict__ Qb, const bf16_t* __restrict__ Kb, int ld, const bf16_t* __restrict__ Vt,
                  const bf16_t* __restrict__ gate, bf16_t* mixed, const int* __restrict__ pos, int qb, int h, int rowb,
                  float lam_full, float lam_init, const float* __restrict__ gsub) {
  constexpr int KS = DIFF ? 1 : 3, NM = DIFF ? 2 : 1, KW = DIFF ? 80 : 112,
                NQT = DIFF ? 1 : 2, QU = 64 * NQT;
  bf16_t* sK = (bf16_t*)lds; bf16_t* sV = sK + 64 * KW;
  const int tid = otid(), lane = tid & 63, w = tid >> 6, lr = lane & 15, g = lane >> 4;
  const int q0 = qb * QU, qw0 = q0 + 16 * NQT * w;
  bf16x8 qf[NM][NQT][KS];
#pragma unroll
  for (int m = 0; m < NM; ++m)
#pragma unroll
    for (int qt = 0; qt < NQT; ++qt)
#pragma unroll
      for (int ks = 0; ks < KS; ++ks) qf[m][qt][ks] = *(const bf16x8*)(Qb + (size_t)(qw0 + 16 * qt + lr) * ld + m * 32 + ks * 32 + g * 8);
  f32x4 O[NM][4][NQT]; float mrun[NM][NQT], lrun[NM][NQT];
#pragma unroll
  for (int m = 0; m < NM; ++m)
#pragma unroll
    for (int qt = 0; qt < NQT; ++qt) { mrun[m][qt] = -INFINITY; lrun[m][qt] = 0.f;
#pragma unroll
      for (int dt = 0; dt < 4; ++dt) O[m][dt][qt] = (f32x4){0.f, 0.f, 0.f, 0.f}; }
  float posq[2] = {0.f, 0.f};
  if (DIFF) { posq[0] = (float)pos[qw0 + lr]; if (NQT > 1) posq[1] = (float)pos[qw0 + 16 + lr]; }
  const float sc = DIFF ? (0.17677669529663687f * 1.4426950408889634f) : (0.10206207261596575f * 1.4426950408889634f);
  const float slope2 = DIFF ? ex2(-2.f * (float)(h + 1)) * 1.4426950408889634f : 0.f;
  const int nkt = (q0 + QU) / 64;
  const int vr = tid >> 3, vc = tid & 7;
  int kr0, kc0, kr1, kc1, kr2 = 0, kc2 = 0;
  if (DIFF) { kr0 = vr; kc0 = vc; kr1 = vr + 32; kc1 = vc; }
  else { kr0 = tid / 12; kc0 = tid - kr0 * 12; kr1 = (tid + 256) / 12; kc1 = (tid + 256) - kr1 * 12; kr2 = (tid + 512) / 12; kc2 = (tid + 512) - kr2 * 12; }
  uint4 rk0, rk1, rk2 = {0u, 0u, 0u, 0u}, rv0, rv1;
#define ATT_LOAD(j_) do { rk0 = *(const uint4*)(Kb + (size_t)(64 * (j_) + kr0) * ld + kc0 * 8); rk1 = *(const uint4*)(Kb + (size_t)(64 * (j_) + kr1) * ld + kc1 * 8); \
    if (!DIFF) rk2 = *(const uint4*)(Kb + (size_t)(64 * (j_) + kr2) * ld + kc2 * 8); \
    rv0 = *(const uint4*)(Vt + (size_t)vr * 2048 + 64 * (j_) + vc * 8); rv1 = *(const uint4*)(Vt + (size_t)(vr + 32) * 2048 + 64 * (j_) + vc * 8); } while (0)
  ATT_LOAD(0);
  for (int j = 0; j < nkt; ++j) {
    __syncthreads();
    *(uint4*)(sK + kr0 * KW + kc0 * 8) = rk0; *(uint4*)(sK + kr1 * KW + kc1 * 8) = rk1; if (!DIFF) *(uint4*)(sK + kr2 * KW + kc2 * 8) = rk2;
    *(uint4*)(sV + vr * 72 + vc * 8) = rv0; *(uint4*)(sV + (vr + 32) * 72 + vc * 8) = rv1;
    __syncthreads();
    if (j + 1 < nkt) ATT_LOAD(j + 1);
    if (64 * j <= qw0 + 16 * NQT - 1) {
      const bool domask = (64 * j + 63 > qw0);
      int4 pk[4];
      if (DIFF) {
#pragma unroll
        for (int kt = 0; kt < 4; ++kt) pk[kt] = *(const int4*)(pos + 64 * j + 16 * kt + 4 * g);
      }
#pragma unroll
      for (int m = 0; m < NM; ++m) {
        f32x4 s[4][NQT];
#pragma unroll
        for (int kt = 0; kt < 4; ++kt) {
#pragma unroll
          for (int qt = 0; qt < NQT; ++qt) s[kt][qt] = (f32x4){0.f, 0.f, 0.f, 0.f};
#pragma unroll
          for (int ks = 0; ks < KS; ++ks) {
            const bf16x8 kf = *(const bf16x8*)(sK + (16 * kt + lr) * KW + m * 32 + ks * 32 + g * 8);
#pragma unroll
            for (int qt = 0; qt < NQT; ++qt) s[kt][qt] = MFMA16(kf, qf[m][qt][ks], s[kt][qt]);
          }
        }
#pragma unroll
        for (int kt = 0; kt < 4; ++kt)
#pragma unroll
          for (int qt = 0; qt < NQT; ++qt)
#pragma unroll
            for (int i = 0; i < 4; ++i) {
              float v = s[kt][qt][i] * sc;
              if (DIFF) { const int pki = (i == 0) ? pk[kt].x : (i == 1) ? pk[kt].y : (i == 2) ? pk[kt].z : pk[kt].w; v -= slope2 * fabsf(posq[qt] - (float)pki); }
              s[kt][qt][i] = v;
            }
        if (domask) {
#pragma unroll
          for (int kt = 0; kt < 4; ++kt)
#pragma unroll
            for (int qt = 0; qt < NQT; ++qt)
#pragma unroll
              for (int i = 0; i < 4; ++i) if (64 * j + 16 * kt + 4 * g + i > qw0 + 16 * qt + lr) s[kt][qt][i] = -INFINITY;
        }
#pragma unroll
        for (int qt = 0; qt < NQT; ++qt) {
          float mx = -INFINITY;
#pragma unroll
          for (int kt = 0; kt < 4; ++kt)
#pragma unroll
            for (int i = 0; i < 4; ++i) mx = fmaxf(mx, s[kt][qt][i]);
          mx = xmax32(xmax16(mx));
          const float mn = fmaxf(mrun[m][qt], mx), alpha = ex2(mrun[m][qt] - mn); mrun[m][qt] = mn;
          float ls = 0.f;
#pragma unroll
          for (int kt = 0; kt < 4; ++kt)
#pragma unroll
            for (int i = 0; i < 4; ++i) { const float pv = ex2(s[kt][qt][i] - mn); ls += pv; s[kt][qt][i] = pv; }
          lrun[m][qt] = lrun[m][qt] * alpha + ls;
#pragma unroll
          for (int dt = 0; dt < 4; ++dt) O[m][dt][qt] = O[m][dt][qt] * alpha;
        }
#pragma unroll
        for (int s2 = 0; s2 < 2; ++s2) {
          bf16x8 pf[NQT];
#pragma unroll
          for (int qt = 0; qt < NQT; ++qt) {
            uint4 u; u.x = pk2(s[2 * s2][qt][0], s[2 * s2][qt][1]); u.y = pk2(s[2 * s2][qt][2], s[2 * s2][qt][3]);
            u.z = pk2(s[2 * s2 + 1][qt][0], s[2 * s2 + 1][qt][1]); u.w = pk2(s[2 * s2 + 1][qt][2], s[2 * s2 + 1][qt][3]);
            pf[qt] = __builtin_bit_cast(bf16x8, u);
          }
#pragma unroll
          for (int dt = 0; dt < 4; ++dt) {
            const uint2 lo = *(const uint2*)(sV + (16 * dt + lr) * 72 + 32 * s2 + 4 * g), hi = *(const uint2*)(sV + (16 * dt + lr) * 72 + 32 * s2 + 16 + 4 * g);
            uint4 u; u.x = lo.x; u.y = lo.y; u.z = hi.x; u.w = hi.y;
            const bf16x8 vf = __builtin_bit_cast(bf16x8, u);
#pragma unroll
            for (int qt = 0; qt < NQT; ++qt) O[m][dt][qt] = MFMA16(vf, pf[qt], O[m][dt][qt]);
          }
        }
      }
    }
  }
#undef ATT_LOAD
#pragma unroll
  for (int qt = 0; qt < NQT; ++qt) {
    const size_t row = (size_t)rowb + qw0 + 16 * qt + lr;
    float inv[NM];
#pragma unroll
    for (int m = 0; m < NM; ++m) { const float lt = xsum32(xsum16(lrun[m][qt])); inv[m] = 1.f / lt; }
    if (!DIFF) {
#pragma unroll
      for (int dt = 0; dt < 4; ++dt) {
        const int col = h * 64 + 16 * dt + 4 * g;
        const f32x4 gt = load4bf(gate + row * LDPA + 512 + col); f32x4 o = O[0][dt][qt] * inv[0];
#pragma unroll
        for (int i = 0; i < 4; ++i) o[i] *= silu(gt[i]);
        store4bf(mixed + row * 1024 + col, o);
      }
    } else {
      f32x4 o[4]; float ss = 0.f;
#pragma unroll
      for (int dt = 0; dt < 4; ++dt) { o[dt] = O[0][dt][qt] * inv[0] - O[NM - 1][dt][qt] * (lam_full * inv[NM - 1]); ss += o[dt][0] * o[dt][0] + o[dt][1] * o[dt][1] + o[dt][2] * o[dt][2] + o[dt][3] * o[dt][3]; }
      ss = xsum32(xsum16(ss));
      const float rs = (1.f / sqrtf(ss * (1.f / 64.f) + 1e-5f)) * (1.f - lam_init);
#pragma unroll
      for (int dt = 0; dt < 4; ++dt) {
        const int dvc = 16 * dt + 4 * g, col = h * 64 + dvc;
        const f32x4 gs = *(const f32x4*)(gsub + dvc); const f32x4 gt = load4bf(gate + row * LDPA + 512 + 384 + col);
        f32x4 r;
#pragma unroll
        for (int i = 0; i < 4; ++i) r[i] = o[dt][i] * rs * gs[i] * silu(gt[i]);
        store4bf(mixed + row * 1024 + 384 + col, r);
      }
    }
  }
}

DI void p4_unit(unsigned char* lds, const KP& p, int l, int rt) {
  unsigned char* ws = p.ws;
  const int tid = otid(), lane = tid & 63, w = tid >> 6, row0 = rt * 64;
  const bf16_t* rbuf = (const bf16_t*)(ws + OFF_SC); const bf16_t* kbuf = rbuf + (size_t)T * 384; const bf16_t* vbuf = kbuf + (size_t)T * 384;
  const float* ybuf = (const float*)(ws + OFF_R2); bf16_t* mixed = (bf16_t*)(ws + OFF_MIX);
  const bf16_t* pA = (const bf16_t*)(ws + OFF_PA);
  const float* lnw = p.in[23] + l * 384; const float* lnb = p.in[24] + l * 384; const float* rk = p.in[22] + l * 384;
  {
    float lw[6], lb[6], rkk[6];
#pragma unroll
    for (int h = 0; h < 6; ++h) { lw[h] = lnw[h * 64 + lane]; lb[h] = lnb[h * 64 + lane]; rkk[h] = rk[h * 64 + lane]; }
    for (int t = w; t < 64; t += 4) {
      const int row = row0 + t; const size_t o = (size_t)row * 384 + lane;
      float y[6], r[6], k[6], v[6], gt[6];
#pragma unroll
      for (int h = 0; h < 6; ++h) { y[h] = ybuf[o + h * 64]; r[h] = bf2f(rbuf[o + h * 64]); k[h] = bf2f(kbuf[o + h * 64]); v[h] = bf2f(vbuf[o + h * 64]); gt[h] = bf2f(pA[(size_t)row * LDPA + 512 + 640 + h * 64 + lane]); }
#pragma unroll
      for (int h = 0; h < 6; ++h) {
        const float mean = wave_sum(y[h]) * (1.f / 64.f); const float d = y[h] - mean; const float var = wave_sum(d * d) * (1.f / 64.f);
        const float dot = wave_sum(r[h] * k[h] * rkk[h]);
        float outv = d * (1.f / sqrtf(var + 64e-5f)) * lw[h] + lb[h] + dot * v[h];
        if ((row & 2047) == 0) outv = ((const float*)(ws + OFF_T0))[((size_t)l * 16 + (row >> 11)) * 384 + h * 64 + lane];
        mixed[(size_t)row * 1024 + 640 + h * 64 + lane] = (bf16_t)f2bf(outv * silu(gt[h]));
      }
    }
  }
  __syncthreads();
  const bf16_t* WoT = (const bf16_t*)(ws + OFF_WO + l * SZ_WO);
  EpiOut eo{l == 0 ? p.in[0] : p.out, p.out};
  for (int ct = 0; ct < 8; ++ct) gemm_tile<2>(lds, mixed, 1024, WoT, 1024, 1024, row0, ct * 128, eo);
  __syncthreads();
  if (l == 0) norm_rows_bf16(p.out, p.in[2] + 1024, (bf16_t*)(ws + OFF_R1), row0, row0 + 64, w, 4, lane);
  else {
    const float* fg = p.in[25];
    for (int row = row0 + w; row < row0 + 64; row += 4) {
      f32x4* xr = (f32x4*)(p.out + (size_t)row * 1024) + lane;
      f32x4 v[4]; float s = 0.f;
#pragma unroll
      for (int j = 0; j < 4; ++j) { v[j] = xr[64 * j]; s += v[j][0] * v[j][0] + v[j][1] * v[j][1] + v[j][2] * v[j][2] + v[j][3] * v[j][3]; }
      const float rstd = 1.f / sqrtf(wave_sum(s) * (1.f / 1024.f) + 1e-6f);
#pragma unroll
      for (int j = 0; j < 4; ++j) { const f32x4 gg = *((const f32x4*)fg + lane + 64 * j); xr[64 * j] = v[j] * rstd * gg; }
    }
  }
}

DI void t0_unit(unsigned char* lds, const KP& p, int l, int b) {
  unsigned char* ws = p.ws;
  float* hv_ = (float*)lds;
  float* pv = hv_ + 1024;
  float* red = pv + 1280;
  float* kp = red + 8;
  float* vv = kp + 384;
  const int tid = otid(), lane = tid & 63, w = tid >> 6;
  const size_t row = (size_t)b * 2048;
  const float* xr = (l == 0 ? p.in[0] : (const float*)p.out) + row * 1024;
  const float* g = p.in[2] + l * 1024;
  __syncthreads();
  float ss = 0.f;
  for (int k = tid; k < 1024; k += NTH) { const float x = xr[k]; ss += x * x; }
  ss = wave_sum(ss);
  if (lane == 0) red[w] = ss;
  __syncthreads();
  const float rstd = 1.f / sqrtf((red[0] + red[1] + red[2] + red[3]) * (1.f / 1024.f) + 1e-6f);
  for (int k = tid; k < 1024; k += NTH) hv_[k] = xr[k] * rstd * g[k];
  __syncthreads();
  const float* W = p.in[3] + (size_t)l * 1024 * 3488 + 2208;
  const float* Wv = p.in[4];
  const float* mu = p.in[12] + l * 1280; const float* muv = p.in[13];
  const int ncol = l ? 1248 : 1216;
  for (int c0 = tid; c0 < ncol; c0 += NTH) {
    const float* wp; int ldw; float m;
    if (c0 < 1152) { wp = W + c0; ldw = 3488; m = mu[c0]; }
    else if (c0 < 1216) { wp = W + 1216 + (c0 - 1152); ldw = 3488; m = mu[1216 + (c0 - 1152)]; }
    else { wp = Wv + (c0 - 1216); ldw = 32; m = muv[c0 - 1216]; }
    float a0_ = 0.f, a1_ = 0.f, a2_ = 0.f, a3_ = 0.f;
    for (int k = 0; k < 1024; k += 16) {
      float wv[16];
#pragma unroll
      for (int u = 0; u < 16; ++u) wv[u] = wp[(size_t)(k + u) * ldw];
#pragma unroll
      for (int u = 0; u < 16; u += 4) { a0_ += hv_[k + u] * wv[u]; a1_ += hv_[k + u + 1] * wv[u + 1]; a2_ += hv_[k + u + 2] * wv[u + 2]; a3_ += hv_[k + u + 3] * wv[u + 3]; }
    }
    pv[c0] = ((a0_ + a1_) + (a2_ + a3_)) * (1.f - m);
  }
  __syncthreads();
  const float* a2w = p.in[17] + (size_t)l * 64 * 384; const float* a0w = p.in[16] + l * 384; const float* kaw = p.in[21] + l * 384;
  const float* v2w = p.in[19]; const float* v0w = p.in[18];
  for (int j = tid; j < 384; j += NTH) {
    float acc = a0w[j];
    for (int i = 0; i < 64; ++i) acc += pv[1152 + i] * a2w[i * 384 + j];
    const float a = sigm(acc);
    kp[j] = pv[384 + j] * (1.f + (a - 1.f) * kaw[j]);
    float v = pv[768 + j];
    if (l > 0) {
      float av = v0w[j];
      for (int i = 0; i < 32; ++i) av += pv[1216 + i] * v2w[i * 384 + j];
      vv[j] = av;
    } else vv[j] = 0.f;
    pv[768 + j] = v;
  }
  __syncthreads();
  float* t0 = (float*)(ws + OFF_T0) + ((size_t)l * 16 + b) * 384;
  if (l > 0) {
    const float* vfirst = (const float*)(ws + OFF_T0) + 2 * 16 * 384 + (size_t)b * 384;
    for (int j = tid; j < 384; j += NTH) { const float xv = pv[768 + j]; pv[768 + j] = xv + (vfirst[j] - xv) * sigm(vv[j]); }
  } else {
    float* vfirst = (float*)(ws + OFF_T0) + 2 * 16 * 384 + (size_t)b * 384;
    for (int j = tid; j < 384; j += NTH) vfirst[j] = pv[768 + j];
  }
  __syncthreads();
  const float* lnw = p.in[23] + l * 384; const float* lnb = p.in[24] + l * 384; const float* rk = p.in[22] + l * 384;
  for (int h = w; h < 6; h += 4) {
    const int j = h * 64 + lane;
    const float r = pv[j], k = kp[j], v = pv[768 + j];
    const float c = wave_sum(k * r), dot = wave_sum(r * k * rk[j]);
    const float y = v * c;
    const float mean = wave_sum(y) * (1.f / 64.f); const float d = y - mean; const float var = wave_sum(d * d) * (1.f / 64.f);
    t0[j] = d * (1.f / sqrtf(var + 64e-5f)) * lnw[j] + lnb[j] + dot * v;
  }
}

DI void p3_run(unsigned char* lds, int* s_unit, const KP& p, int l, int cslot, bool do_scan, bool do_att) {
  unsigned char* ws = p.ws;
  const int tid = otid();
  unsigned* ctrS = (unsigned*)(ws + OFF_CTL) + 16 * (2 * cslot + 1);
  unsigned* ctrA = (unsigned*)(ws + OFF_CTL) + 16 * (2 * cslot + 2);
  unsigned* cucnt = (unsigned*)(ws + OFF_CU) + 4096 * cslot;
  const bf16_t* pA = (const bf16_t*)(ws + OFF_PA);
  const bf16_t* Qm = (const bf16_t*)(ws + OFF_R1); const bf16_t* Km = Qm + (size_t)T * 576;
  bf16_t* mixed = (bf16_t*)(ws + OFF_MIX);
  const int* pos = (const int*)p.in[1];
  const float* lam = p.in[10] + l * 128;
  float d0 = 0.f, d1 = 0.f;
  for (int i = 0; i < 32; ++i) { d0 += lam[i] * lam[32 + i]; d1 += lam[64 + i] * lam[96 + i]; }
  const float lam_init = 0.8f - 0.6f * expf(-0.3f * (float)(l + 1));
  const float lam_full = expf(d0) - expf(d1) + lam_init;
  bool prefer_scan = false, sdone = !do_scan, t0done = false;
  if (tid == 0) {
    const unsigned xcc = (unsigned)__builtin_amdgcn_s_getreg((3 << 11) | 20) & 0xFu;
    const unsigned cu = (unsigned)__builtin_amdgcn_s_getreg((7 << 11) | (8 << 6) | 4) & 0xFFu;
    prefer_scan = (atomicAdd(cucnt + ((xcc << 8) | cu), 1u) == 0u);
  }
  for (;;) {
    __syncthreads();
    if (tid == 0) {
      int code = -1;
      if (do_scan && !t0done) { const unsigned u = atomicAdd(ctrS + 8, 1u); if (u < 16u) code = NSCAN + NATT + (int)u; else t0done = true; }
      if (code < 0 && prefer_scan && !sdone) { const unsigned u = atomicAdd(ctrS, 1u); if (u < (unsigned)NSCAN) code = (int)u; else sdone = true; }
      if (code < 0 && do_att) { const unsigned u = atomicAdd(ctrA, 1u); if (u < (unsigned)NATT) code = NSCAN + (int)u; }
      if (code < 0 && !sdone) { const unsigned u = atomicAdd(ctrS, 1u); if (u < (unsigned)NSCAN) code = (int)u; else sdone = true; }
      *s_unit = code;
    }
    __syncthreads();
    const int u = *s_unit;
    if (u < 0) break;
    if (u >= NSCAN + NATT) t0_unit(lds, p, l, u - NSCAN - NATT);
    else if (u < NSCAN) scan_unit(lds, p, u);
    else if (u < NSCAN + NMLA) {
      const int v = u - NSCAN, qb = 15 - v / 96, bh = v % 96, b = bh / 6, h = bh - b * 6;
      attn_unit<false>(lds, Qm + (size_t)b * 2048 * 576 + h * 96, Km + (size_t)b * 2048 * 576 + h * 96, 576, (const bf16_t*)(ws + OFF_VTM) + (size_t)bh * 64 * 2048,
                       pA, mixed, pos, qb, h, b * 2048, 0.f, 0.f, nullptr);
    } else {
      const int v = u - NSCAN - NMLA, qb = 31 - v / 64, bh = v % 64, b = bh >> 2, h = bh & 3;
      attn_unit<true>(lds, pA + (size_t)b * 2048 * LDPA + h * 64, pA + (size_t)b * 2048 * LDPA + 256 + h * 64, LDPA, (const bf16_t*)(ws + OFF_VTD) + (size_t)bh * 64 * 2048,
                      pA, mixed, pos, qb, h, b * 2048, lam_full, lam_init, p.in[11] + l * 64);
    }
  }
}

struct GBar { unsigned* w; unsigned x, nloc, nx; };
DI unsigned gb_ld(unsigned* p) { return __hip_atomic_load(p, __ATOMIC_RELAXED, __HIP_MEMORY_SCOPE_AGENT); }
DI unsigned gb_add(unsigned* p) { return __hip_atomic_fetch_add(p, 1u, __ATOMIC_RELAXED, __HIP_MEMORY_SCOPE_AGENT); }
DI void gbar(GBar& B, unsigned nblk) {
  asm volatile("s_waitcnt vmcnt(0)" ::: "memory");
  __syncthreads();
  if (threadIdx.x == 0) {
    unsigned* w = B.w;
    if (B.nloc == 0u) {
      unsigned sum, cnt, mine, sp = 0u;
      for (;;) {
        sum = 0u; cnt = 0u; mine = 0u;
#pragma unroll
        for (unsigned j = 0; j < 16; ++j) { const unsigned c = gb_ld(w + 896 + 4 * j); sum += c; cnt += (c > 0u) ? 1u : 0u; mine = (j == B.x) ? c : mine; }
        if (sum == nblk || ++sp > (1u << 22)) break;
        __builtin_amdgcn_s_sleep(1);
      }
      B.nloc = mine > 0u ? mine : 1u; B.nx = cnt > 0u ? cnt : 1u;
    }
    const unsigned old = gb_add(w + 640 + 8 * B.x), gen = old / B.nloc;
    if (old + 1u == (gen + 1u) * B.nloc) {
      __builtin_amdgcn_fence(__ATOMIC_RELEASE, "agent");
      asm volatile("s_waitcnt vmcnt(0)" ::: "memory");
      const unsigned og = gb_add(w + 960), tg = og / B.nx;
      if (og + 1u == (tg + 1u) * B.nx) (void)gb_add(w + 968);
      else { unsigned sp = 0u; while (gb_ld(w + 968) == tg && ++sp < (1u << 22)) __builtin_amdgcn_s_sleep(1); }
      __builtin_amdgcn_fence(__ATOMIC_ACQUIRE, "agent");
      (void)gb_add(w + 768 + 8 * B.x);
    } else {
      unsigned sp = 0u; while (gb_ld(w + 768 + 8 * B.x) == gen && ++sp < (1u << 22)) __builtin_amdgcn_s_sleep(1);
      __builtin_amdgcn_fence(__ATOMIC_ACQUIRE, "agent");
    }
    asm volatile("s_waitcnt vmcnt(0)" ::: "memory");
  }
  __syncthreads();
}

__global__ void __launch_bounds__(NTH, 2) mk_fwd(KP p) {
  extern __shared__ __attribute__((aligned(16))) unsigned char lds[];
  int& s_unit = *(int*)(lds + 73728 + 1024);
  cg::grid_group grid = cg::this_grid();
  unsigned char* ws = p.ws;
  const int tid = otid(), lane = tid & 63, w = tid >> 6;
  const int G = gridDim.x, bid = blockIdx.x;
#define RUN(k) (p.ph_lo <= (k) && (k) < p.ph_hi)
  GBar gb; gb.w = (unsigned*)(ws + OFF_CTL); gb.x = (unsigned)__builtin_amdgcn_s_getreg((3 << 11) | 20) & 0xFu; gb.nloc = 0u; gb.nx = 0u;
  if (tid == 0 && p.ph_hi - p.ph_lo > 1) (void)gb_add(gb.w + 896 + 4 * gb.x);
#define SEAM(k) do { if (RUN(k) && RUN((k) + 1)) gbar(gb, (unsigned)G); } while (0)
  if (p.ph_lo < 0) grid.sync();

  if (RUN(0)) {
    const int gt = bid * NTH + tid, ngt = G * NTH;
    for (int i = gt; i < 3 * 4096; i += ngt) ((unsigned*)(ws + OFF_CU))[i] = 0u;
    for (int l = 0; l < 2; ++l) {
      bf16_t* Wc = (bf16_t*)(ws + OFF_WC + l * SZ_WC);
      if (l == 0) convT(p.in[3], 1024, 3488, Wc, 1024, NP, nullptr, gt, ngt);
      else { convT(p.in[3] + (size_t)1024 * 3488, 1024, 3488, Wc, 1024, 3488, nullptr, gt, ngt); convT(p.in[4], 1024, 32, Wc + (size_t)3488 * 1024, 1024, 96, nullptr, gt, ngt); }
      convT(p.in[5] + (size_t)l * 1024 * 1024, 1024, 1024, (bf16_t*)(ws + OFF_WO + l * SZ_WO), 1024, 1024, nullptr, gt, ngt);
      convT(p.in[8] + (size_t)l * 256 * 576, 256, 576, (bf16_t*)(ws + OFF_WUQ + l * SZ_WUQ), 256, 640, p.in[6] + l * 256, gt, ngt);
      convT(p.in[9] + (size_t)l * 128 * 768, 128, 768, (bf16_t*)(ws + OFF_WUKV + l * SZ_WUKV), 128, 768, p.in[7] + l * 128, gt, ngt);
      convT(p.in[15] + (size_t)l * 64 * 384, 64, 384, (bf16_t*)(ws + OFF_W2 + l * SZ_L), 64, 384, nullptr, gt, ngt);
      convT(p.in[17] + (size_t)l * 64 * 384, 64, 384, (bf16_t*)(ws + OFF_A2 + l * SZ_L), 64, 384, nullptr, gt, ngt);
    }
    convT(p.in[19], 32, 384, (bf16_t*)(ws + OFF_V2), 64, 384, nullptr, gt, ngt);
    {
      float* tab = (float*)(ws + OFF_TAB); const int* pos = (const int*)p.in[1];
      for (int idx = gt; idx < 2048 * 16; idx += ngt) {
        const int s = idx >> 4, i = idx & 15;
        const float inv = exp2f(-(float)i * (13.287712379549449f / 16.f));
        const float ang = (float)pos[s] * inv;
        double rev = (double)ang * 0.15915494309189535; rev -= __builtin_rint(rev);
        tab[s * 32 + i] = __builtin_amdgcn_cosf((float)rev); tab[s * 32 + 16 + i] = __builtin_amdgcn_sinf((float)rev);
      }
    }
    norm_rows2_bf16(p.in[0], p.in[2], (bf16_t*)(ws + OFF_R1), T, bid * 4 + w, G * 4, lane);
  }
  SEAM(0);
#if PROBE == 8
  for (int i = 0; i < 10; ++i) grid.sync();
#endif
#if PROBE == 6
  if (RUN(0)) { norm_rows_bf16(p.in[0], p.in[2], (bf16_t*)(ws + OFF_R1), 0, T, bid * 4 + w, G * 4, lane); grid.sync(); }
#endif
  for (int l = 0; l < 2; ++l) {
    const int pb = 1 + 4 * l;
    if (RUN(pb)) {
      EpiRoute e{(bf16_t*)(ws + OFF_PA), (bf16_t*)(ws + OFF_R2), (bf16_t*)(ws + OFF_VTD), l ? 3520 : 3488};
      const bf16_t* hb = (const bf16_t*)(ws + OFF_R1); const bf16_t* Wc = (const bf16_t*)(ws + OFF_WC + l * SZ_WC);
      for (int rep = 0; rep < ((PROBE == 1 && l == 0) ? 2 : 1); ++rep)
      for (int u = bid; u < 256 * 28; u += G) { const int rt = u / 28, ct = u - rt * 28; gemm_tile<4>(lds, hb, 1024, Wc, 1024, 1024, rt * 128, ct * 128, e); }
    }
    SEAM(pb);
    if (RUN(pb + 1)) { for (int rt = bid; rt < 512; rt += G) p2_unit(lds, p, l, rt);
#if PROBE == 13
      if (l == 0) { gbar((unsigned*)(ws + OFF_CTL) + 512, (unsigned)G); for (int rt = bid; rt < 512; rt += G) p2_unit(lds, p, l, rt, 2, true); }
#elif PROBE == 15
      if (l == 0) { gbar((unsigned*)(ws + OFF_CTL) + 512, (unsigned)G); for (int rt = bid; rt < 512; rt += G) p2_unit(lds, p, l, rt, 8, true); }
#elif PROBE == 14
      if (l == 0) { gbar((unsigned*)(ws + OFF_CTL) + 512, (unsigned)G); for (int rt = bid; rt < 512; rt += G) p2_unit(lds, p, l, rt, 4, false); }
#endif
    }
    SEAM(pb + 1);
    if (RUN(pb + 2)) {
      p3_run(lds, &s_unit, p, l, l, true, true);
#if PROBE == 3
      if (l == 0) { grid.sync(); p3_run(lds, &s_unit, p, l, 2, true, false); }
#elif PROBE == 9
      if (l == 0) { grid.sync(); p3_run(lds, &s_unit, p, l, 2, true, true); }
#elif PROBE == 10
      if (l == 0) { grid.sync(); p3_run(lds, &s_unit, p, l, 2, false, true); }
#endif
    }
    SEAM(pb + 2);
    if (RUN(pb + 3)) { for (int rep = 0; rep < ((PROBE == 5 && l == 0) ? 2 : 1); ++rep) { if (rep) grid.sync(); for (int rt = bid; rt < 512; rt += G) p4_unit(lds, p, l, rt); } }
    SEAM(pb + 3);
  }
#undef RUN
#undef SEAM
}

extern "C" void kernel_launch(void* const* d_in, const int* in_sizes, int n_in, void* d_out, int out_size, void* d_ws, size_t ws_size, hipStream_t stream) {
  static int grid = 0;
  if (grid == 0) {
    if (n_in != 26 || ws_size < WS_END) { fprintf(stderr, "kernel_launch: need 26 inputs and %zu bytes of workspace (got %d, %zu)\n", (size_t)WS_END, n_in, ws_size); grid = -1; return; }
    int dev = 0, cus = 0, per_cu = 0;
    (void)hipGetDevice(&dev);
    (void)hipDeviceGetAttribute(&cus, hipDeviceAttributeMultiprocessorCount, dev);
    (void)hipFuncSetAttribute((const void*)mk_fwd, hipFuncAttributeMaxDynamicSharedMemorySize, LDS_BYTES);
    (void)hipOccupancyMaxActiveBlocksPerMultiprocessor(&per_cu, (const void*)mk_fwd, NTH, LDS_BYTES);
    if (per_cu > 2) per_cu = 2;
    if (per_cu < 1) { fprintf(stderr, "kernel_launch: occupancy query returned %d\n", per_cu); per_cu = 1; }
    grid = cus * per_cu;
  }
  if (grid < 0) return;
  (void)hipMemsetAsync(d_ws, 0, 4096, stream);
  KP p{};
  for (int i = 0; i < 26; ++i) p.in[i] = (const float*)d_in[i];
  p.out = (float*)d_out; p.ws = (unsigned char*)d_ws;
  if (MK_LAUNCHES == 1) {
    p.ph_lo = 0; p.ph_hi = NPHASE;
    void* args[] = {&p};
    hipError_t e = hipLaunchCooperativeKernel((const void*)mk_fwd, dim3(grid), dim3(NTH), args, LDS_BYTES, stream);
    if (e != hipSuccess) fprintf(stderr, "cooperative launch failed: %s (grid %d)\n", hipGetErrorString(e), grid);
  } else {
    for (int k = 0; k < NPHASE; ++k) { p.ph_lo = k; p.ph_hi = k + 1; hipLaunchKernelGGL(mk_fwd, dim3(grid), dim3(NTH), LDS_BYTES, stream, p); }
  }
}
```
